# Optimizing an MI355X kernel written in HIP

```python
import math
import jax, jax.numpy as jnp
from jax import lax
import numpy as np

D_MODEL = 1024
BATCH = 8
SEQ = 2048
DEPTH = 1

CHUNK = 64
Q_BLOCK = 128

SSD_HEADS = 8
SSD_HEAD_DIM = 64
D_SSD = SSD_HEADS * SSD_HEAD_DIM
SSD_GROUPS = 2
SSD_STATE = 128
CONV_WIDTH = 4
D_CONV = D_SSD + 2 * SSD_GROUPS * SSD_STATE

SB_HEADS = 8
SB_HEAD_DIM = 64
D_SB = SB_HEADS * SB_HEAD_DIM

D_MIX = D_SSD + D_SB
D_IN_PROJ = D_SSD + D_CONV + SSD_HEADS + 3 * D_SB

D_FF = int(math.ceil(8 * D_MODEL / 3 / 256) * 256)
EPS = 1e-6

kernel_name = "hymba_ssd_stickbreaking_sandwich_block"


def rms_norm(x, g):
    xf = x.astype(jnp.float32)
    y = xf * lax.rsqrt(jnp.mean(xf * xf, axis=-1, keepdims=True) + EPS)
    return (y * g.astype(jnp.float32)).astype(x.dtype)


def causal_depthwise_conv(u, w, b):
    k = w.shape[0]
    out = lax.conv_general_dilated(
        u, w[:, None, :].astype(u.dtype), window_strides=(1,), padding=[(k - 1, 0)],
        dimension_numbers=("NWC", "WIO", "NWC"), feature_group_count=u.shape[-1])
    return out + b.astype(u.dtype)


def segsum(a):
    t = a.shape[-1]
    cs = jnp.cumsum(a, axis=-1)
    diff = cs[..., :, None] - cs[..., None, :]
    mask = jnp.tril(jnp.ones((t, t), dtype=bool))
    return jnp.where(mask, diff, -jnp.inf)


def ssd_scan(xs, dt, a, bm, cm):
    b_, seq, n_heads, p = xs.shape
    g, n = bm.shape[-2:]
    r = n_heads // g
    c = seq // CHUNK
    x = (xs * dt[..., None]).reshape(b_, c, CHUNK, g, r, p)
    adt = (dt * a).reshape(b_, c, CHUNK, g, r).transpose(0, 3, 4, 1, 2)
    bc = bm.reshape(b_, c, CHUNK, g, n)
    cc = cm.reshape(b_, c, CHUNK, g, n)
    a_cs = jnp.cumsum(adt, axis=-1)
    decay_in = jnp.exp(segsum(adt))
    cb = jnp.einsum("bclgn,bcsgn->bgcls", cc, bc)
    y_diag = jnp.einsum("bgcls,bgrcls,bcsgrp->bclgrp", cb, decay_in, x)
    decay_states = jnp.exp(a_cs[..., -1:] - a_cs)
    chunk_states = jnp.einsum("bclgn,bgrcl,bclgrp->bcgrpn", bc, decay_states, x)
    chunk_decay = jnp.exp(a_cs[..., -1])

    def step(state, inp):
        s_c, d_c = inp
        return state * d_c[..., None, None] + s_c, state

    init = jnp.zeros_like(chunk_states[:, 0])
    _, prev = lax.scan(step, init, (jnp.moveaxis(chunk_states, 1, 0), jnp.moveaxis(chunk_decay, -1, 0)))
    prev = jnp.moveaxis(prev, 0, 1)
    y_off = jnp.einsum("bclgn,bcgrpn,bgrcl->bclgrp", cc, prev, jnp.exp(a_cs))
    return (y_diag + y_off).reshape(b_, seq, n_heads, p)


def stick_breaking_attention(q, k, v):
    seq, d = q.shape[2], q.shape[3]
    scale = 1.0 / math.sqrt(d)
    outs = []
    for i in range(seq // Q_BLOCK):
        start = i * Q_BLOCK
        end = start + Q_BLOCK
        kb = k[:, :, :end]
        vb = v[:, :, :end]
        z = jnp.einsum("bhqd,bhkd->bhqk", q[:, :, start:end], kb).astype(jnp.float32) * scale
        t_idx = start + jnp.arange(Q_BLOCK)
        s_idx = jnp.arange(end)
        strict = s_idx[None, :] < t_idx[:, None]
        log_1mb = jnp.where(strict, jax.nn.log_sigmoid(-z), 0.0)
        after = lax.cumsum(log_1mb, axis=3, reverse=True) - log_1mb
        w = jnp.where(strict, jnp.exp(jax.nn.log_sigmoid(z) + after), 0.0)
        outs.append(jnp.einsum("bhqk,bhkd->bhqd", w.astype(vb.dtype), vb))
    return jnp.concatenate(outs, axis=2)


def setup_inputs(seed: int = 0) -> dict:
    key = jax.random.key(seed)
    ks = jax.random.split(key, 20)
    f32 = jnp.float32

    def gain(k, n):
        return 1.0 + 0.02 * jax.random.normal(k, (DEPTH, n), f32)

    x = jax.random.normal(ks[0], (BATCH, SEQ, D_MODEL), f32)
    w_in = jax.random.normal(ks[1], (DEPTH, D_MODEL, D_IN_PROJ), f32) * D_MODEL ** -0.5
    conv_w = jax.random.normal(ks[2], (DEPTH, CONV_WIDTH, D_CONV), f32) * CONV_WIDTH ** -0.5
    conv_b = 0.02 * jax.random.normal(ks[3], (DEPTH, D_CONV), f32)
    dt0 = jnp.exp(jax.random.uniform(ks[4], (DEPTH, SSD_HEADS), f32, math.log(1e-3), math.log(1e-1)))
    dt_bias = dt0 + jnp.log(-jnp.expm1(-dt0))
    a_log = jnp.log(jax.random.uniform(ks[5], (DEPTH, SSD_HEADS), f32, 1.0, 16.0))
    d_skip = 1.0 + 0.1 * jax.random.normal(ks[6], (DEPTH, SSD_HEADS), f32)
    w_out = jax.random.normal(ks[7], (DEPTH, D_MIX, D_MODEL), f32) * D_MIX ** -0.5
    w_gate = jax.random.normal(ks[8], (DEPTH, D_MODEL, D_FF), f32) * D_MODEL ** -0.5
    w_up = jax.random.normal(ks[9], (DEPTH, D_MODEL, D_FF), f32) * D_MODEL ** -0.5
    w_down = jax.random.normal(ks[10], (DEPTH, D_FF, D_MODEL), f32) * D_FF ** -0.5
    return {
        "x": x,
        "pre_mix_gain": gain(ks[11], D_MODEL),
        "w_in": w_in,
        "conv_w": conv_w,
        "conv_b": conv_b,
        "dt_bias": dt_bias,
        "a_log": a_log,
        "d_skip": d_skip,
        "ssd_norm_gain": gain(ks[12], D_SSD),
        "sb_norm_gain": gain(ks[13], D_SB),
        "w_out": w_out,
        "post_mix_gain": gain(ks[14], D_MODEL),
        "pre_ffn_gain": gain(ks[15], D_MODEL),
        "w_gate": w_gate,
        "w_up": w_up,
        "w_down": w_down,
        "post_ffn_gain": gain(ks[16], D_MODEL),
    }


def reference(x, pre_mix_gain, w_in, conv_w, conv_b, dt_bias, a_log, d_skip, ssd_norm_gain,
              sb_norm_gain, w_out, post_mix_gain, pre_ffn_gain, w_gate, w_up, w_down, post_ffn_gain):
    b_, seq, _ = x.shape
    splits = np.cumsum([D_SSD, D_CONV, SSD_HEADS, D_SB, D_SB]).tolist()
    for layer in range(DEPTH):
        h = rms_norm(x, pre_mix_gain[layer])
        proj = h @ w_in[layer]
        z, xbc, dt_raw, q, k, v = jnp.split(proj, splits, axis=-1)

        xbc = jax.nn.silu(causal_depthwise_conv(xbc, conv_w[layer], conv_b[layer]))
        xs, bm, cm = jnp.split(xbc, [D_SSD, D_SSD + SSD_GROUPS * SSD_STATE], axis=-1)
        xs = xs.astype(jnp.float32).reshape(b_, seq, SSD_HEADS, SSD_HEAD_DIM)
        bm = bm.astype(jnp.float32).reshape(b_, seq, SSD_GROUPS, SSD_STATE)
        cm = cm.astype(jnp.float32).reshape(b_, seq, SSD_GROUPS, SSD_STATE)
        dt = jax.nn.softplus(dt_raw.astype(jnp.float32) + dt_bias[layer].astype(jnp.float32))
        a = -jnp.exp(a_log[layer].astype(jnp.float32))
        y = ssd_scan(xs, dt, a, bm, cm) + d_skip[layer].astype(jnp.float32)[:, None] * xs
        y = y.reshape(b_, seq, D_SSD) * jax.nn.silu(z.astype(jnp.float32))
        y = rms_norm(y.reshape(b_, seq, SSD_GROUPS, D_SSD // SSD_GROUPS),
                     ssd_norm_gain[layer].reshape(SSD_GROUPS, D_SSD // SSD_GROUPS))
        y_ssd = y.reshape(b_, seq, D_SSD).astype(x.dtype)

        def heads(t):
            return t.reshape(b_, seq, SB_HEADS, SB_HEAD_DIM).transpose(0, 2, 1, 3)
        o = stick_breaking_attention(heads(q), heads(k), heads(v)).transpose(0, 2, 1, 3)
        o = rms_norm(o, sb_norm_gain[layer].reshape(SB_HEADS, SB_HEAD_DIM))
        y_sb = o.reshape(b_, seq, D_SB).astype(x.dtype)

        mix = jnp.concatenate([y_ssd, y_sb], axis=-1) @ w_out[layer]
        x = x + rms_norm(mix, post_mix_gain[layer])

        h = rms_norm(x, pre_ffn_gain[layer])
        f = (jax.nn.silu(h @ w_gate[layer]) * (h @ w_up[layer])) @ w_down[layer]
        x = x + rms_norm(f, post_ffn_gain[layer])
    return x
```

```cpp
#define REPMASK 0
#include <hip/hip_runtime.h>
#include <hip/hip_cooperative_groups.h>
#include <cstdio>
#include <cstdint>
namespace cg = cooperative_groups;
#ifndef REPMASK
#define REPMASK 0
#endif

constexpr int NB = 8, SEQ = 2048, DM = 1024, M = NB * SEQ;
constexpr int DIN = 3080;
constexpr int N1 = 3072;
constexpr int PZ = 0, PX = 512, PQ = 1536, PK = 2048, PV = 2560;
constexpr int DFF = 2816, N3 = 2 * DFF;
constexpr int NH = 8, HD = 64, NST = 128, CH = 64, NCH = SEQ / CH;
constexpr float EPS = 1e-6f;
constexpr float LOG2E = 1.4426950408889634f;
constexpr float QSCALE = 0.125f * LOG2E;

constexpr size_t MiB = 1u << 20;
constexpr size_t WS_W1 = 0, WS_W2 = 6 * MiB, WS_W3 = 8 * MiB, WS_W4 = 19 * MiB;
constexpr size_t WS_DT = 25 * MiB;
constexpr size_t WS_CD = 25 * MiB + 512 * 1024;
constexpr size_t WS_H = 26 * MiB;
constexpr size_t WS_PROJ = 58 * MiB;
constexpr size_t WS_CS = 154 * MiB;
constexpr size_t WS_XC = 186 * MiB;
constexpr size_t WS_CTL = 218 * MiB;
constexpr size_t WS_PB = 219 * MiB;
constexpr size_t WS_END = 251 * MiB;

constexpr int LDS_BYTES = 147456;
constexpr int NTHR = 512, NWAVES = 8;

#define LAS __attribute__((address_space(3)))
typedef unsigned short bf16;
typedef unsigned v4u __attribute__((ext_vector_type(4)));
typedef unsigned v2u __attribute__((ext_vector_type(2)));
typedef float v4f __attribute__((ext_vector_type(4)));
typedef float f32x16 __attribute__((ext_vector_type(16)));

__device__ __forceinline__ unsigned f2bf(float f) { unsigned u = __builtin_bit_cast(unsigned, f); return (u + 0x7fffu + ((u >> 16) & 1u)) >> 16; }
typedef float f32x2_t __attribute__((ext_vector_type(2)));
typedef __bf16 bf16x2_t __attribute__((ext_vector_type(2)));
__device__ __forceinline__ unsigned cvtpk(float lo, float hi) { f32x2_t v = {lo, hi}; bf16x2_t b = __builtin_convertvector(v, bf16x2_t); return __builtin_bit_cast(unsigned, b); }
__device__ __forceinline__ unsigned pk2(float lo, float hi) { return cvtpk(lo, hi); }
__device__ __forceinline__ void wt8(void* p, unsigned lo, unsigned hi) { __hip_atomic_store((unsigned long long*)p, (unsigned long long)lo | ((unsigned long long)hi << 32), __ATOMIC_RELAXED, __HIP_MEMORY_SCOPE_AGENT); }
__device__ __forceinline__ __amdgpu_buffer_rsrc_t wt_rsrc(void* base, unsigned bytes) { return __builtin_amdgcn_make_buffer_rsrc(base, 0, (int)bytes, 0x00020000); }
__device__ __forceinline__ void wt16(__amdgpu_buffer_rsrc_t r, unsigned byte_off, v4u v) { __builtin_amdgcn_raw_buffer_store_b128(v, r, (int)byte_off, 0, 16); }
__device__ __forceinline__ float bf2f(unsigned b) { return __builtin_bit_cast(float, b << 16); }
__device__ __forceinline__ float bflo(unsigned w) { return __builtin_bit_cast(float, w << 16); }
__device__ __forceinline__ float bfhi(unsigned w) { return __builtin_bit_cast(float, w & 0xffff0000u); }
__device__ __forceinline__ float wave_sum(float v) {
#pragma unroll
    for (int o = 1; o < 64; o <<= 1) v += __shfl_xor(v, o);
    return v;
}
__device__ __forceinline__ float siluf(float v) { return v / (1.f + __expf(-v)); }
__device__ __forceinline__ float silu_fast(float v) { return v * __builtin_amdgcn_rcpf(1.f + __builtin_amdgcn_exp2f(-LOG2E * v)); }
__device__ __forceinline__ float softplusf(float v) { return fmaxf(v, 0.f) + log1pf(__expf(-fabsf(v))); }

namespace pg8 {
#define PG8_LAS __attribute__((address_space(3)))
typedef unsigned short bf16_t;
typedef short bf16x8 __attribute__((ext_vector_type(8)));
typedef float f32x4 __attribute__((ext_vector_type(4)));
typedef unsigned u32x4 __attribute__((ext_vector_type(4)));
constexpr int BM = 256, BK = 64, HALF = 128, HTB = HALF * BK * 2  , STAGE_BYTES = 8 * HTB, NXCD = 8, WGM = 8;

__host__ __device__ __forceinline__ int lds_byte(int r, int c) { const int st = (r >> 4) * 2 + (c >> 5), rr = r & 15, cc = c & 31, ob = rr * 64 + cc * 2; return st * 1024 + (ob ^ (((ob >> 9) & 1) << 5)); }
__host__ __device__ __forceinline__ void stage_rc(int b, int& R, int& C) { const int st = b / 1024, sb = b % 1024, swz = sb ^ (((sb >> 9) & 1) << 5); R = (st >> 1) * 16 + swz / 64; C = (st & 1) * 32 + (swz % 64) / 2; }
__host__ __device__ __forceinline__ int perm32(int rho) { const int n = rho >> 4, i = rho & 15; return 8 * (i >> 2) + 4 * n + (i & 3); }

struct Unit { int pm, pn; };
struct Gemm { const bf16_t* A; const bf16_t* Bt; int M, N, K; };

struct StaticOrder {
    int nM, nN, nwg, G, c;
    __host__ __device__ void init(int M, int N, int G_, int c_) { nM = M / BM; nN = N / BM; nwg = nM * nN; G = G_; c = c_; }
    __host__ __device__ bool next(int i, Unit& u) const {
        const long L = (long)i * G + c; if (L >= nwg) return false;
        int wgid = (int)L; { const int q = nwg / NXCD, r = nwg % NXCD, xcd = wgid % NXCD, off = wgid / NXCD; wgid = (xcd < r ? xcd * (q + 1) : r * (q + 1) + (xcd - r) * q) + off; }
        const int nig = WGM * nN, gid = wgid / nig, fm = gid * WGM, gsz = (nM - fm) < WGM ? (nM - fm) : WGM;
        u.pm = fm + ((wgid % nig) % gsz); u.pn = (wgid % nig) / gsz; return true;
    }
    __device__ __forceinline__ void a_ready(const Unit&) const {}
    __device__ __forceinline__ void done(const Unit&) const {}
};

__device__ __forceinline__ unsigned cvt_pk_bf16(float lo, float hi) { unsigned r; asm volatile("v_cvt_pk_bf16_f32 %0, %1, %2" : "=v"(r) : "v"(lo), "v"(hi)); return r; }
template <class Epi, class Sched, bool ALIGN_EPI = false, bool SP2 = false>
__device__ __forceinline__ void gemm_phase(PG8_LAS unsigned char* lds, const Gemm g, const Sched& S, const Epi& E) {
    const int tid = threadIdx.x, wid = __builtin_amdgcn_readfirstlane(tid >> 6), lane = tid & 63, wr = wid >> 2, wc = wid & 3, fr = lane & 15, fq = lane >> 4;
    const int K = g.K, nt = K / BK;
    unsigned voffA[2], voffB[2];
#pragma unroll
    for (int i = 0; i < 2; ++i) { int R, C; stage_rc(tid * 16 + i * 8192, R, C); const int Rb = Epi::PERM ? ((R & ~31) + perm32(R & 31)) : R;
        voffA[i] = (unsigned)(R * K + C) * 2u; voffB[i] = (unsigned)(Rb * K + C) * 2u; }
    const size_t kstep = (size_t)(BK * 2);
    const size_t hstep = (size_t)HALF * K * 2;
    const size_t tstep = 2 * hstep;
    const unsigned ldsw = (unsigned)wid * 1024u;
    const int aoff = lds_byte(wr * 64 + fr, fq * 8), boff = lds_byte(wc * 32 + fr, fq * 8);
#define PG8_SA(b, h) (((b) * 2 + (h)) * HTB)
#define PG8_SB(b, h) ((4 + (b) * 2 + (h)) * HTB)
#define PG8_STAGE(bufoff, gbase, voff) do { _Pragma("unroll") for (int _i = 0; _i < 2; ++_i) \
        __builtin_amdgcn_global_load_lds((const unsigned*)((const char*)(gbase) + (voff)[_i]), (PG8_LAS unsigned*)(lds + (bufoff) + ldsw + _i * 8192), 16, 0, 0); } while (0)
#define PG8_LDA(dst, b, h) do { _Pragma("unroll") for (int m = 0; m < 4; ++m) _Pragma("unroll") for (int k = 0; k < 2; ++k) dst[m][k] = *(const PG8_LAS bf16x8*)(lds + PG8_SA(b, h) + aoff + m * 2048 + k * 1024); } while (0)
#define PG8_LDB(dst, b, h) do { _Pragma("unroll") for (int n = 0; n < 2; ++n) _Pragma("unroll") for (int k = 0; k < 2; ++k) dst[n][k] = *(const PG8_LAS bf16x8*)(lds + PG8_SB(b, h) + boff + n * 2048 + k * 1024); } while (0)
#define PG8_MMA(ai, bj, At, Bt) do { __builtin_amdgcn_s_setprio(1); _Pragma("unroll") for (int m = 0; m < 4; ++m) _Pragma("unroll") for (int n = 0; n < 2; ++n) _Pragma("unroll") for (int k = 0; k < 2; ++k) \
        acc[ai][bj][m][n] = __builtin_amdgcn_mfma_f32_16x16x32_bf16(Bt[n][k], At[m][k], acc[ai][bj][m][n], 0, 0, 0); __builtin_amdgcn_s_setprio(0); } while (0)
#define PG8_WAIT_V(n) asm volatile("s_waitcnt vmcnt(" #n ")" ::: "memory")
#define PG8_WAIT_L(n) asm volatile("s_waitcnt lgkmcnt(" #n ")" ::: "memory")
#define PG8_BAR __builtin_amdgcn_s_barrier()
#define PG8_SCHED __builtin_amdgcn_sched_barrier(0)
    Unit cur, nxt; int ui = 0;
    if (!S.next(0, cur)) return;
    f32x4 acc[2][2][4][2];
#pragma unroll
    for (int a = 0; a < 2; ++a)
#pragma unroll
        for (int b = 0; b < 2; ++b)
#pragma unroll
            for (int m = 0; m < 4; ++m)
#pragma unroll
                for (int n = 0; n < 2; ++n) acc[a][b][m][n] = (f32x4){0.f, 0.f, 0.f, 0.f};
    bf16x8 At[4][2], B0[2][2], B1[2][2];
    const char* cA = (const char*)g.A + (size_t)cur.pm * tstep; const char* cB = (const char*)g.Bt + (size_t)cur.pn * tstep;
    S.a_ready(cur);
    if constexpr (SP2) {
        PG8_STAGE(PG8_SB(0, 0), cB, voffB); PG8_STAGE(PG8_SB(0, 1), cB + hstep, voffB); PG8_STAGE(PG8_SA(0, 0), cA, voffA); PG8_STAGE(PG8_SA(0, 1), cA + hstep, voffA);
        if (wr == 1) PG8_BAR;
        PG8_WAIT_V(2); PG8_BAR;
        PG8_STAGE(PG8_SB(1, 0), cB + kstep, voffB); PG8_STAGE(PG8_SA(1, 0), cA + kstep, voffA); PG8_STAGE(PG8_SB(1, 1), cB + hstep + kstep, voffB);
        PG8_WAIT_V(6); PG8_BAR;
    } else {
        PG8_STAGE(PG8_SB(0, 0), cB, voffB); PG8_STAGE(PG8_SA(0, 0), cA, voffA); PG8_STAGE(PG8_SB(0, 1), cB + hstep, voffB); PG8_STAGE(PG8_SA(0, 1), cA + hstep, voffA);
        if (wr == 1) PG8_BAR;
        PG8_WAIT_V(4); PG8_BAR;
        PG8_STAGE(PG8_SB(1, 0), cB + kstep, voffB); PG8_STAGE(PG8_SA(1, 0), cA + kstep, voffA); PG8_STAGE(PG8_SB(1, 1), cB + hstep + kstep, voffB);
        PG8_WAIT_V(6); PG8_BAR;
    }
    for (;;) {
        const bool has_next = S.next(ui + 1, nxt);
        const char* nA = has_next ? (const char*)g.A + (size_t)nxt.pm * tstep : cA; const char* nB = has_next ? (const char*)g.Bt + (size_t)nxt.pn * tstep : cB;
        for (int t = 0; t < nt; t += 2) {
            const bool last = (t == nt - 2);
            const char* a1 = cA + (size_t)(t + 1) * kstep;
            const char* a2 = last ? nA : cA + (size_t)(t + 2) * kstep; const char* b2 = last ? nB : cB + (size_t)(t + 2) * kstep;
            const char* a3 = a2 + kstep; const char* b3 = b2 + kstep;
            if (last && has_next) S.a_ready(nxt);
            if constexpr (SP2) {
            PG8_LDB(B0, 0, 0); PG8_LDB(B1, 0, 1); PG8_SCHED; PG8_LDA(At, 0, 0); PG8_STAGE(PG8_SA(1, 1), a1 + hstep, voffA);
            PG8_WAIT_V(8); PG8_WAIT_L(0); PG8_BAR; PG8_MMA(0, 0, At, B0); PG8_MMA(0, 1, At, B1); PG8_BAR; PG8_SCHED;
            PG8_LDA(At, 0, 1); PG8_STAGE(PG8_SB(0, 0), b2, voffB); PG8_STAGE(PG8_SB(0, 1), b2 + hstep, voffB); PG8_STAGE(PG8_SA(0, 0), a2, voffA);
            PG8_WAIT_V(8); PG8_WAIT_L(0); PG8_BAR; PG8_MMA(1, 0, At, B0); PG8_MMA(1, 1, At, B1); PG8_BAR; PG8_SCHED;
            PG8_LDB(B0, 1, 0); PG8_LDB(B1, 1, 1); PG8_SCHED; PG8_LDA(At, 1, 0); PG8_STAGE(PG8_SA(0, 1), a2 + hstep, voffA);
            PG8_WAIT_V(8); PG8_WAIT_L(0); PG8_BAR; PG8_MMA(0, 0, At, B0); PG8_MMA(0, 1, At, B1); PG8_BAR; PG8_SCHED;
            PG8_LDA(At, 1, 1); PG8_STAGE(PG8_SB(1, 0), b3, voffB); PG8_STAGE(PG8_SB(1, 1), b3 + hstep, voffB); PG8_STAGE(PG8_SA(1, 0), a3, voffA);
            PG8_WAIT_V(8); PG8_WAIT_L(0); PG8_BAR; PG8_MMA(1, 0, At, B0); PG8_MMA(1, 1, At, B1); PG8_BAR; PG8_SCHED;
            } else {
            PG8_LDB(B0, 0, 0); PG8_SCHED; PG8_LDA(At, 0, 0); PG8_STAGE(PG8_SA(1, 1), a1 + hstep, voffA);
            PG8_WAIT_L(8); PG8_BAR; PG8_WAIT_L(0); PG8_MMA(0, 0, At, B0); PG8_BAR; PG8_SCHED;
            PG8_LDB(B1, 0, 1); PG8_STAGE(PG8_SB(0, 0), b2, voffB);
            PG8_BAR; PG8_WAIT_L(0); PG8_MMA(0, 1, At, B1); PG8_BAR;
            PG8_LDA(At, 0, 1); PG8_STAGE(PG8_SA(0, 0), a2, voffA);
            PG8_BAR; PG8_WAIT_L(0); PG8_MMA(1, 0, At, B0); PG8_BAR; PG8_SCHED;
            PG8_STAGE(PG8_SB(0, 1), b2 + hstep, voffB);
            PG8_WAIT_V(6); PG8_BAR; PG8_MMA(1, 1, At, B1); PG8_BAR;
            PG8_LDB(B0, 1, 0); PG8_SCHED; PG8_LDA(At, 1, 0); PG8_STAGE(PG8_SA(0, 1), a2 + hstep, voffA);
            PG8_WAIT_L(8); PG8_BAR; PG8_WAIT_L(0); PG8_MMA(0, 0, At, B0); PG8_BAR; PG8_SCHED;
            PG8_LDB(B1, 1, 1); PG8_STAGE(PG8_SB(1, 0), b3, voffB);
            PG8_BAR; PG8_WAIT_L(0); PG8_MMA(0, 1, At, B1); PG8_BAR;
            PG8_LDA(At, 1, 1); PG8_STAGE(PG8_SA(1, 0), a3, voffA);
            PG8_BAR; PG8_WAIT_L(0); PG8_MMA(1, 0, At, B0); PG8_BAR; PG8_SCHED;
            PG8_STAGE(PG8_SB(1, 1), b3 + hstep, voffB);
            PG8_WAIT_V(6); PG8_BAR; PG8_MMA(1, 1, At, B1); PG8_BAR;
            }
        }
        if constexpr (ALIGN_EPI) { if (wr == 0) PG8_BAR; }
        if constexpr (!Epi::AFTER_DRAIN) { E(acc, cur, wr, wc, fr, fq); S.done(cur); }
        if (!has_next) break;
#pragma unroll
        for (int a = 0; a < 2; ++a)
#pragma unroll
            for (int b = 0; b < 2; ++b)
#pragma unroll
                for (int m = 0; m < 4; ++m)
#pragma unroll
                    for (int n = 0; n < 2; ++n) acc[a][b][m][n] = (f32x4){0.f, 0.f, 0.f, 0.f};
        cur = nxt; cA = nA; cB = nB; ++ui;
        if constexpr (ALIGN_EPI) { if (wr == 1) PG8_BAR; }
    }
    PG8_WAIT_V(0);
    if constexpr (!ALIGN_EPI) { if (wr == 0) PG8_BAR; }
    PG8_BAR;
    if constexpr (Epi::AFTER_DRAIN) { E.fused(acc, cur, wr, wc, fr, fq, lds, wid, lane); S.done(cur); }
#undef PG8_SA
#undef PG8_SB
#undef PG8_STAGE
#undef PG8_LDA
#undef PG8_LDB
#undef PG8_MMA
#undef PG8_WAIT_V
#undef PG8_WAIT_L
#undef PG8_BAR
#undef PG8_SCHED
}
}

namespace pg8 {
struct EpiProj {
    static constexpr bool PERM = true, AFTER_DRAIN = false;
    bf16_t* O;
    __device__ __forceinline__ void operator()(const f32x4 (&acc)[2][2][4][2], const Unit& u, int wr, int wc, int fr, int fq) const {
        const int row0 = u.pm * BM + wr * 64 + fr, col0 = u.pn * BM + wc * 32 + 8 * fq;
        const float sc = (u.pn == 6 || u.pn == 7) ? QSCALE : 1.f;
        const __amdgpu_buffer_rsrc_t rs = wt_rsrc(O, (unsigned)((size_t)16384 * N1 * 2));
#pragma unroll
        for (int ai = 0; ai < 2; ++ai)
#pragma unroll
            for (int m = 0; m < 4; ++m) { const unsigned rowb = (unsigned)(((size_t)(row0 + ai * HALF + m * 16) * N1 + col0) * 2);
#pragma unroll
                for (int bj = 0; bj < 2; ++bj) { const f32x4 v0 = acc[ai][bj][m][0] * sc, v1 = acc[ai][bj][m][1] * sc;
                    u32x4 w; w.x = cvt_pk_bf16(v0[0], v0[1]); w.y = cvt_pk_bf16(v0[2], v0[3]); w.z = cvt_pk_bf16(v1[0], v1[1]); w.w = cvt_pk_bf16(v1[2], v1[3]);
                    wt16(rs, rowb + bj * HALF * 2, w); } }
    }
};
struct EpiBf16 {
    static constexpr bool PERM = true, AFTER_DRAIN = false;
    bf16_t* O; int ldc;
    __device__ __forceinline__ void operator()(const f32x4 (&acc)[2][2][4][2], const Unit& u, int wr, int wc, int fr, int fq) const {
        const int row0 = u.pm * BM + wr * 64 + fr, col0 = u.pn * BM + wc * 32 + 8 * fq;
#pragma unroll
        for (int ai = 0; ai < 2; ++ai)
#pragma unroll
            for (int m = 0; m < 4; ++m) { bf16_t* rowp = O + (size_t)(row0 + ai * HALF + m * 16) * ldc + col0;
#pragma unroll
                for (int bj = 0; bj < 2; ++bj) { const f32x4 v0 = acc[ai][bj][m][0], v1 = acc[ai][bj][m][1];
                    u32x4 w; w.x = cvt_pk_bf16(v0[0], v0[1]); w.y = cvt_pk_bf16(v0[2], v0[3]); w.z = cvt_pk_bf16(v1[0], v1[1]); w.w = cvt_pk_bf16(v1[2], v1[3]);
                    *(u32x4*)(rowp + bj * HALF) = w; } }
    }
};
__device__ __forceinline__ void rms_exchange(const f32x4 (&v)[2][2][4][2], const Unit& u, int wr, int wc, int fr, int fq, PG8_LAS unsigned char* lds, int wid, int lane, float* xbuf, unsigned* cnt) {
    PG8_LAS float* P = (PG8_LAS float*)lds;
    PG8_LAS float* S = (PG8_LAS float*)(lds + 4096);
#pragma unroll
    for (int ai = 0; ai < 2; ++ai)
#pragma unroll
        for (int m = 0; m < 4; ++m) {
            float s = 0.f;
#pragma unroll
            for (int bj = 0; bj < 2; ++bj)
#pragma unroll
                for (int n = 0; n < 2; ++n) { const f32x4 x = v[ai][bj][m][n]; s += (x[0] * x[0] + x[1] * x[1]) + (x[2] * x[2] + x[3] * x[3]); }
            s += __shfl_xor(s, 16); s += __shfl_xor(s, 32);
            if (fq == 0) P[(ai * HALF + wr * 64 + m * 16 + fr) * 4 + wc] = s;
        }
    asm volatile("s_waitcnt lgkmcnt(0)" ::: "memory"); __builtin_amdgcn_s_barrier(); asm volatile("" ::: "memory");
    const int row = wid * 32 + (lane & 31);
    if (lane < 32) {
        const float tot = (P[row * 4 + 0] + P[row * 4 + 1]) + (P[row * 4 + 2] + P[row * 4 + 3]);
        __hip_atomic_store((unsigned*)xbuf + (size_t)(u.pm * BM + row) * 4 + u.pn, __builtin_bit_cast(unsigned, tot), __ATOMIC_RELAXED, __HIP_MEMORY_SCOPE_AGENT);
    }
    asm volatile("s_waitcnt vmcnt(0)" ::: "memory");
    if (lane == 0) __hip_atomic_fetch_add(cnt + 64 * u.pm, 1u, __ATOMIC_RELAXED, __HIP_MEMORY_SCOPE_AGENT);
    if (wid == 0) {
        unsigned sp = 0u;
        while ((unsigned)__builtin_amdgcn_readfirstlane(__hip_atomic_load(cnt + 64 * u.pm, __ATOMIC_RELAXED, __HIP_MEMORY_SCOPE_AGENT)) < 32u) { __builtin_amdgcn_s_sleep(2); if (++sp > (1u << 22)) break; }
        __builtin_amdgcn_fence(__ATOMIC_ACQUIRE, "agent");
    }
    asm volatile("s_waitcnt vmcnt(0) lgkmcnt(0)" ::: "memory"); __builtin_amdgcn_s_barrier(); asm volatile("" ::: "memory");
    if (lane < 32) {
        const unsigned* slot = (const unsigned*)xbuf + (size_t)(u.pm * BM + row) * 4; float q = 0.f;
#pragma unroll
        for (int t = 0; t < 4; ++t) q += __builtin_bit_cast(float, __hip_atomic_load(slot + t, __ATOMIC_RELAXED, __HIP_MEMORY_SCOPE_AGENT));
        S[row] = rsqrtf(q * (1.f / 1024.f) + 1e-6f);
    }
    asm volatile("s_waitcnt vmcnt(0) lgkmcnt(0)" ::: "memory"); __builtin_amdgcn_s_barrier(); asm volatile("" ::: "memory");
}
struct EpiRmsRes {
    static constexpr bool PERM = false, AFTER_DRAIN = true;
    const bf16_t* x1b; float* out; const float* gain; float* xbuf; unsigned* cnt;
    __device__ __forceinline__ void fused(f32x4 (&acc)[2][2][4][2], const Unit& u, int wr, int wc, int fr, int fq, PG8_LAS unsigned char* lds, int wid, int lane) const {
        typedef unsigned u32x2v __attribute__((ext_vector_type(2)));
        const PG8_LAS float* S = (const PG8_LAS float*)(lds + 4096);
        const int col0 = u.pn * BM + wc * 32 + 4 * fq;
        u32x2v pre[2][4][2][2];
#pragma unroll
        for (int ai = 0; ai < 2; ++ai)
#pragma unroll
            for (int m = 0; m < 4; ++m) { const size_t off = (size_t)(u.pm * BM + ai * HALF + wr * 64 + m * 16 + fr) * 1024 + col0;
#pragma unroll
                for (int bj = 0; bj < 2; ++bj)
#pragma unroll
                    for (int n = 0; n < 2; ++n) pre[ai][m][bj][n] = *(const u32x2v*)(x1b + off + bj * HALF + n * 16); }
        rms_exchange(acc, u, wr, wc, fr, fq, lds, wid, lane, xbuf, cnt);
        f32x4 gv[2][2];
#pragma unroll
        for (int bj = 0; bj < 2; ++bj)
#pragma unroll
            for (int n = 0; n < 2; ++n) gv[bj][n] = *(const f32x4*)(gain + col0 + bj * HALF + n * 16);
#pragma unroll
        for (int ai = 0; ai < 2; ++ai)
#pragma unroll
            for (int m = 0; m < 4; ++m) { const int r = ai * HALF + wr * 64 + m * 16 + fr; const float rs = S[r]; const size_t off = (size_t)(u.pm * BM + r) * 1024 + col0;
#pragma unroll
                for (int bj = 0; bj < 2; ++bj)
#pragma unroll
                    for (int n = 0; n < 2; ++n) { const u32x2v pv = pre[ai][m][bj][n];
                        const f32x4 bs = {__builtin_bit_cast(float, pv.x << 16), __builtin_bit_cast(float, pv.x & 0xffff0000u), __builtin_bit_cast(float, pv.y << 16), __builtin_bit_cast(float, pv.y & 0xffff0000u)};
                        *(f32x4*)(out + off + bj * HALF + n * 16) = bs + acc[ai][bj][m][n] * rs * gv[bj][n]; } }
    }
};
struct EpiRmsResRms {
    static constexpr bool PERM = false, AFTER_DRAIN = true;
    const float* x; bf16_t* x1b; bf16_t* h2; const float* g1; const float* g2; float* xbuf1; unsigned* cnt1; float* xbuf2; unsigned* cnt2;
    __device__ __forceinline__ void fused(f32x4 (&acc)[2][2][4][2], const Unit& u, int wr, int wc, int fr, int fq, PG8_LAS unsigned char* lds, int wid, int lane) const {
        typedef unsigned u32x2v __attribute__((ext_vector_type(2)));
        const PG8_LAS float* S = (const PG8_LAS float*)(lds + 4096);
        const int col0 = u.pn * BM + wc * 32 + 4 * fq;
        rms_exchange(acc, u, wr, wc, fr, fq, lds, wid, lane, xbuf1, cnt1);
        {
            f32x4 gv[2][2];
#pragma unroll
            for (int bj = 0; bj < 2; ++bj)
#pragma unroll
                for (int n = 0; n < 2; ++n) gv[bj][n] = *(const f32x4*)(g1 + col0 + bj * HALF + n * 16);
#pragma unroll
            for (int ai = 0; ai < 2; ++ai)
#pragma unroll
                for (int m = 0; m < 4; ++m) { const int r = ai * HALF + wr * 64 + m * 16 + fr; const float rs = S[r]; const size_t off = (size_t)(u.pm * BM + r) * 1024 + col0;
#pragma unroll
                    for (int bj = 0; bj < 2; ++bj)
#pragma unroll
                        for (int n = 0; n < 2; ++n) { const f32x4 bs = *(const f32x4*)(x + off + bj * HALF + n * 16); acc[ai][bj][m][n] = bs + acc[ai][bj][m][n] * rs * gv[bj][n]; }
                    asm volatile("" : "+v"(acc[ai][0][m][0]), "+v"(acc[ai][0][m][1]), "+v"(acc[ai][1][m][0]), "+v"(acc[ai][1][m][1]));
                    if (m & 1) asm volatile("" ::: "memory"); }
        }
        rms_exchange(acc, u, wr, wc, fr, fq, lds, wid, lane, xbuf2, cnt2);
        f32x4 gv[2][2];
#pragma unroll
        for (int bj = 0; bj < 2; ++bj)
#pragma unroll
            for (int n = 0; n < 2; ++n) gv[bj][n] = *(const f32x4*)(g2 + col0 + bj * HALF + n * 16);
#pragma unroll
        for (int ai = 0; ai < 2; ++ai)
#pragma unroll
            for (int m = 0; m < 4; ++m) { const int r = ai * HALF + wr * 64 + m * 16 + fr; const float rs = S[r]; const size_t off = (size_t)(u.pm * BM + r) * 1024 + col0;
#pragma unroll
                for (int bj = 0; bj < 2; ++bj)
#pragma unroll
                    for (int n = 0; n < 2; ++n) { const f32x4 x1 = acc[ai][bj][m][n]; { u32x2v xw; xw.x = cvt_pk_bf16(x1[0], x1[1]); xw.y = cvt_pk_bf16(x1[2], x1[3]); *(u32x2v*)(x1b + off + bj * HALF + n * 16) = xw; }
                        const f32x4 o = x1 * rs * gv[bj][n]; u32x2v w; w.x = cvt_pk_bf16(o[0], o[1]); w.y = cvt_pk_bf16(o[2], o[3]); *(u32x2v*)(h2 + off + bj * HALF + n * 16) = w; }
                asm volatile("" ::: "memory"); }
    }
};
struct EpiF32 {
    static constexpr bool PERM = true, AFTER_DRAIN = false;
    float* O; int ldc;
    __device__ __forceinline__ void operator()(const f32x4 (&acc)[2][2][4][2], const Unit& u, int wr, int wc, int fr, int fq) const {
        const int row0 = u.pm * BM + wr * 64 + fr, col0 = u.pn * BM + wc * 32 + 8 * fq;
#pragma unroll
        for (int ai = 0; ai < 2; ++ai)
#pragma unroll
            for (int m = 0; m < 4; ++m) { float* rowp = O + (size_t)(row0 + ai * HALF + m * 16) * ldc + col0;
#pragma unroll
                for (int bj = 0; bj < 2; ++bj) { *(f32x4*)(rowp + bj * HALF) = acc[ai][bj][m][0]; *(f32x4*)(rowp + bj * HALF + 4) = acc[ai][bj][m][1]; } }
    }
};
struct EpiSwiglu {
    static constexpr bool PERM = true, AFTER_DRAIN = false;
    bf16_t* O;
    __device__ __forceinline__ void operator()(const f32x4 (&acc)[2][2][4][2], const Unit& u, int wr, int wc, int fr, int fq) const {
        const int row0 = u.pm * BM + wr * 64 + fr, col0 = u.pn * HALF + wc * 32 + 8 * fq;
        const __amdgpu_buffer_rsrc_t rs = wt_rsrc(O, (unsigned)((size_t)16384 * DFF * 2));
#pragma unroll
        for (int ai = 0; ai < 2; ++ai)
#pragma unroll
            for (int m = 0; m < 4; ++m) { const unsigned rowb = (unsigned)(((size_t)(row0 + ai * HALF + m * 16) * DFF + col0) * 2);
                float r[8];
#pragma unroll
                for (int n = 0; n < 2; ++n)
#pragma unroll
                    for (int e = 0; e < 4; ++e) { const float g = acc[ai][0][m][n][e], up = acc[ai][1][m][n][e];
                        r[4 * n + e] = g * __builtin_amdgcn_rcpf(1.f + __expf(-g)) * up; }
                u32x4 w; w.x = cvt_pk_bf16(r[0], r[1]); w.y = cvt_pk_bf16(r[2], r[3]); w.z = cvt_pk_bf16(r[4], r[5]); w.w = cvt_pk_bf16(r[6], r[7]);
                wt16(rs, rowb, w); }
    }
};
}

struct Args {
    const float* x; const float* pre_mix_gain; const float* w_in; const float* conv_w; const float* conv_b; const float* dt_bias; const float* a_log; const float* d_skip;
    const float* ssd_norm_gain; const float* sb_norm_gain; const float* w_out; const float* post_mix_gain; const float* pre_ffn_gain; const float* w_gate; const float* w_up;
    const float* w_down; const float* post_ffn_gain; float* out; unsigned char* ws; int ph_lo, ph_hi;
};

__device__ __forceinline__ void transpose_item(const float* src, int ldw, bf16* dst, int K, LAS float* scr, int lane, __amdgpu_buffer_rsrc_t wr, const bf16* wbase) {
    float tv[32];
#pragma unroll
    for (int i = 0; i < 32; ++i) tv[i] = src[(size_t)(2 * i + (lane >> 5)) * ldw + (lane & 31)];
#pragma unroll
    for (int i = 0; i < 32; ++i) scr[(2 * i + (lane >> 5)) * 33 + (lane & 31)] = tv[i];
    asm volatile("s_waitcnt lgkmcnt(0)" ::: "memory");
    const int c = lane & 7;
#pragma unroll
    for (int j = 0; j < 4; ++j) { const int n = (lane >> 3) + 8 * j; const LAS float* s = scr + (8 * c) * 33 + n;
        v4u o; o.x = pk2(s[0 * 33], s[1 * 33]); o.y = pk2(s[2 * 33], s[3 * 33]); o.z = pk2(s[4 * 33], s[5 * 33]); o.w = pk2(s[6 * 33], s[7 * 33]);
        wt16(wr, (unsigned)((dst + (size_t)n * K + 8 * c - wbase) * 2), o); }
    asm volatile("s_waitcnt lgkmcnt(0)" ::: "memory");
}

__device__ __forceinline__ void phase_p0(const Args& a, LAS unsigned char* lds, bool defer_w4) {
    const int tid = threadIdx.x, lane = tid & 63, wave = tid >> 6;
    const int gw = blockIdx.x * NWAVES + wave, NGW = gridDim.x * NWAVES;
    unsigned char* ws = a.ws;
    LAS float* scr = (LAS float*)(lds + wave * 8704);
    LAS float* wdt = (LAS float*)(lds + 73728);
    for (int i = tid; i < 8192; i += NTHR) { const int hd = i & 7, k = i >> 3; wdt[hd * 1024 + k] = a.w_in[(size_t)k * DIN + 1536 + hd]; }
    __syncthreads();
    bf16* W1 = (bf16*)(ws + WS_W1); bf16* W2 = (bf16*)(ws + WS_W2); bf16* W3 = (bf16*)(ws + WS_W3); bf16* W4 = (bf16*)(ws + WS_W4);
    const __amdgpu_buffer_rsrc_t wrs = wt_rsrc(W1, 25u << 20);
    constexpr int I1 = 16 * 48, I2 = 16 * 32, I3 = 16 * 88, I4 = 44 * 32;
    const int NITEMS = 2 * I1 + I2 + 2 * I3 + (defer_w4 ? 0 : I4);
    for (int _rp = 0; _rp < 1 + (((REPMASK) >> 12) & 1); ++_rp)
    for (int it = gw; it < NITEMS; it += NGW) {
        int r = it;
        if (r < I1) { const int kb = r / 48, nb = r % 48; transpose_item(a.w_in + (size_t)(64 * kb) * DIN + 32 * nb, DIN, W1 + (size_t)(32 * nb) * 1024 + 64 * kb, 1024, scr, lane, wrs, W1); continue; } r -= I1;
        if (r < I1) { const int kb = r / 48, nb = r % 48; transpose_item(a.w_in + (size_t)(64 * kb) * DIN + 1544 + 32 * nb, DIN, W1 + (size_t)(1536 + 32 * nb) * 1024 + 64 * kb, 1024, scr, lane, wrs, W1); continue; } r -= I1;
        if (r < I2) { const int kb = r / 32, nb = r % 32; transpose_item(a.w_out + (size_t)(64 * kb) * 1024 + 32 * nb, 1024, W2 + (size_t)(32 * nb) * 1024 + 64 * kb, 1024, scr, lane, wrs, W1); continue; } r -= I2;
        if (r < I3) { const int kb = r / 88, nb = r % 88, n0 = 32 * nb; transpose_item(a.w_gate + (size_t)(64 * kb) * DFF + n0, DFF, W3 + (size_t)(256 * (n0 >> 7) + (n0 & 127)) * 1024 + 64 * kb, 1024, scr, lane, wrs, W1); continue; } r -= I3;
        if (r < I3) { const int kb = r / 88, nb = r % 88, n0 = 32 * nb; transpose_item(a.w_up + (size_t)(64 * kb) * DFF + n0, DFF, W3 + (size_t)(256 * (n0 >> 7) + 128 + (n0 & 127)) * 1024 + 64 * kb, 1024, scr, lane, wrs, W1); continue; } r -= I3;
        { const int kb = r / 32, nb = r % 32; transpose_item(a.w_down + (size_t)(64 * kb) * 1024 + 32 * nb, 1024, W4 + (size_t)(32 * nb) * DFF + 64 * kb, DFF, scr, lane, wrs, W1); }
    }
    bf16* H = (bf16*)(ws + WS_H); float* DT = (float*)(ws + WS_DT);
    const int hh = lane >> 5, b4 = (lane >> 4) & 1, b3 = (lane >> 3) & 1;
    v4f gpm[4];
#pragma unroll
    for (int j = 0; j < 4; ++j) gpm[j] = ((const v4f*)a.pre_mix_gain)[lane + 64 * j];
    v4f v[4], vn[4];
    if (gw < M) {
#pragma unroll
        for (int j = 0; j < 4; ++j) v[j] = ((const v4f*)(a.x + (size_t)gw * DM))[lane + 64 * j];
    }
    for (int _rq = 0; _rq < 1 + (((REPMASK) >> 13) & 1); ++_rq)
    for (int m = gw; m < M; m += NGW) {
        const int mn = m + NGW < M ? m + NGW : gw;
        if (true) {
#pragma unroll
            for (int j = 0; j < 4; ++j) vn[j] = ((const v4f*)(a.x + (size_t)mn * DM))[lane + 64 * j];
        }
        float s = 0.f;
#pragma unroll
        for (int j = 0; j < 4; ++j) s += (v[j].x * v[j].x + v[j].y * v[j].y) + (v[j].z * v[j].z + v[j].w * v[j].w);
        const float rstd = rsqrtf(wave_sum(s) * (1.f / DM) + EPS);
        float da[8];
#pragma unroll
        for (int hd = 0; hd < 8; ++hd) da[hd] = 0.f;
        unsigned long long* o8 = (unsigned long long*)(H + (size_t)m * DM) + lane;
#pragma unroll
        for (int j = 0; j < 4; ++j) {
            const v4f hv = v[j] * rstd * gpm[j];
            wt8(o8 + 64 * j, pk2(hv.x, hv.y), pk2(hv.z, hv.w));
#pragma unroll
            for (int hd = 0; hd < 8; ++hd) { const v4f w = *(const LAS v4f*)(wdt + hd * 1024 + 4 * lane + 256 * j); da[hd] += (hv.x * w.x + hv.y * w.y) + (hv.z * w.z + hv.w * w.w); }
        }
        float k4[4], k2[2], k1;
#pragma unroll
        for (int i = 0; i < 4; ++i) { const float keep = hh ? da[4 + i] : da[i], send = hh ? da[i] : da[4 + i]; k4[i] = keep + __shfl_xor(send, 32); }
#pragma unroll
        for (int i = 0; i < 2; ++i) { const float keep = b4 ? k4[2 + i] : k4[i], send = b4 ? k4[i] : k4[2 + i]; k2[i] = keep + __shfl_xor(send, 16); }
        { const float keep = b3 ? k2[1] : k2[0], send = b3 ? k2[0] : k2[1]; k1 = keep + __shfl_xor(send, 8); }
        k1 += __shfl_xor(k1, 4); k1 += __shfl_xor(k1, 2); k1 += __shfl_xor(k1, 1);
        if ((lane & 7) == 0) DT[(size_t)m * 8 + (lane >> 3)] = k1;
#pragma unroll
        for (int j = 0; j < 4; ++j) v[j] = vn[j];
    }
}

__device__ __forceinline__ void phase_w4(const Args& a, LAS unsigned char* lds) {
    if (blockIdx.x < 128) return;
    const int lane = threadIdx.x & 63, wave = threadIdx.x >> 6, gw = (blockIdx.x - 128) * NWAVES + wave, NGW = 128 * NWAVES;
    LAS float* scr = (LAS float*)(lds + wave * 8704);
    bf16* W1 = (bf16*)(a.ws + WS_W1); bf16* W4 = (bf16*)(a.ws + WS_W4);
    const __amdgpu_buffer_rsrc_t wrs = wt_rsrc(W1, 25u << 20);
    for (int r = gw; r < 44 * 32; r += NGW) { const int kb = r / 32, nb = r % 32; transpose_item(a.w_down + (size_t)(64 * kb) * 1024 + 32 * nb, 1024, W4 + (size_t)(32 * nb) * DFF + 64 * kb, DFF, scr, lane, wrs, W1); }
}

__device__ __forceinline__ void phase_conv_naive(const Args& a) {
    const bf16* PROJ = (const bf16*)(a.ws + WS_PROJ); float* XC = (float*)(a.ws + WS_CS);
    const size_t total = (size_t)M * 1024, stride = (size_t)gridDim.x * NTHR;
    for (size_t idx = (size_t)blockIdx.x * NTHR + threadIdx.x; idx < total; idx += stride) {
        const int m = (int)(idx >> 10), ch = (int)(idx & 1023), t = m & (SEQ - 1);
        float acc = a.conv_b[ch];
#pragma unroll
        for (int j = 0; j < 4; ++j) { const int tt = t - 3 + j; if (tt >= 0) acc += a.conv_w[j * 1024 + ch] * bf2f(PROJ[(size_t)(m - 3 + j) * N1 + PX + ch]); }
        XC[idx] = siluf(acc);
    }
}

__device__ __forceinline__ void phase_ssd_naive(const Args& a, LAS unsigned char* lds) {
    if (blockIdx.x >= 16) return;
    const int tid = threadIdx.x, lane = tid & 63, wave = tid >> 6;
    const int b = blockIdx.x >> 1, g = blockIdx.x & 1;
    const bool act = tid < 256;
    const int hl = (tid >> 6) & 3, p = tid & 63, h = 4 * g + hl;
    const bf16* PROJ = (const bf16*)(a.ws + WS_PROJ); const float* XC = (const float*)(a.ws + WS_CS); const float* DT = (const float*)(a.ws + WS_DT);
    bf16* YC = (bf16*)(a.ws + WS_H);
    LAS float* sBC = (LAS float*)lds; LAS float* red = (LAS float*)(lds + 1024);
    float st[128];
#pragma unroll
    for (int n = 0; n < 128; ++n) st[n] = 0.f;
    const float av = -__expf(a.a_log[h]), dtb = a.dt_bias[h], dsk = a.d_skip[h], gain = a.ssd_norm_gain[g * 256 + hl * 64 + p];
    for (int t = 0; t < SEQ; ++t) {
        const size_t m = (size_t)b * SEQ + t;
        if (act) sBC[tid] = XC[m * 1024 + (tid < 128 ? 512 + g * 128 + tid : 768 + g * 128 + (tid - 128))];
        __syncthreads();
        float y = 0.f;
        if (act) {
            const float dt = softplusf(DT[m * 8 + h] + dtb), dA = __expf(dt * av), xv = XC[m * 1024 + h * 64 + p], dx = dt * xv;
#pragma unroll
            for (int n = 0; n < 128; ++n) { st[n] = st[n] * dA + dx * sBC[n]; y += sBC[128 + n] * st[n]; }
            y += dsk * xv;
            y *= siluf(bf2f(PROJ[m * N1 + PZ + h * 64 + p]));
        }
        const float ss = wave_sum(y * y);
        if (lane == 0) red[wave] = ss;
        __syncthreads();
        const float tot = (red[0] + red[1]) + (red[2] + red[3]);
        if (act) YC[m * 1024 + h * 64 + p] = (bf16)f2bf(y * rsqrtf(tot * (1.f / 256.f) + EPS) * gain);
    }
}

__device__ __forceinline__ void phase_attn_naive(const Args& a, LAS unsigned char* lds) {
    const int tid = threadIdx.x;
    const bf16* PROJ = (const bf16*)(a.ws + WS_PROJ); bf16* YC = (bf16*)(a.ws + WS_H);
    LAS float* sK = (LAS float*)(lds + 4096); LAS float* sV = (LAS float*)(lds + 4096 + 16384);
    for (int unit = blockIdx.x; unit < 256; unit += gridDim.x) {
        const int b = unit >> 5, h = (unit >> 2) & 7, qb = unit & 3;
        const int t = qb * 512 + tid; const size_t m = (size_t)b * SEQ + t;
        float q[64], o[64];
#pragma unroll
        for (int d = 0; d < 64; ++d) { q[d] = bf2f(PROJ[m * N1 + PQ + h * 64 + d]); o[d] = 0.f; }
        float P = 1.f;
        for (int kt = qb * 8 + 7; kt >= 0; --kt) {
            __syncthreads();
#pragma unroll
            for (int i = 0; i < 8; ++i) { const int idx = tid + 512 * i, key = idx >> 6, d = idx & 63; const size_t mk = (size_t)b * SEQ + kt * 64 + key;
                sK[idx] = bf2f(PROJ[mk * N1 + PK + h * 64 + d]); sV[idx] = bf2f(PROJ[mk * N1 + PV + h * 64 + d]); }
            __syncthreads();
            for (int kk = 63; kk >= 0; --kk) {
                const int s = kt * 64 + kk;
                if (s < t) {
                    float z = 0.f;
#pragma unroll
                    for (int d = 0; d < 64; ++d) z += q[d] * sK[kk * 64 + d];
                    z = fminf(z, 100.f);
                    const float e = exp2f(z), r = 1.f / (1.f + e);
                    P *= r;
                    const float w = e * P;
#pragma unroll
                    for (int d = 0; d < 64; ++d) o[d] += w * sV[kk * 64 + d];
                }
            }
        }
        float ss = 0.f;
#pragma unroll
        for (int d = 0; d < 64; ++d) ss += o[d] * o[d];
        const float rstd = rsqrtf(ss * (1.f / 64.f) + EPS);
#pragma unroll
        for (int d = 0; d < 64; ++d) YC[m * 1024 + 512 + h * 64 + d] = (bf16)f2bf(o[d] * rstd * a.sb_norm_gain[h * 64 + d]);
    }
}


typedef short v4i16 __attribute__((ext_vector_type(4)));
typedef short bf16x8v __attribute__((ext_vector_type(8)));
constexpr int AT_KSTR = 144, AT_KBYTES = 64 * AT_KSTR, AT_VBYTES = 64 * 128, AT_BUF = AT_KBYTES + AT_VBYTES;
#define MFMA32(a, b, c) __builtin_amdgcn_mfma_f32_32x32x16_bf16((a), (b), (c), 0, 0, 0)

template <bool DIAG>
__device__ __forceinline__ void attn_tile(LAS const unsigned char* Kb, LAS const unsigned char* Vb, const bf16x8v (&qf)[4], f32x16& o0, f32x16& o1, float& carry,
                                          int qrel, int l32, int hh, unsigned vbase0, unsigned vbase1) {
    f32x16 p[2];
    bf16x8v kf[2][4];
#pragma unroll
    for (int blk = 0; blk < 2; ++blk)
#pragma unroll
        for (int s = 0; s < 4; ++s) kf[blk][s] = *(LAS const bf16x8v*)(Kb + (32 * blk + l32) * AT_KSTR + 32 * s + 16 * hh);
    asm volatile("s_waitcnt lgkmcnt(0)" ::: "memory");
#pragma unroll
    for (int bi = 0; bi < 2; ++bi) {
        const int blk = 1 - bi;
#pragma unroll
        for (int i = 0; i < 16; ++i) p[blk][i] = 0.f;
#pragma unroll
        for (int s = 0; s < 4; ++s) p[blk] = MFMA32(kf[blk][s], qf[s], p[blk]);
    }
#pragma unroll
    for (int bi = 0; bi < 2; ++bi) {
        const int blk = 1 - bi;
        float R[16];
#pragma unroll
        for (int i = 0; i < 16; ++i) {
            float rv = __builtin_amdgcn_rcpf(1.f + __builtin_amdgcn_exp2f(p[blk][i]));
            if (DIAG) { const int krel = 32 * blk + (i & 3) + 8 * (i >> 2) + 4 * hh; if (krel >= qrel) rv = 1.f; }
            R[i] = rv;
        }
        float GG[4], sel[4];
#pragma unroll
        for (int g = 0; g < 4; ++g) { R[4 * g + 2] *= R[4 * g + 3]; R[4 * g + 1] *= R[4 * g + 2]; R[4 * g] *= R[4 * g + 1]; }
#pragma unroll
        for (int g = 0; g < 4; g += 2) {
            const unsigned ua = __builtin_bit_cast(unsigned, R[4 * g]), ub = __builtin_bit_cast(unsigned, R[4 * g + 4]);
            auto s1 = __builtin_amdgcn_permlane32_swap(ua, ub, false, false);
            auto s2 = __builtin_amdgcn_permlane32_swap(ub, ua, false, false);
            const float pa = __builtin_bit_cast(float, hh ? s2[0] : s1[1]), pb2 = __builtin_bit_cast(float, hh ? s1[0] : s2[1]);
            GG[g] = R[4 * g] * pa; GG[g + 1] = R[4 * g + 4] * pb2;
            sel[g] = hh ? 1.f : pa; sel[g + 1] = hh ? 1.f : pb2;
        }
        float T3 = carry, T2 = T3 * GG[3], T1 = T2 * GG[2], T0 = T1 * GG[1];
        carry = T0 * GG[0];
        const float base[4] = {T0 * sel[0], T1 * sel[1], T2 * sel[2], T3 * sel[3]};
        float w[16];
#pragma unroll
        for (int g = 0; g < 4; ++g) {
            w[4 * g + 3] = base[g] * (1.f - R[4 * g + 3]); w[4 * g + 2] = base[g] * (R[4 * g + 3] - R[4 * g + 2]);
            w[4 * g + 1] = base[g] * (R[4 * g + 2] - R[4 * g + 1]); w[4 * g] = base[g] * (R[4 * g + 1] - R[4 * g]);
        }
#pragma unroll
        for (int s = 0; s < 2; ++s) {
            v4u pk; pk.x = cvtpk(w[8 * s], w[8 * s + 1]); pk.y = cvtpk(w[8 * s + 2], w[8 * s + 3]); pk.z = cvtpk(w[8 * s + 4], w[8 * s + 5]); pk.w = cvtpk(w[8 * s + 6], w[8 * s + 7]);
            const bf16x8v pb = __builtin_bit_cast(bf16x8v, pk);
            const int rowoff = (32 * blk + 16 * s) * 128;
            const v4i16 a0l = __builtin_amdgcn_ds_read_tr16_b64_v4i16((LAS v4i16*)(Vb + vbase0 + rowoff));
            const v4i16 a0h = __builtin_amdgcn_ds_read_tr16_b64_v4i16((LAS v4i16*)(Vb + vbase0 + rowoff + 8 * 128));
            const v4i16 a1l = __builtin_amdgcn_ds_read_tr16_b64_v4i16((LAS v4i16*)(Vb + vbase1 + rowoff));
            const v4i16 a1h = __builtin_amdgcn_ds_read_tr16_b64_v4i16((LAS v4i16*)(Vb + vbase1 + rowoff + 8 * 128));
            const bf16x8v va0 = __builtin_shufflevector(a0l, a0h, 0, 1, 2, 3, 4, 5, 6, 7), va1 = __builtin_shufflevector(a1l, a1h, 0, 1, 2, 3, 4, 5, 6, 7);
            o0 = MFMA32(va0, pb, o0); o1 = MFMA32(va1, pb, o1);
        }
    }
}

__device__ __forceinline__ void attn_unit(const Args& a, LAS unsigned char* lds, int b, int h, int qb) {
    const int tid = threadIdx.x, lane = tid & 63, w = __builtin_amdgcn_readfirstlane(tid >> 6), l32 = lane & 31, hh = lane >> 5;
    const bf16* PROJ = (const bf16*)(a.ws + WS_PROJ); bf16* YC = (bf16*)(a.ws + WS_H);
    const size_t rowbase = (size_t)b * SEQ;
    const int q0 = qb * 256 + 32 * w, ktd = q0 >> 6, ktmax = 4 * qb + 3, qrel = 32 * (w & 1) + l32;
    bf16x8v qf[4];
    { const bf16* qp = PROJ + (rowbase + q0 + l32) * N1 + PQ + h * 64 + 8 * hh;
#pragma unroll
      for (int s = 0; s < 4; ++s) qf[s] = *(const bf16x8v*)(qp + 16 * s); }
    f32x16 o0, o1;
#pragma unroll
    for (int i = 0; i < 16; ++i) { o0[i] = 0.f; o1[i] = 0.f; }
    float carry = 1.f;
    const int skey = tid >> 3, sc = tid & 7;
    const bf16* kg = PROJ + (rowbase + skey) * N1 + PK + h * 64 + 8 * sc;
    const unsigned kwoff = skey * AT_KSTR + sc * 16, vwoff = AT_KBYTES + skey * 128 + ((sc * 16) ^ (((skey >> 1) & 1) << 6));
    const int gi = (lane >> 4) & 1, q4 = (lane & 15) >> 2, pp = lane & 3;
    const unsigned vb = (4 * hh + q4) * 128 + 32 * gi + 8 * pp, xq = (q4 >> 1) << 6;
    const unsigned vbase0 = vb + xq, vbase1 = vb + (64 ^ xq);
    LAS unsigned* dflag = (LAS unsigned*)(lds + 6 * AT_BUF);
    bool wdone = false;
    const int tlo = ktmax >= 5 ? ktmax - 5 : 0, nwin = ktmax - tlo + 1;
    {
        v4u kr[6], vr[6];
#pragma unroll
        for (int i = 0; i < 6; ++i) if (i < nwin) { const size_t t = (size_t)(tlo + i) * 64 * N1; kr[i] = *(const v4u*)(kg + t); vr[i] = *(const v4u*)(kg + t + (PV - PK)); }
#pragma unroll
        for (int i = 0; i < 6; ++i) if (i < nwin) { *(LAS v4u*)(lds + i * AT_BUF + kwoff) = kr[i]; *(LAS v4u*)(lds + i * AT_BUF + vwoff) = vr[i]; }
    }
    __syncthreads();
#pragma unroll 1
    for (int kt = ktd; kt >= tlo; --kt) {
        if (!wdone) {
            LAS unsigned char* bt = lds + (kt - tlo) * AT_BUF;
            if (kt == ktd) attn_tile<true>(bt, bt + AT_KBYTES, qf, o0, o1, carry, qrel, l32, hh, vbase0, vbase1);
            else attn_tile<false>(bt, bt + AT_KBYTES, qf, o0, o1, carry, qrel, l32, hh, vbase0, vbase1);
            wdone = __builtin_amdgcn_ballot_w64(carry >= 3.5527137e-15f) == 0ull;
        }
    }
    if (lane == 0) dflag[16 + w] = wdone ? 1u : 0u;
    __syncthreads();
    bool alldone;
    { const v4u f0 = *(const LAS v4u*)(dflag + 16), f1 = *(const LAS v4u*)(dflag + 20);
      alldone = __builtin_amdgcn_readfirstlane((f0.x & f0.y & f0.z & f0.w) & (f1.x & f1.y & f1.z & f1.w)) != 0u; }
    if (!alldone && tlo > 0) {
        const int npair = tlo >> 1;
        const bf16* kg2 = kg + (size_t)64 * N1;
        v4u kr0, vr0, kr1, vr1;
        { const size_t t = (size_t)(npair - 1) * 128 * N1;
          kr0 = *(const v4u*)(kg + t); vr0 = *(const v4u*)(kg + t + (PV - PK)); kr1 = *(const v4u*)(kg2 + t); vr1 = *(const v4u*)(kg2 + t + (PV - PK)); }
        *(LAS v4u*)(lds + AT_BUF + kwoff) = kr0; *(LAS v4u*)(lds + AT_BUF + vwoff) = vr0; *(LAS v4u*)(lds + kwoff) = kr1; *(LAS v4u*)(lds + vwoff) = vr1;
        __syncthreads();
        int cur = 0, it = 0;
        for (int pj = npair - 1; pj >= 0; --pj, ++it) {
            if (pj > 0) { const size_t t = (size_t)(pj - 1) * 128 * N1;
                kr0 = *(const v4u*)(kg + t); vr0 = *(const v4u*)(kg + t + (PV - PK)); kr1 = *(const v4u*)(kg2 + t); vr1 = *(const v4u*)(kg2 + t + (PV - PK)); }
            LAS unsigned char* bh = lds + cur * (2 * AT_BUF); LAS unsigned char* bl = bh + AT_BUF;
            if (!wdone) {
                attn_tile<false>(bh, bh + AT_KBYTES, qf, o0, o1, carry, qrel, l32, hh, vbase0, vbase1);
                if (__builtin_amdgcn_ballot_w64(carry >= 3.5527137e-15f) != 0ull)
                    attn_tile<false>(bl, bl + AT_KBYTES, qf, o0, o1, carry, qrel, l32, hh, vbase0, vbase1);
                wdone = __builtin_amdgcn_ballot_w64(carry >= 3.5527137e-15f) == 0ull;
            }
            if (lane == 0) dflag[(it & 1) * 8 + w] = wdone ? 1u : 0u;
            if (pj > 0) { LAS unsigned char* nb = lds + (cur ^ 1) * (2 * AT_BUF);
                *(LAS v4u*)(nb + AT_BUF + kwoff) = kr0; *(LAS v4u*)(nb + AT_BUF + vwoff) = vr0; *(LAS v4u*)(nb + kwoff) = kr1; *(LAS v4u*)(nb + vwoff) = vr1; }
            __syncthreads();
            cur ^= 1;
            const v4u f0 = *(const LAS v4u*)(dflag + (it & 1) * 8), f1 = *(const LAS v4u*)(dflag + (it & 1) * 8 + 4);
            if (__builtin_amdgcn_readfirstlane((f0.x & f0.y & f0.z & f0.w) & (f1.x & f1.y & f1.z & f1.w)) != 0u) break;
        }
    }
    float ss = 0.f;
#pragma unroll
    for (int i = 0; i < 16; ++i) ss += o0[i] * o0[i] + o1[i] * o1[i];
    ss += __shfl_xor(ss, 32);
    const float rstd = rsqrtf(ss * (1.f / 64.f) + EPS);
    bf16* yp = YC + (rowbase + q0 + l32) * 1024 + 512 + h * 64 + 4 * hh;
    const float* gp = a.sb_norm_gain + h * 64 + 4 * hh;
#pragma unroll
    for (int g = 0; g < 4; ++g) {
        const v4f g0 = *(const v4f*)(gp + 8 * g), g1 = *(const v4f*)(gp + 32 + 8 * g);
        v2u s0, s1;
        s0.x = pk2(o0[4 * g] * rstd * g0.x, o0[4 * g + 1] * rstd * g0.y); s0.y = pk2(o0[4 * g + 2] * rstd * g0.z, o0[4 * g + 3] * rstd * g0.w);
        s1.x = pk2(o1[4 * g] * rstd * g1.x, o1[4 * g + 1] * rstd * g1.y); s1.y = pk2(o1[4 * g + 2] * rstd * g1.z, o1[4 * g + 3] * rstd * g1.w);
        *(v2u*)(yp + 8 * g) = s0; *(v2u*)(yp + 32 + 8 * g) = s1;
    }
}

__device__ __forceinline__ void phase_attn(const Args& a, LAS unsigned char* lds) {
    for (int pid = blockIdx.x; pid < 256; pid += gridDim.x) {
        int bh, qp;
        if (gridDim.x == 256) { const int xcd = pid & 7, j = pid >> 3; bh = xcd * 8 + (j >> 2); qp = j & 3; }
        else { bh = pid >> 2; qp = pid & 3; }
        attn_unit(a, lds, bh >> 3, bh & 7, 7 - qp);
        attn_unit(a, lds, bh >> 3, bh & 7, qp);
    }
}

constexpr int SD_DT = 0, SD_ACS = 1024, SD_WB = 2048, SD_X = 4096, SD_XS = 576, SD_B = 40960, SD_BS = 320, SD_C = 61440, SD_Z = 81920, SD_ZS = 528;

__device__ __forceinline__ float ssd_dt_load(const Args& a, int b, int c, int g) {
    const int tid = threadIdx.x;
    if (tid >= 256) return 0.f;
    return ((const float*)(a.ws + WS_DT))[((size_t)b * SEQ + 64 * c + (tid & 63)) * 8 + 4 * g + (tid >> 6)];
}
template <bool S1>
__device__ __forceinline__ void ssd_dt(const Args& a, LAS unsigned char* lds, int b, int c, int g, float dtraw) {
    const int tid = threadIdx.x, lane = tid & 63;
    if (tid < 256) {
        const int hl = tid >> 6, h = 4 * g + hl;
        const float dtv = softplusf(dtraw + a.dt_bias[h]);
        float cs = dtv * (-__expf(a.a_log[h]));
#pragma unroll
        for (int o = 1; o < 64; o <<= 1) { const float t = __shfl_up(cs, o); if (lane >= o) cs += t; }
        ((LAS float*)(lds + SD_DT))[hl * 64 + lane] = dtv;
        ((LAS float*)(lds + SD_ACS))[hl * 64 + lane] = cs;
        if (S1) {
            const float tot = __shfl(cs, 63);
            ((LAS float*)(lds + SD_WB))[hl * 64 + lane] = __expf(tot - cs) * dtv;
            if (lane == 63) ((float*)(a.ws + WS_CD))[((size_t)b * NCH + c) * 8 + h] = __expf(tot);
        }
    }
}

struct ConvIn { unsigned halo[3]; unsigned vin[32]; };
__device__ __forceinline__ void ssd_conv_load(const Args& a, ConvIn& r, int b, int c, int th, int col) {
    const bf16* PROJ = (const bf16*)(a.ws + WS_PROJ);
    const int t0 = 64 * c + 32 * th;
    const bf16* src = PROJ + ((size_t)b * SEQ + t0) * N1 + PX + col;
#pragma unroll
    for (int j = 0; j < 3; ++j) { unsigned v = 0u; if (t0 - 3 + j >= 0) v = *(const unsigned*)(src + (ptrdiff_t)(j - 3) * N1); r.halo[j] = v; }
#pragma unroll
    for (int i = 0; i < 32; ++i) r.vin[i] = *(const unsigned*)(src + (size_t)i * N1);
}
template <bool SCALE, bool LDSOUT = true, bool GOUT = false>
__device__ __forceinline__ void ssd_conv_compute(const Args& a, const ConvIn& r, LAS unsigned char* dst, int dstride, int th, int col, const LAS float* wsc, bf16* gdst = nullptr) {
    float w0[4], w1[4];
#pragma unroll
    for (int j = 0; j < 4; ++j) { w0[j] = a.conv_w[j * 1024 + col]; w1[j] = a.conv_w[j * 1024 + col + 1]; }
    const float b0 = a.conv_b[col], b1 = a.conv_b[col + 1];
    float u0[3], u1[3];
#pragma unroll
    for (int j = 0; j < 3; ++j) { u0[j] = bflo(r.halo[j]); u1[j] = bfhi(r.halo[j]); }
    bf16* gp = GOUT ? gdst + (size_t)(32 * th) * 1024 : nullptr;
#pragma unroll
    for (int i = 0; i < 32; ++i) {
        const unsigned v = r.vin[i];
        const float c0 = bflo(v), c1 = bfhi(v);
        float y0 = b0 + w0[0] * u0[0] + w0[1] * u0[1] + w0[2] * u0[2] + w0[3] * c0;
        float y1 = b1 + w1[0] * u1[0] + w1[1] * u1[1] + w1[2] * u1[2] + w1[3] * c1;
        u0[0] = u0[1]; u0[1] = u0[2]; u0[2] = c0; u1[0] = u1[1]; u1[1] = u1[2]; u1[2] = c1;
        y0 = silu_fast(y0); y1 = silu_fast(y1);
        if (GOUT) { *(unsigned*)gp = pk2(y0, y1); gp += 1024; asm volatile("" : "+v"(gp)); }
        if (SCALE) { const float s = wsc[32 * th + i]; y0 *= s; y1 *= s; }
        if (LDSOUT) *(LAS unsigned*)(dst + (32 * th + i) * dstride) = pk2(y0, y1);
    }
}

__device__ __forceinline__ bf16x8v tr_pair(LAS const unsigned char* p, int rowstride4) {
    const v4i16 lo = __builtin_amdgcn_ds_read_tr16_b64_v4i16((LAS v4i16*)p);
    const v4i16 hi = __builtin_amdgcn_ds_read_tr16_b64_v4i16((LAS v4i16*)(p + rowstride4));
    return __builtin_shufflevector(lo, hi, 0, 1, 2, 3, 4, 5, 6, 7);
}

__device__ __forceinline__ void phase_ssd_s1(const Args& a, LAS unsigned char* lds) {
    const int tid = threadIdx.x, lane = tid & 63, w = __builtin_amdgcn_readfirstlane(tid >> 6), l32 = lane & 31, hh = lane >> 5;
    const int hl = w >> 1, half = w & 1;
    const int gi = (lane >> 4) & 1, q4 = (lane & 15) >> 2, pp = lane & 3;
    bf16* CS = (bf16*)(a.ws + WS_CS);
    ConvIn cin; float dtraw = 0.f;
    const int cp = tid & 255, th = tid >> 8;
    bf16* XC = (bf16*)(a.ws + WS_XC);
#define S1_COL(G) (cp < 128 ? 256 * (G) + 2 * cp : (cp < 192 ? 512 + 128 * (G) + 2 * (cp - 128) : 768 + 128 * (G) + 2 * (cp - 192)))
    if (blockIdx.x < NB * NCH * 2) { const int it0 = blockIdx.x, g0 = it0 & 1, c0 = (it0 >> 1) & (NCH - 1), b0 = it0 >> 6;
        ssd_conv_load(a, cin, b0, c0, th, S1_COL(g0));
        dtraw = ssd_dt_load(a, b0, c0, g0); }
    for (int item = blockIdx.x; item < NB * NCH * 2; item += gridDim.x) {
        const int g = item & 1, c = (item >> 1) & (NCH - 1), b = item >> 6;
        const int ccol = S1_COL(g);
        __syncthreads();
        ssd_dt<true>(a, lds, b, c, g, dtraw);
        __syncthreads();
        { bf16* gdst = XC + ((size_t)b * SEQ + 64 * c) * 1024 + ccol;
          if (cp < 128) ssd_conv_compute<true, true, true>(a, cin, lds + SD_X + 4 * cp, SD_XS, th, ccol, (const LAS float*)(lds + SD_WB) + (cp >> 5) * 64, gdst);
          else if (cp < 192) ssd_conv_compute<false, true, true>(a, cin, lds + SD_B + 4 * (cp - 128), SD_BS, th, ccol, nullptr, gdst);
          else ssd_conv_compute<false, false, true>(a, cin, lds, 0, th, ccol, nullptr, gdst); }
        __syncthreads();
        { const int itn = item + gridDim.x;
          if (itn < NB * NCH * 2) { const int gn = itn & 1, cn = (itn >> 1) & (NCH - 1), bn = itn >> 6;
              ssd_conv_load(a, cin, bn, cn, th, S1_COL(gn));
              dtraw = ssd_dt_load(a, bn, cn, gn); } }
        f32x16 acc[2][2];
#pragma unroll
        for (int i = 0; i < 16; ++i) { acc[0][0][i] = 0.f; acc[0][1][i] = 0.f; acc[1][0][i] = 0.f; acc[1][1][i] = 0.f; }
#pragma unroll
        for (int s = 0; s < 4; ++s) {
            const int l0 = 16 * s + 8 * hh + q4;
            bf16x8v af[2], bfr[2];
#pragma unroll
            for (int nb = 0; nb < 2; ++nb) af[nb] = tr_pair(lds + SD_B + l0 * SD_BS + (32 * (2 * half + nb) + 16 * gi + 4 * pp) * 2, 4 * SD_BS);
#pragma unroll
            for (int pb = 0; pb < 2; ++pb) bfr[pb] = tr_pair(lds + SD_X + l0 * SD_XS + (64 * hl + 32 * pb + 16 * gi + 4 * pp) * 2, 4 * SD_XS);
#pragma unroll
            for (int nb = 0; nb < 2; ++nb)
#pragma unroll
                for (int pb = 0; pb < 2; ++pb) acc[nb][pb] = MFMA32(bfr[pb], af[nb], acc[nb][pb]);
        }
        bf16* dst = CS + ((((size_t)b * NCH + c) * 8 + 4 * g + hl) * 64) * 128;
#pragma unroll
        for (int nb = 0; nb < 2; ++nb)
#pragma unroll
            for (int pb = 0; pb < 2; ++pb)
#pragma unroll
                for (int i = 0; i < 16; ++i) { const int p = 32 * pb + (i & 3) + 8 * (i >> 2) + 4 * hh; dst[p * 128 + 32 * (2 * half + nb) + l32] = (bf16)f2bf(acc[nb][pb][i]); }
    }
}
#undef S1_COL

__device__ __forceinline__ void phase_ssd_s2(const Args& a) {
    const bf16* CS = (const bf16*)(a.ws + WS_CS); const float* CD = (const float*)(a.ws + WS_CD);
    for (int gid = blockIdx.x * NTHR + threadIdx.x; gid < 64 * 2048; gid += gridDim.x * NTHR) {
        const int bh = gid >> 11, e4 = gid & 2047, b = bh >> 3, h = bh & 7;
        const v2u* p = (const v2u*)(CS + (((size_t)b * NCH) * 8 + h) * 8192) + e4;
        const float* cd = CD + (size_t)b * NCH * 8 + h;
        v2u* o = (v2u*)((bf16*)(a.ws + WS_PB) + (((size_t)b * NCH) * 8 + h) * 8192) + e4;
        v4f st = {0.f, 0.f, 0.f, 0.f};
        for (int c0 = 0; c0 < NCH; c0 += 16) {
            v2u v[16]; float d[16];
#pragma unroll
            for (int j = 0; j < 16; ++j) { v[j] = p[(size_t)(c0 + j) * 16384]; d[j] = cd[(c0 + j) * 8]; }
#pragma unroll
            for (int j = 0; j < 16; ++j) { v2u w2; w2.x = cvtpk(st.x, st.y); w2.y = cvtpk(st.z, st.w); wt8(o + (size_t)(c0 + j) * 16384, w2.x, w2.y);
                const v4f vv = {bflo(v[j].x), bfhi(v[j].x), bflo(v[j].y), bfhi(v[j].y)}; st = st * d[j] + vv; }
        }
    }
}

__device__ __forceinline__ void phase_ssd_s3(const Args& a, LAS unsigned char* lds) {
    const int tid = threadIdx.x, lane = tid & 63, w = __builtin_amdgcn_readfirstlane(tid >> 6), l32 = lane & 31, hh = lane >> 5;
    const int hl = w >> 1, half = w & 1;
    const int gi = (lane >> 4) & 1, q4 = (lane & 15) >> 2, pp = lane & 3;
    const bf16* PROJ = (const bf16*)(a.ws + WS_PROJ); bf16* YC = (bf16*)(a.ws + WS_H);
    for (int item = blockIdx.x; item < NB * NCH * 2; item += gridDim.x) {
        const int g = item & 1, c = (item >> 1) & (NCH - 1), b = item >> 6, h = 4 * g + hl;
        const size_t m0 = (size_t)b * SEQ + 64 * c;
        __syncthreads();
        bf16x8v pvf[8][2];
        { const bf16* pvb = (const bf16*)(a.ws + WS_PB) + ((((size_t)b * NCH + c) * 8 + h) * 64 + l32) * 128 + 8 * hh;
#pragma unroll
          for (int s = 0; s < 8; ++s) { pvf[s][0] = *(const bf16x8v*)(pvb + 16 * s); pvf[s][1] = *(const bf16x8v*)(pvb + 32 * 128 + 16 * s); } }
        v4u zr[4], xr[4], br[2], cr[2];
        {
            const bf16* XCm = (const bf16*)(a.ws + WS_XC) + m0 * 1024;
#pragma unroll
            for (int i = 0; i < 4; ++i) { const int id = tid + 512 * i, row = id >> 5, ck = id & 31; xr[i] = *(const v4u*)(XCm + (size_t)row * 1024 + 256 * g + 8 * ck);
                zr[i] = *(const v4u*)(PROJ + (m0 + row) * N1 + PZ + 256 * g + 8 * ck); }
#pragma unroll
            for (int i = 0; i < 2; ++i) { const int id = tid + 512 * i, row = id >> 4, ck = id & 15; br[i] = *(const v4u*)(XCm + (size_t)row * 1024 + 512 + 128 * g + 8 * ck); cr[i] = *(const v4u*)(XCm + (size_t)row * 1024 + 768 + 128 * g + 8 * ck); }
            ssd_dt<false>(a, lds, b, c, g, ssd_dt_load(a, b, c, g));
#pragma unroll
            for (int i = 0; i < 4; ++i) { const int id = tid + 512 * i, row = id >> 5, ck = id & 31; *(LAS v4u*)(lds + SD_X + row * SD_XS + 16 * ck) = xr[i]; *(LAS v4u*)(lds + SD_Z + row * SD_ZS + 16 * ck) = zr[i]; }
#pragma unroll
            for (int i = 0; i < 2; ++i) { const int id = tid + 512 * i, row = id >> 4, ck = id & 15; *(LAS v4u*)(lds + SD_B + row * SD_BS + 16 * ck) = br[i]; *(LAS v4u*)(lds + SD_C + row * SD_BS + 16 * ck) = cr[i]; }
        }
        __syncthreads();
        const int lcol = 32 * half + l32;
        bf16x8v cf[8];
        f32x16 yo[2], yd[2];
#pragma unroll
        for (int i = 0; i < 16; ++i) { yo[0][i] = 0.f; yo[1][i] = 0.f; yd[0][i] = 0.f; yd[1][i] = 0.f; }
#pragma unroll
        for (int s = 0; s < 8; ++s) {
            cf[s] = *(LAS const bf16x8v*)(lds + SD_C + lcol * SD_BS + (16 * s + 8 * hh) * 2);
            yo[0] = MFMA32(pvf[s][0], cf[s], yo[0]); yo[1] = MFMA32(pvf[s][1], cf[s], yo[1]);
        }
        const float acs_l = ((const LAS float*)(lds + SD_ACS))[hl * 64 + lcol];
#pragma unroll
        for (int sb = 0; sb < 2; ++sb) {
            if (sb <= half) {
                f32x16 cb;
#pragma unroll
                for (int i = 0; i < 16; ++i) cb[i] = 0.f;
#pragma unroll
                for (int s = 0; s < 8; ++s) { const bf16x8v bfrag = *(LAS const bf16x8v*)(lds + SD_B + (32 * sb + l32) * SD_BS + (16 * s + 8 * hh) * 2); cb = MFMA32(bfrag, cf[s], cb); }
                float mv[16];
#pragma unroll
                for (int gq = 0; gq < 4; ++gq) {
                    const v4f as4 = *(const LAS v4f*)(lds + SD_ACS + (hl * 64 + 32 * sb + 8 * gq + 4 * hh) * 4), dt4 = *(const LAS v4f*)(lds + SD_DT + (hl * 64 + 32 * sb + 8 * gq + 4 * hh) * 4);
#pragma unroll
                    for (int j = 0; j < 4; ++j) { const int srow = 32 * sb + 8 * gq + 4 * hh + j;
                        const float dec = __expf(fminf(acs_l - as4[j], 0.f)) * dt4[j];
                        mv[4 * gq + j] = (srow <= lcol) ? cb[4 * gq + j] * dec : 0.f; }
                }
#pragma unroll
                for (int k2 = 0; k2 < 2; ++k2) {
                    v4u pk; pk.x = cvtpk(mv[8 * k2], mv[8 * k2 + 1]); pk.y = cvtpk(mv[8 * k2 + 2], mv[8 * k2 + 3]); pk.z = cvtpk(mv[8 * k2 + 4], mv[8 * k2 + 5]); pk.w = cvtpk(mv[8 * k2 + 6], mv[8 * k2 + 7]);
                    const bf16x8v mf = __builtin_bit_cast(bf16x8v, pk);
#pragma unroll
                    for (int pb = 0; pb < 2; ++pb) {
                        const bf16x8v xf = tr_pair(lds + SD_X + (32 * sb + 16 * k2 + 4 * hh + q4) * SD_XS + (64 * hl + 32 * pb + 16 * gi + 4 * pp) * 2, 8 * SD_XS);
                        yd[pb] = MFMA32(xf, mf, yd[pb]);
                    }
                }
            }
        }
        const float eal = __expf(acs_l), dsk = a.d_skip[h];
        float y[2][16]; float ss = 0.f;
#pragma unroll
        for (int pb = 0; pb < 2; ++pb)
#pragma unroll
            for (int gq = 0; gq < 4; ++gq) {
                const int ch = 64 * hl + 32 * pb + 8 * gq + 4 * hh;
                const v2u xv = *(const LAS v2u*)(lds + SD_X + lcol * SD_XS + ch * 2), zv = *(const LAS v2u*)(lds + SD_Z + lcol * SD_ZS + ch * 2);
                const float xs[4] = {bflo(xv.x), bfhi(xv.x), bflo(xv.y), bfhi(xv.y)}, zs[4] = {bflo(zv.x), bfhi(zv.x), bflo(zv.y), bfhi(zv.y)};
#pragma unroll
                for (int j = 0; j < 4; ++j) { float t = yd[pb][4 * gq + j] + yo[pb][4 * gq + j] * eal + dsk * xs[j]; t *= silu_fast(zs[j]); y[pb][4 * gq + j] = t; ss += t * t; }
            }
        ss += __shfl_xor(ss, 32);
        if (hh == 0) ((LAS float*)(lds + SD_WB))[hl * 64 + lcol] = ss;
        __syncthreads();
        const LAS float* sred = (const LAS float*)(lds + SD_WB);
        const float tot = (sred[lcol] + sred[64 + lcol]) + (sred[128 + lcol] + sred[192 + lcol]);
        const float rstd = rsqrtf(tot * (1.f / 256.f) + EPS);
        bf16* yp = YC + (m0 + lcol) * 1024 + 256 * g + 64 * hl + 4 * hh;
        const float* gp = a.ssd_norm_gain + 256 * g + 64 * hl + 4 * hh;
#pragma unroll
        for (int pb = 0; pb < 2; ++pb)
#pragma unroll
            for (int gq = 0; gq < 4; ++gq) {
                const v4f gn = *(const v4f*)(gp + 32 * pb + 8 * gq);
                v2u o; o.x = pk2(y[pb][4 * gq] * rstd * gn.x, y[pb][4 * gq + 1] * rstd * gn.y); o.y = pk2(y[pb][4 * gq + 2] * rstd * gn.z, y[pb][4 * gq + 3] * rstd * gn.w);
                *(v2u*)(yp + 32 * pb + 8 * gq) = o;
            }
    }
}

__device__ __forceinline__ void phase_norm1(const Args& a) {
    const int lane = threadIdx.x & 63, wave = threadIdx.x >> 6, gw = blockIdx.x * NWAVES + wave, NGW = gridDim.x * NWAVES;
    const bf16* MIX = (const bf16*)(a.ws + WS_PROJ); bf16* H = (bf16*)(a.ws + WS_H);
    v4f g1[4], g2[4];
#pragma unroll
    for (int j = 0; j < 4; ++j) { g1[j] = ((const v4f*)a.post_mix_gain)[lane + 64 * j]; g2[j] = ((const v4f*)a.pre_ffn_gain)[lane + 64 * j]; }
    v2u mv[4], mvn[4]; v4f xv[4], xvn[4];
    if (gw < M) {
#pragma unroll
        for (int j = 0; j < 4; ++j) { mv[j] = ((const v2u*)(MIX + (size_t)gw * DM))[lane + 64 * j]; xv[j] = ((const v4f*)(a.x + (size_t)gw * DM))[lane + 64 * j]; }
    }
    for (int m = gw; m < M; m += NGW) {
        const int mn = m + NGW;
        if (mn < M) {
#pragma unroll
            for (int j = 0; j < 4; ++j) { mvn[j] = ((const v2u*)(MIX + (size_t)mn * DM))[lane + 64 * j]; xvn[j] = ((const v4f*)(a.x + (size_t)mn * DM))[lane + 64 * j]; }
        }
        v4f* orow = (v4f*)(a.out + (size_t)m * DM) + lane;
        v4f v[4]; float s = 0.f;
#pragma unroll
        for (int j = 0; j < 4; ++j) { v[j] = (v4f){bflo(mv[j].x), bfhi(mv[j].x), bflo(mv[j].y), bfhi(mv[j].y)}; s += (v[j].x * v[j].x + v[j].y * v[j].y) + (v[j].z * v[j].z + v[j].w * v[j].w); }
        const float rstd = rsqrtf(wave_sum(s) * (1.f / DM) + EPS);
        float s2 = 0.f;
#pragma unroll
        for (int j = 0; j < 4; ++j) { xv[j] = xv[j] + v[j] * rstd * g1[j]; orow[64 * j] = xv[j];
            s2 += (xv[j].x * xv[j].x + xv[j].y * xv[j].y) + (xv[j].z * xv[j].z + xv[j].w * xv[j].w); }
        const float rstd2 = rsqrtf(wave_sum(s2) * (1.f / DM) + EPS);
        unsigned long long* o8 = (unsigned long long*)(H + (size_t)m * DM) + lane;
#pragma unroll
        for (int j = 0; j < 4; ++j) { const v4f hv = xv[j] * rstd2 * g2[j];
            o8[64 * j] = (unsigned long long)pk2(hv.x, hv.y) | ((unsigned long long)pk2(hv.z, hv.w) << 32); }
#pragma unroll
        for (int j = 0; j < 4; ++j) { mv[j] = mvn[j]; xv[j] = xvn[j]; }
    }
}
__device__ __forceinline__ void phase_norm2(const Args& a) {
    const int lane = threadIdx.x & 63, wave = threadIdx.x >> 6, gw = blockIdx.x * NWAVES + wave, NGW = gridDim.x * NWAVES;
    const bf16* F = (const bf16*)(a.ws + WS_CS);
    v4f g1[4];
#pragma unroll
    for (int j = 0; j < 4; ++j) g1[j] = ((const v4f*)a.post_ffn_gain)[lane + 64 * j];
    v2u fv[4], fvn[4]; v4f xv[4], xvn[4];
    if (gw < M) {
#pragma unroll
        for (int j = 0; j < 4; ++j) { fv[j] = ((const v2u*)(F + (size_t)gw * DM))[lane + 64 * j]; xv[j] = ((const v4f*)(a.out + (size_t)gw * DM))[lane + 64 * j]; }
    }
    for (int m = gw; m < M; m += NGW) {
        const int mn = m + NGW;
        if (mn < M) {
#pragma unroll
            for (int j = 0; j < 4; ++j) { fvn[j] = ((const v2u*)(F + (size_t)mn * DM))[lane + 64 * j]; xvn[j] = ((const v4f*)(a.out + (size_t)mn * DM))[lane + 64 * j]; }
        }
        v4f* orow = (v4f*)(a.out + (size_t)m * DM) + lane;
        v4f v[4]; float s = 0.f;
#pragma unroll
        for (int j = 0; j < 4; ++j) { v[j] = (v4f){bflo(fv[j].x), bfhi(fv[j].x), bflo(fv[j].y), bfhi(fv[j].y)}; s += (v[j].x * v[j].x + v[j].y * v[j].y) + (v[j].z * v[j].z + v[j].w * v[j].w); }
        const float rstd = rsqrtf(wave_sum(s) * (1.f / DM) + EPS);
#pragma unroll
        for (int j = 0; j < 4; ++j) orow[64 * j] = xv[j] + v[j] * rstd * g1[j];
#pragma unroll
        for (int j = 0; j < 4; ++j) { fv[j] = fvn[j]; xv[j] = xvn[j]; }
    }
}

#define XB_TMO      128
#define XB_XCNT(j)  (256  + 64 * (j))
#define XB_XSUB(j)  (1280 + 64 * (j))
#define XB_XGEN(j)  (2304 + 64 * (j))
#define XB_TOP      3328
#define XB_TOPGEN   3392
#define XCD_BAR_WORDS 3456
#define XB_SPIN_CAP (1u << 18)

__device__ __forceinline__ unsigned xb_ld(unsigned* p)              { return __hip_atomic_load(p, __ATOMIC_RELAXED, __HIP_MEMORY_SCOPE_AGENT); }
__device__ __forceinline__ unsigned xb_add(unsigned* p, unsigned v) { return __hip_atomic_fetch_add(p, v, __ATOMIC_RELAXED, __HIP_MEMORY_SCOPE_AGENT); }
__device__ __forceinline__ unsigned xb_xcc_id() { return (unsigned)__builtin_amdgcn_s_getreg((3 << 11) | 20) & 0xFu; }
#define XB_SPIN(cond, bar) do { unsigned _sp = 0; while (cond) { __builtin_amdgcn_s_sleep(1); \
    if ((++_sp & 255u) == 0u) { if (xb_ld(&(bar)[XB_TMO])) break; if (_sp > XB_SPIN_CAP) { atomicAdd(&(bar)[XB_TMO], 1u); break; } } } } while (0)

struct XcdBarrier {
    unsigned* bar; unsigned x;
    volatile LAS unsigned* st;
};

__device__ __forceinline__ XcdBarrier xcd_barrier_post(unsigned* bar, volatile LAS unsigned* st) {
    XcdBarrier b; b.bar = bar; b.x = xb_xcc_id(); b.st = st;
    if (threadIdx.x == 0) (void)xb_add(&bar[XB_XCNT(b.x)], 1u);
    return b;
}
__device__ __forceinline__ void xcd_barrier_complete(unsigned* bar, unsigned x, unsigned& nloc, unsigned& nx) {
    const unsigned G = gridDim.x * gridDim.y * gridDim.z;
    unsigned sum, cnt, mine, sp = 0u;
    for (;;) {
        sum = 0u; cnt = 0u; mine = 0u;
#pragma unroll
        for (unsigned j = 0; j < 16; ++j) { const unsigned c = xb_ld(&bar[XB_XCNT(j)]); sum += c; cnt += (c > 0u) ? 1u : 0u; mine = (j == x) ? c : mine; }
        if (sum == G) break;
        __builtin_amdgcn_s_sleep(1);
        if ((++sp & 255u) == 0u) { if (xb_ld(&bar[XB_TMO])) break; if (sp > XB_SPIN_CAP) { atomicAdd(&bar[XB_TMO], 1u); break; } }
    }
    nloc = mine > 0u ? mine : 1u; nx = cnt > 0u ? cnt : 1u;
}

__device__ __forceinline__ void xcd_barrier(const XcdBarrier& b) {
    asm volatile("s_waitcnt vmcnt(0)" ::: "memory");
    __syncthreads();
    if (threadIdx.x == 0) {
        unsigned* bar = b.bar;
        __builtin_amdgcn_s_waitcnt(0);
        unsigned nloc = b.st[0], nx = b.st[1];
        if (nloc == 0u) { xcd_barrier_complete(bar, b.x, nloc, nx); b.st[0] = nloc; b.st[1] = nx; }
        const unsigned old = xb_add(&bar[XB_XSUB(b.x)], 1u);
        const unsigned gen = old / nloc;
        if (old + 1u == (gen + 1u) * nloc) {
            __builtin_amdgcn_fence(__ATOMIC_RELEASE, "agent");
            asm volatile("s_waitcnt vmcnt(0)" ::: "memory");
            const unsigned og = xb_add(&bar[XB_TOP], 1u);
            const unsigned tg = og / nx;
            if (og + 1u == (tg + 1u) * nx) xb_add(&bar[XB_TOPGEN], 1u);
            else XB_SPIN(xb_ld(&bar[XB_TOPGEN]) == tg, bar);
            __builtin_amdgcn_fence(__ATOMIC_ACQUIRE, "agent");
            xb_add(&bar[XB_XGEN(b.x)], 1u);
            asm volatile("s_waitcnt vmcnt(0)" ::: "memory");
        } else {
            XB_SPIN(xb_ld(&bar[XB_XGEN(b.x)]) == gen, bar);
            __builtin_amdgcn_fence(__ATOMIC_ACQUIRE, "agent");
            asm volatile("s_waitcnt vmcnt(0)" ::: "memory");
        }
    }
    __syncthreads();
}


constexpr int NPHASE = 10;
__global__ void __launch_bounds__(NTHR, 2) fwd(Args a) {
    extern __shared__ __attribute__((aligned(16))) unsigned char lds_raw[];
    LAS unsigned char* lds = (LAS unsigned char*)lds_raw;
    const int lo = a.ph_lo, hi = a.ph_hi;
#ifndef REPMASK
#define REPMASK 0
#endif
#define REP(k) for (int _r = 0; _r < (((REPMASK) >> (k)) & 1) + 1; ++_r)
#define IN(k) (lo <= (k) && (k) < hi)
#define SEAM(k) do { if (IN(k) && IN((k) + 1)) xcd_barrier(bar); } while (0)
    unsigned char* ws = a.ws;
    volatile LAS unsigned* misc = (volatile LAS unsigned*)(lds + 131072);
    if (threadIdx.x < 2) misc[threadIdx.x] = 0u;
    __syncthreads();
    XcdBarrier bar = xcd_barrier_post((unsigned*)(ws + WS_CTL), misc);
    if ((REPMASK) & 16384) { for (int i = 0; i < 10; ++i) xcd_barrier(bar); }
    const bool defer_w4 = (gridDim.x == 256) && lo == 0 && hi > 7;
    if (IN(0)) REP(0) { phase_p0(a, lds, defer_w4); __syncthreads(); }
    SEAM(0);
    if (IN(1)) REP(1) { pg8::Gemm g{(const bf16*)(ws + WS_H), (const bf16*)(ws + WS_W1), M, N1, DM}; pg8::StaticOrder S; S.init(M, N1, gridDim.x, blockIdx.x);
        pg8::EpiProj E{(bf16*)(ws + WS_PROJ)}; pg8::gemm_phase<pg8::EpiProj, pg8::StaticOrder, true, true>(lds, g, S, E); }
    SEAM(1);
    if (IN(2)) REP(2) { phase_ssd_s1(a, lds); }
    SEAM(2);
    if (IN(3)) REP(3) { phase_ssd_s2(a); }
    SEAM(3);
    if (IN(4)) { REP(10) { phase_ssd_s3(a, lds); __syncthreads(); } REP(11) { phase_attn(a, lds); __syncthreads(); } }
    SEAM(4);
    const bool fuse_n1 = (gridDim.x == 256) && lo <= 5 && hi > 7;
    if (IN(5)) { pg8::Gemm g{(const bf16*)(ws + WS_H), (const bf16*)(ws + WS_W2), M, DM, DM}; pg8::StaticOrder S; S.init(M, DM, gridDim.x, blockIdx.x);
        if (fuse_n1) {
            pg8::EpiRmsResRms E{a.x, (bf16*)(ws + WS_CS), (bf16*)(ws + WS_PB), a.post_mix_gain, a.pre_ffn_gain, (float*)(ws + WS_CTL + 65536 + 262144), (unsigned*)(ws + WS_CTL + 32768), (float*)(ws + WS_CTL + 65536 + 524288), (unsigned*)(ws + WS_CTL + 49152)};
            pg8::gemm_phase<pg8::EpiRmsResRms, pg8::StaticOrder, false, true>(lds, g, S, E);
        } else {
            pg8::EpiBf16 E{(bf16*)(ws + WS_PROJ), DM}; pg8::gemm_phase<pg8::EpiBf16, pg8::StaticOrder, true, true>(lds, g, S, E);
        }
    }
    if (!fuse_n1) {
    SEAM(5);
    if (IN(6)) REP(6) { phase_norm1(a); }
    }
    SEAM(6);
    if (IN(7)) REP(7) { pg8::Gemm g{(const bf16*)(ws + (fuse_n1 ? WS_PB : WS_H)), (const bf16*)(ws + WS_W3), M, N3, DM}; pg8::StaticOrder S; S.init(M, N3, gridDim.x, blockIdx.x);
        pg8::EpiSwiglu E{(bf16*)(ws + WS_PROJ)}; pg8::gemm_phase<pg8::EpiSwiglu, pg8::StaticOrder, true, true>(lds, g, S, E);
        if (defer_w4) { __syncthreads(); phase_w4(a, lds); } }
    SEAM(7);
    if (IN(8)) { pg8::Gemm g{(const bf16*)(ws + WS_PROJ), (const bf16*)(ws + WS_W4), M, DM, DFF}; pg8::StaticOrder S; S.init(M, DM, gridDim.x, blockIdx.x);
        if (gridDim.x == 256 && hi > 9 && lo <= 5) {
            pg8::EpiRmsRes E{(const bf16*)(ws + WS_CS), a.out, a.post_ffn_gain, (float*)(ws + WS_CTL + 65536), (unsigned*)(ws + WS_CTL + 16384)};
            pg8::gemm_phase<pg8::EpiRmsRes, pg8::StaticOrder, false, true>(lds, g, S, E);
        } else {
            pg8::EpiBf16 E{(bf16*)(ws + WS_CS), DM}; pg8::gemm_phase<pg8::EpiBf16, pg8::StaticOrder, true, true>(lds, g, S, E);
            SEAM(8);
            if (IN(9)) { phase_norm2(a); }
        }
    }
#undef IN
#undef SEAM
}

#ifndef N_LAUNCHES
#define N_LAUNCHES 1
#endif
extern "C" void kernel_launch(void* const* d_in, const int* in_sizes, int n_in, void* d_out, int out_size, void* d_ws, size_t ws_size, hipStream_t stream) {
    static int grid = 0;
    if (grid == 0) {
        if (n_in != 17 || out_size != M * DM || ws_size < WS_END) { fprintf(stderr, "kernel_launch: unexpected problem (n_in %d out %d ws %zu)\n", n_in, out_size, ws_size); grid = -1; return; }
        int dev = 0, cus = 0, per_cu = 0;
        hipGetDevice(&dev); hipDeviceGetAttribute(&cus, hipDeviceAttributeMultiprocessorCount, dev);
        if (hipFuncSetAttribute((const void*)fwd, hipFuncAttributeMaxDynamicSharedMemorySize, LDS_BYTES) != hipSuccess) { fprintf(stderr, "kernel_launch: hipFuncSetAttribute failed\n"); grid = -1; return; }
        if (hipOccupancyMaxActiveBlocksPerMultiprocessor(&per_cu, (const void*)fwd, NTHR, LDS_BYTES) != hipSuccess || per_cu < 1) { fprintf(stderr, "kernel_launch: occupancy query says %d blocks per CU\n", per_cu); per_cu = 1; }
        (void)hipGetLastError();
        grid = cus;
    }
    if (grid < 0) return;
    if (hipMemsetAsync((char*)d_ws + WS_CTL, 0, 65536, stream) != hipSuccess) { fprintf(stderr, "kernel_launch: memset failed\n"); return; }
    Args a{};
    const float** ap = (const float**)&a;
    for (int i = 0; i < 17; ++i) ap[i] = (const float*)d_in[i];
    a.out = (float*)d_out; a.ws = (unsigned char*)d_ws;
#if N_LAUNCHES == 1
    a.ph_lo = 0; a.ph_hi = NPHASE;
    void* args[] = {&a};
    hipError_t e = hipLaunchCooperativeKernel((const void*)fwd, dim3(grid), dim3(NTHR), args, LDS_BYTES, stream);
    if (e != hipSuccess) fprintf(stderr, "cooperative launch failed: %s (grid %d)\n", hipGetErrorString(e), grid);
#else
    for (int ph = 0; ph < NPHASE; ++ph) { a.ph_lo = ph; a.ph_hi = ph + 1; hipLaunchKernelGGL(fwd, dim3(grid), dim3(NTHR), LDS_BYTES, stream, a); }
#endif
}
```

```cpp
#define REPMASK 0
#include <hip/hip_runtime.h>
#include <hip/hip_cooperative_groups.h>
#include <cstdio>
#include <cstdint>
namespace cg = cooperative_groups;
#ifndef REPMASK
#define REPMASK 0
#endif

constexpr int NB = 8, SEQ = 2048, DM = 1024, M = NB * SEQ;
constexpr int DIN = 3080;
constexpr int N1 = 3072;
constexpr int PZ = 0, PX = 512, PQ = 1536, PK = 2048, PV = 2560;
constexpr int DFF = 2816, N3 = 2 * DFF;
constexpr int NH = 8, HD = 64, NST = 128, CH = 64, NCH = SEQ / CH;
constexpr float EPS = 1e-6f;
constexpr float LOG2E = 1.4426950408889634f;
constexpr float QSCALE = 0.125f * LOG2E;

constexpr size_t MiB = 1u << 20;
constexpr size_t WS_W1 = 0, WS_W2 = 6 * MiB, WS_W3 = 8 * MiB, WS_W4 = 19 * MiB;
constexpr size_t WS_DT = 25 * MiB;
constexpr size_t WS_CD = 25 * MiB + 512 * 1024;
constexpr size_t WS_H = 26 * MiB;
constexpr size_t WS_PROJ = 58 * MiB;
constexpr size_t WS_CS = 154 * MiB;
constexpr size_t WS_CTL = 218 * MiB;
constexpr size_t WS_PB = 219 * MiB;
constexpr size_t WS_END = 251 * MiB;

constexpr int LDS_BYTES = 147456;
constexpr int NTHR = 512, NWAVES = 8;

#define LAS __attribute__((address_space(3)))
typedef unsigned short bf16;
typedef unsigned v4u __attribute__((ext_vector_type(4)));
typedef unsigned v2u __attribute__((ext_vector_type(2)));
typedef float v4f __attribute__((ext_vector_type(4)));
typedef float f32x16 __attribute__((ext_vector_type(16)));

__device__ __forceinline__ unsigned f2bf(float f) { unsigned u = __builtin_bit_cast(unsigned, f); return (u + 0x7fffu + ((u >> 16) & 1u)) >> 16; }
typedef float f32x2_t __attribute__((ext_vector_type(2)));
typedef __bf16 bf16x2_t __attribute__((ext_vector_type(2)));
__device__ __forceinline__ unsigned cvtpk(float lo, float hi) { f32x2_t v = {lo, hi}; bf16x2_t b = __builtin_convertvector(v, bf16x2_t); return __builtin_bit_cast(unsigned, b); }
__device__ __forceinline__ unsigned pk2(float lo, float hi) { return cvtpk(lo, hi); }
__device__ __forceinline__ void wt8(void* p, unsigned lo, unsigned hi) { __hip_atomic_store((unsigned long long*)p, (unsigned long long)lo | ((unsigned long long)hi << 32), __ATOMIC_RELAXED, __HIP_MEMORY_SCOPE_AGENT); }
__device__ __forceinline__ __amdgpu_buffer_rsrc_t wt_rsrc(void* base, unsigned bytes) { return __builtin_amdgcn_make_buffer_rsrc(base, 0, (int)bytes, 0x00020000); }
__device__ __forceinline__ void wt16(__amdgpu_buffer_rsrc_t r, unsigned byte_off, v4u v) { __builtin_amdgcn_raw_buffer_store_b128(v, r, (int)byte_off, 0, 16); }
__device__ __forceinline__ float bf2f(unsigned b) { return __builtin_bit_cast(float, b << 16); }
__device__ __forceinline__ float bflo(unsigned w) { return __builtin_bit_cast(float, w << 16); }
__device__ __forceinline__ float bfhi(unsigned w) { return __builtin_bit_cast(float, w & 0xffff0000u); }
__device__ __forceinline__ float wave_sum(float v) {
#pragma unroll
    for (int o = 1; o < 64; o <<= 1) v += __shfl_xor(v, o);
    return v;
}
__device__ __forceinline__ float siluf(float v) { return v / (1.f + __expf(-v)); }
__device__ __forceinline__ float silu_fast(float v) { return v * __builtin_amdgcn_rcpf(1.f + __builtin_amdgcn_exp2f(-LOG2E * v)); }
__device__ __forceinline__ float softplusf(float v) { return fmaxf(v, 0.f) + log1pf(__expf(-fabsf(v))); }

namespace pg8 {
#define PG8_LAS __attribute__((address_space(3)))
typedef unsigned short bf16_t;
typedef short bf16x8 __attribute__((ext_vector_type(8)));
typedef float f32x4 __attribute__((ext_vector_type(4)));
typedef unsigned u32x4 __attribute__((ext_vector_type(4)));
constexpr int BM = 256, BK = 64, HALF = 128, HTB = HALF * BK * 2  , STAGE_BYTES = 8 * HTB, NXCD = 8, WGM = 8;

__host__ __device__ __forceinline__ int lds_byte(int r, int c) { const int st = (r >> 4) * 2 + (c >> 5), rr = r & 15, cc = c & 31, ob = rr * 64 + cc * 2; return st * 1024 + (ob ^ (((ob >> 9) & 1) << 5)); }
__host__ __device__ __forceinline__ void stage_rc(int b, int& R, int& C) { const int st = b / 1024, sb = b % 1024, swz = sb ^ (((sb >> 9) & 1) << 5); R = (st >> 1) * 16 + swz / 64; C = (st & 1) * 32 + (swz % 64) / 2; }
__host__ __device__ __forceinline__ int perm32(int rho) { const int n = rho >> 4, i = rho & 15; return 8 * (i >> 2) + 4 * n + (i & 3); }

struct Unit { int pm, pn; };
struct Gemm { const bf16_t* A; const bf16_t* Bt; int M, N, K; };

struct StaticOrder {
    int nM, nN, nwg, G, c;
    __host__ __device__ void init(int M, int N, int G_, int c_) { nM = M / BM; nN = N / BM; nwg = nM * nN; G = G_; c = c_; }
    __host__ __device__ bool next(int i, Unit& u) const {
        const long L = (long)i * G + c; if (L >= nwg) return false;
        int wgid = (int)L; { const int q = nwg / NXCD, r = nwg % NXCD, xcd = wgid % NXCD, off = wgid / NXCD; wgid = (xcd < r ? xcd * (q + 1) : r * (q + 1) + (xcd - r) * q) + off; }
        const int nig = WGM * nN, gid = wgid / nig, fm = gid * WGM, gsz = (nM - fm) < WGM ? (nM - fm) : WGM;
        u.pm = fm + ((wgid % nig) % gsz); u.pn = (wgid % nig) / gsz; return true;
    }
    __device__ __forceinline__ void a_ready(const Unit&) const {}
    __device__ __forceinline__ void done(const Unit&) const {}
};

__device__ __forceinline__ unsigned cvt_pk_bf16(float lo, float hi) { unsigned r; asm volatile("v_cvt_pk_bf16_f32 %0, %1, %2" : "=v"(r) : "v"(lo), "v"(hi)); return r; }
template <class Epi, class Sched, bool ALIGN_EPI = false, bool SP2 = false>
__device__ __forceinline__ void gemm_phase(PG8_LAS unsigned char* lds, const Gemm g, const Sched& S, const Epi& E) {
    const int tid = threadIdx.x, wid = __builtin_amdgcn_readfirstlane(tid >> 6), lane = tid & 63, wr = wid >> 2, wc = wid & 3, fr = lane & 15, fq = lane >> 4;
    const int K = g.K, nt = K / BK;
    unsigned voffA[2], voffB[2];
#pragma unroll
    for (int i = 0; i < 2; ++i) { int R, C; stage_rc(tid * 16 + i * 8192, R, C); const int Rb = Epi::PERM ? ((R & ~31) + perm32(R & 31)) : R;
        voffA[i] = (unsigned)(R * K + C) * 2u; voffB[i] = (unsigned)(Rb * K + C) * 2u; }
    const size_t kstep = (size_t)(BK * 2);
    const size_t hstep = (size_t)HALF * K * 2;
    const size_t tstep = 2 * hstep;
    const unsigned ldsw = (unsigned)wid * 1024u;
    const int aoff = lds_byte(wr * 64 + fr, fq * 8), boff = lds_byte(wc * 32 + fr, fq * 8);
#define PG8_SA(b, h) (((b) * 2 + (h)) * HTB)
#define PG8_SB(b, h) ((4 + (b) * 2 + (h)) * HTB)
#define PG8_STAGE(bufoff, gbase, voff) do { _Pragma("unroll") for (int _i = 0; _i < 2; ++_i) \
        __builtin_amdgcn_global_load_lds((const unsigned*)((const char*)(gbase) + (voff)[_i]), (PG8_LAS unsigned*)(lds + (bufoff) + ldsw + _i * 8192), 16, 0, 0); } while (0)
#define PG8_LDA(dst, b, h) do { _Pragma("unroll") for (int m = 0; m < 4; ++m) _Pragma("unroll") for (int k = 0; k < 2; ++k) dst[m][k] = *(const PG8_LAS bf16x8*)(lds + PG8_SA(b, h) + aoff + m * 2048 + k * 1024); } while (0)
#define PG8_LDB(dst, b, h) do { _Pragma("unroll") for (int n = 0; n < 2; ++n) _Pragma("unroll") for (int k = 0; k < 2; ++k) dst[n][k] = *(const PG8_LAS bf16x8*)(lds + PG8_SB(b, h) + boff + n * 2048 + k * 1024); } while (0)
#define PG8_MMA(ai, bj, At, Bt) do { __builtin_amdgcn_s_setprio(1); _Pragma("unroll") for (int m = 0; m < 4; ++m) _Pragma("unroll") for (int n = 0; n < 2; ++n) _Pragma("unroll") for (int k = 0; k < 2; ++k) \
        acc[ai][bj][m][n] = __builtin_amdgcn_mfma_f32_16x16x32_bf16(Bt[n][k], At[m][k], acc[ai][bj][m][n], 0, 0, 0); __builtin_amdgcn_s_setprio(0); } while (0)
#define PG8_WAIT_V(n) asm volatile("s_waitcnt vmcnt(" #n ")" ::: "memory")
#define PG8_WAIT_L(n) asm volatile("s_waitcnt lgkmcnt(" #n ")" ::: "memory")
#define PG8_BAR __builtin_amdgcn_s_barrier()
#define PG8_SCHED __builtin_amdgcn_sched_barrier(0)
    Unit cur, nxt; int ui = 0;
    if (!S.next(0, cur)) return;
    f32x4 acc[2][2][4][2];
#pragma unroll
    for (int a = 0; a < 2; ++a)
#pragma unroll
        for (int b = 0; b < 2; ++b)
#pragma unroll
            for (int m = 0; m < 4; ++m)
#pragma unroll
                for (int n = 0; n < 2; ++n) acc[a][b][m][n] = (f32x4){0.f, 0.f, 0.f, 0.f};
    bf16x8 At[4][2], B0[2][2], B1[2][2];
    const char* cA = (const char*)g.A + (size_t)cur.pm * tstep; const char* cB = (const char*)g.Bt + (size_t)cur.pn * tstep;
    S.a_ready(cur);
    if constexpr (SP2) {
        PG8_STAGE(PG8_SB(0, 0), cB, voffB); PG8_STAGE(PG8_SB(0, 1), cB + hstep, voffB); PG8_STAGE(PG8_SA(0, 0), cA, voffA); PG8_STAGE(PG8_SA(0, 1), cA + hstep, voffA);
        if (wr == 1) PG8_BAR;
        PG8_WAIT_V(2); PG8_BAR;
        PG8_STAGE(PG8_SB(1, 0), cB + kstep, voffB); PG8_STAGE(PG8_SA(1, 0), cA + kstep, voffA); PG8_STAGE(PG8_SB(1, 1), cB + hstep + kstep, voffB);
        PG8_WAIT_V(6); PG8_BAR;
    } else {
        PG8_STAGE(PG8_SB(0, 0), cB, voffB); PG8_STAGE(PG8_SA(0, 0), cA, voffA); PG8_STAGE(PG8_SB(0, 1), cB + hstep, voffB); PG8_STAGE(PG8_SA(0, 1), cA + hstep, voffA);
        if (wr == 1) PG8_BAR;
        PG8_WAIT_V(4); PG8_BAR;
        PG8_STAGE(PG8_SB(1, 0), cB + kstep, voffB); PG8_STAGE(PG8_SA(1, 0), cA + kstep, voffA); PG8_STAGE(PG8_SB(1, 1), cB + hstep + kstep, voffB);
        PG8_WAIT_V(6); PG8_BAR;
    }
    for (;;) {
        const bool has_next = S.next(ui + 1, nxt);
        const char* nA = has_next ? (const char*)g.A + (size_t)nxt.pm * tstep : cA; const char* nB = has_next ? (const char*)g.Bt + (size_t)nxt.pn * tstep : cB;
        for (int t = 0; t < nt; t += 2) {
            const bool last = (t == nt - 2);
            const char* a1 = cA + (size_t)(t + 1) * kstep;
            const char* a2 = last ? nA : cA + (size_t)(t + 2) * kstep; const char* b2 = last ? nB : cB + (size_t)(t + 2) * kstep;
            const char* a3 = a2 + kstep; const char* b3 = b2 + kstep;
            if (last && has_next) S.a_ready(nxt);
            if constexpr (SP2) {
            PG8_LDB(B0, 0, 0); PG8_LDB(B1, 0, 1); PG8_SCHED; PG8_LDA(At, 0, 0); PG8_STAGE(PG8_SA(1, 1), a1 + hstep, voffA);
            PG8_WAIT_V(8); PG8_WAIT_L(0); PG8_BAR; PG8_MMA(0, 0, At, B0); PG8_MMA(0, 1, At, B1); PG8_BAR; PG8_SCHED;
            PG8_LDA(At, 0, 1); PG8_STAGE(PG8_SB(0, 0), b2, voffB); PG8_STAGE(PG8_SB(0, 1), b2 + hstep, voffB); PG8_STAGE(PG8_SA(0, 0), a2, voffA);
            PG8_WAIT_V(8); PG8_WAIT_L(0); PG8_BAR; PG8_MMA(1, 0, At, B0); PG8_MMA(1, 1, At, B1); PG8_BAR; PG8_SCHED;
            PG8_LDB(B0, 1, 0); PG8_LDB(B1, 1, 1); PG8_SCHED; PG8_LDA(At, 1, 0); PG8_STAGE(PG8_SA(0, 1), a2 + hstep, voffA);
            PG8_WAIT_V(8); PG8_WAIT_L(0); PG8_BAR; PG8_MMA(0, 0, At, B0); PG8_MMA(0, 1, At, B1); PG8_BAR; PG8_SCHED;
            PG8_LDA(At, 1, 1); PG8_STAGE(PG8_SB(1, 0), b3, voffB); PG8_STAGE(PG8_SB(1, 1), b3 + hstep, voffB); PG8_STAGE(PG8_SA(1, 0), a3, voffA);
            PG8_WAIT_V(8); PG8_WAIT_L(0); PG8_BAR; PG8_MMA(1, 0, At, B0); PG8_MMA(1, 1, At, B1); PG8_BAR; PG8_SCHED;
            } else {
            PG8_LDB(B0, 0, 0); PG8_SCHED; PG8_LDA(At, 0, 0); PG8_STAGE(PG8_SA(1, 1), a1 + hstep, voffA);
            PG8_WAIT_L(8); PG8_BAR; PG8_WAIT_L(0); PG8_MMA(0, 0, At, B0); PG8_BAR; PG8_SCHED;
            PG8_LDB(B1, 0, 1); PG8_STAGE(PG8_SB(0, 0), b2, voffB);
            PG8_BAR; PG8_WAIT_L(0); PG8_MMA(0, 1, At, B1); PG8_BAR;
            PG8_LDA(At, 0, 1); PG8_STAGE(PG8_SA(0, 0), a2, voffA);
            PG8_BAR; PG8_WAIT_L(0); PG8_MMA(1, 0, At, B0); PG8_BAR; PG8_SCHED;
            PG8_STAGE(PG8_SB(0, 1), b2 + hstep, voffB);
            PG8_WAIT_V(6); PG8_BAR; PG8_MMA(1, 1, At, B1); PG8_BAR;
            PG8_LDB(B0, 1, 0); PG8_SCHED; PG8_LDA(At, 1, 0); PG8_STAGE(PG8_SA(0, 1), a2 + hstep, voffA);
            PG8_WAIT_L(8); PG8_BAR; PG8_WAIT_L(0); PG8_MMA(0, 0, At, B0); PG8_BAR; PG8_SCHED;
            PG8_LDB(B1, 1, 1); PG8_STAGE(PG8_SB(1, 0), b3, voffB);
            PG8_BAR; PG8_WAIT_L(0); PG8_MMA(0, 1, At, B1); PG8_BAR;
            PG8_LDA(At, 1, 1); PG8_STAGE(PG8_SA(1, 0), a3, voffA);
            PG8_BAR; PG8_WAIT_L(0); PG8_MMA(1, 0, At, B0); PG8_BAR; PG8_SCHED;
            PG8_STAGE(PG8_SB(1, 1), b3 + hstep, voffB);
            PG8_WAIT_V(6); PG8_BAR; PG8_MMA(1, 1, At, B1); PG8_BAR;
            }
        }
        if constexpr (ALIGN_EPI) { if (wr == 0) PG8_BAR; }
        if constexpr (!Epi::AFTER_DRAIN) { E(acc, cur, wr, wc, fr, fq); S.done(cur); }
        if (!has_next) break;
#pragma unroll
        for (int a = 0; a < 2; ++a)
#pragma unroll
            for (int b = 0; b < 2; ++b)
#pragma unroll
                for (int m = 0; m < 4; ++m)
#pragma unroll
                    for (int n = 0; n < 2; ++n) acc[a][b][m][n] = (f32x4){0.f, 0.f, 0.f, 0.f};
        cur = nxt; cA = nA; cB = nB; ++ui;
        if constexpr (ALIGN_EPI) { if (wr == 1) PG8_BAR; }
    }
    PG8_WAIT_V(0);
    if constexpr (!ALIGN_EPI) { if (wr == 0) PG8_BAR; }
    PG8_BAR;
    if constexpr (Epi::AFTER_DRAIN) { E.fused(acc, cur, wr, wc, fr, fq, lds, wid, lane); S.done(cur); }
#undef PG8_SA
#undef PG8_SB
#undef PG8_STAGE
#undef PG8_LDA
#undef PG8_LDB
#undef PG8_MMA
#undef PG8_WAIT_V
#undef PG8_WAIT_L
#undef PG8_BAR
#undef PG8_SCHED
}
}

namespace pg8 {
struct EpiProj {
    static constexpr bool PERM = true, AFTER_DRAIN = false;
    bf16_t* O;
    __device__ __forceinline__ void operator()(const f32x4 (&acc)[2][2][4][2], const Unit& u, int wr, int wc, int fr, int fq) const {
        const int row0 = u.pm * BM + wr * 64 + fr, col0 = u.pn * BM + wc * 32 + 8 * fq;
        const float sc = (u.pn == 6 || u.pn == 7) ? QSCALE : 1.f;
        const __amdgpu_buffer_rsrc_t rs = wt_rsrc(O, (unsigned)((size_t)16384 * N1 * 2));
#pragma unroll
        for (int ai = 0; ai < 2; ++ai)
#pragma unroll
            for (int m = 0; m < 4; ++m) { const unsigned rowb = (unsigned)(((size_t)(row0 + ai * HALF + m * 16) * N1 + col0) * 2);
#pragma unroll
                for (int bj = 0; bj < 2; ++bj) { const f32x4 v0 = acc[ai][bj][m][0] * sc, v1 = acc[ai][bj][m][1] * sc;
                    u32x4 w; w.x = cvt_pk_bf16(v0[0], v0[1]); w.y = cvt_pk_bf16(v0[2], v0[3]); w.z = cvt_pk_bf16(v1[0], v1[1]); w.w = cvt_pk_bf16(v1[2], v1[3]);
                    wt16(rs, rowb + bj * HALF * 2, w); } }
    }
};
struct EpiBf16 {
    static constexpr bool PERM = true, AFTER_DRAIN = false;
    bf16_t* O; int ldc;
    __device__ __forceinline__ void operator()(const f32x4 (&acc)[2][2][4][2], const Unit& u, int wr, int wc, int fr, int fq) const {
        const int row0 = u.pm * BM + wr * 64 + fr, col0 = u.pn * BM + wc * 32 + 8 * fq;
#pragma unroll
        for (int ai = 0; ai < 2; ++ai)
#pragma unroll
            for (int m = 0; m < 4; ++m) { bf16_t* rowp = O + (size_t)(row0 + ai * HALF + m * 16) * ldc + col0;
#pragma unroll
                for (int bj = 0; bj < 2; ++bj) { const f32x4 v0 = acc[ai][bj][m][0], v1 = acc[ai][bj][m][1];
                    u32x4 w; w.x = cvt_pk_bf16(v0[0], v0[1]); w.y = cvt_pk_bf16(v0[2], v0[3]); w.z = cvt_pk_bf16(v1[0], v1[1]); w.w = cvt_pk_bf16(v1[2], v1[3]);
                    *(u32x4*)(rowp + bj * HALF) = w; } }
    }
};
__device__ __forceinline__ void rms_exchange(const f32x4 (&v)[2][2][4][2], const Unit& u, int wr, int wc, int fr, int fq, PG8_LAS unsigned char* lds, int wid, int lane, float* xbuf, unsigned* cnt) {
    PG8_LAS float* P = (PG8_LAS float*)lds;
    PG8_LAS float* S = (PG8_LAS float*)(lds + 4096);
#pragma unroll
    for (int ai = 0; ai < 2; ++ai)
#pragma unroll
        for (int m = 0; m < 4; ++m) {
            float s = 0.f;
#pragma unroll
            for (int bj = 0; bj < 2; ++bj)
#pragma unroll
                for (int n = 0; n < 2; ++n) { const f32x4 x = v[ai][bj][m][n]; s += (x[0] * x[0] + x[1] * x[1]) + (x[2] * x[2] + x[3] * x[3]); }
            s += __shfl_xor(s, 16); s += __shfl_xor(s, 32);
            if (fq == 0) P[(ai * HALF + wr * 64 + m * 16 + fr) * 4 + wc] = s;
        }
    asm volatile("s_waitcnt lgkmcnt(0)" ::: "memory"); __builtin_amdgcn_s_barrier(); asm volatile("" ::: "memory");
    const int row = wid * 32 + (lane & 31);
    if (lane < 32) {
        const float tot = (P[row * 4 + 0] + P[row * 4 + 1]) + (P[row * 4 + 2] + P[row * 4 + 3]);
        __hip_atomic_store((unsigned*)xbuf + (size_t)(u.pm * BM + row) * 4 + u.pn, __builtin_bit_cast(unsigned, tot), __ATOMIC_RELAXED, __HIP_MEMORY_SCOPE_AGENT);
    }
    asm volatile("s_waitcnt vmcnt(0)" ::: "memory");
    if (lane == 0) __hip_atomic_fetch_add(cnt + 64 * u.pm, 1u, __ATOMIC_RELAXED, __HIP_MEMORY_SCOPE_AGENT);
    if (wid == 0) {
        unsigned sp = 0u;
        while ((unsigned)__builtin_amdgcn_readfirstlane(__hip_atomic_load(cnt + 64 * u.pm, __ATOMIC_RELAXED, __HIP_MEMORY_SCOPE_AGENT)) < 32u) { __builtin_amdgcn_s_sleep(2); if (++sp > (1u << 22)) break; }
        __builtin_amdgcn_fence(__ATOMIC_ACQUIRE, "agent");
    }
    asm volatile("s_waitcnt vmcnt(0) lgkmcnt(0)" ::: "memory"); __builtin_amdgcn_s_barrier(); asm volatile("" ::: "memory");
    if (lane < 32) {
        const unsigned* slot = (const unsigned*)xbuf + (size_t)(u.pm * BM + row) * 4; float q = 0.f;
#pragma unroll
        for (int t = 0; t < 4; ++t) q += __builtin_bit_cast(float, __hip_atomic_load(slot + t, __ATOMIC_RELAXED, __HIP_MEMORY_SCOPE_AGENT));
        S[row] = rsqrtf(q * (1.f / 1024.f) + 1e-6f);
    }
    asm volatile("s_waitcnt vmcnt(0) lgkmcnt(0)" ::: "memory"); __builtin_amdgcn_s_barrier(); asm volatile("" ::: "memory");
}
struct EpiRmsRes {
    static constexpr bool PERM = false, AFTER_DRAIN = true;
    const bf16_t* x1b; float* out; const float* gain; float* xbuf; unsigned* cnt;
    __device__ __forceinline__ void fused(f32x4 (&acc)[2][2][4][2], const Unit& u, int wr, int wc, int fr, int fq, PG8_LAS unsigned char* lds, int wid, int lane) const {
        typedef unsigned u32x2v __attribute__((ext_vector_type(2)));
        const PG8_LAS float* S = (const PG8_LAS float*)(lds + 4096);
        const int col0 = u.pn * BM + wc * 32 + 4 * fq;
        u32x2v pre[2][4][2][2];
#pragma unroll
        for (int ai = 0; ai < 2; ++ai)
#pragma unroll
            for (int m = 0; m < 4; ++m) { const size_t off = (size_t)(u.pm * BM + ai * HALF + wr * 64 + m * 16 + fr) * 1024 + col0;
#pragma unroll
                for (int bj = 0; bj < 2; ++bj)
#pragma unroll
                    for (int n = 0; n < 2; ++n) pre[ai][m][bj][n] = *(const u32x2v*)(x1b + off + bj * HALF + n * 16); }
        rms_exchange(acc, u, wr, wc, fr, fq, lds, wid, lane, xbuf, cnt);
        f32x4 gv[2][2];
#pragma unroll
        for (int bj = 0; bj < 2; ++bj)
#pragma unroll
            for (int n = 0; n < 2; ++n) gv[bj][n] = *(const f32x4*)(gain + col0 + bj * HALF + n * 16);
#pragma unroll
        for (int ai = 0; ai < 2; ++ai)
#pragma unroll
            for (int m = 0; m < 4; ++m) { const int r = ai * HALF + wr * 64 + m * 16 + fr; const float rs = S[r]; const size_t off = (size_t)(u.pm * BM + r) * 1024 + col0;
#pragma unroll
                for (int bj = 0; bj < 2; ++bj)
#pragma unroll
                    for (int n = 0; n < 2; ++n) { const u32x2v pv = pre[ai][m][bj][n];
                        const f32x4 bs = {__builtin_bit_cast(float, pv.x << 16), __builtin_bit_cast(float, pv.x & 0xffff0000u), __builtin_bit_cast(float, pv.y << 16), __builtin_bit_cast(float, pv.y & 0xffff0000u)};
                        *(f32x4*)(out + off + bj * HALF + n * 16) = bs + acc[ai][bj][m][n] * rs * gv[bj][n]; } }
    }
};
struct EpiRmsResRms {
    static constexpr bool PERM = false, AFTER_DRAIN = true;
    const float* x; bf16_t* x1b; bf16_t* h2; const float* g1; const float* g2; float* xbuf1; unsigned* cnt1; float* xbuf2; unsigned* cnt2;
    __device__ __forceinline__ void fused(f32x4 (&acc)[2][2][4][2], const Unit& u, int wr, int wc, int fr, int fq, PG8_LAS unsigned char* lds, int wid, int lane) const {
        typedef unsigned u32x2v __attribute__((ext_vector_type(2)));
        const PG8_LAS float* S = (const PG8_LAS float*)(lds + 4096);
        const int col0 = u.pn * BM + wc * 32 + 4 * fq;
        rms_exchange(acc, u, wr, wc, fr, fq, lds, wid, lane, xbuf1, cnt1);
        {
            f32x4 gv[2][2];
#pragma unroll
            for (int bj = 0; bj < 2; ++bj)
#pragma unroll
                for (int n = 0; n < 2; ++n) gv[bj][n] = *(const f32x4*)(g1 + col0 + bj * HALF + n * 16);
#pragma unroll
            for (int ai = 0; ai < 2; ++ai)
#pragma unroll
                for (int m = 0; m < 4; ++m) { const int r = ai * HALF + wr * 64 + m * 16 + fr; const float rs = S[r]; const size_t off = (size_t)(u.pm * BM + r) * 1024 + col0;
#pragma unroll
                    for (int bj = 0; bj < 2; ++bj)
#pragma unroll
                        for (int n = 0; n < 2; ++n) { const f32x4 bs = *(const f32x4*)(x + off + bj * HALF + n * 16); acc[ai][bj][m][n] = bs + acc[ai][bj][m][n] * rs * gv[bj][n]; }
                    asm volatile("" : "+v"(acc[ai][0][m][0]), "+v"(acc[ai][0][m][1]), "+v"(acc[ai][1][m][0]), "+v"(acc[ai][1][m][1]));
                    if (m & 1) asm volatile("" ::: "memory"); }
        }
        rms_exchange(acc, u, wr, wc, fr, fq, lds, wid, lane, xbuf2, cnt2);
        f32x4 gv[2][2];
#pragma unroll
        for (int bj = 0; bj < 2; ++bj)
#pragma unroll
            for (int n = 0; n < 2; ++n) gv[bj][n] = *(const f32x4*)(g2 + col0 + bj * HALF + n * 16);
#pragma unroll
        for (int ai = 0; ai < 2; ++ai)
#pragma unroll
            for (int m = 0; m < 4; ++m) { const int r = ai * HALF + wr * 64 + m * 16 + fr; const float rs = S[r]; const size_t off = (size_t)(u.pm * BM + r) * 1024 + col0;
#pragma unroll
                for (int bj = 0; bj < 2; ++bj)
#pragma unroll
                    for (int n = 0; n < 2; ++n) { const f32x4 x1 = acc[ai][bj][m][n]; { u32x2v xw; xw.x = cvt_pk_bf16(x1[0], x1[1]); xw.y = cvt_pk_bf16(x1[2], x1[3]); *(u32x2v*)(x1b + off + bj * HALF + n * 16) = xw; }
                        const f32x4 o = x1 * rs * gv[bj][n]; u32x2v w; w.x = cvt_pk_bf16(o[0], o[1]); w.y = cvt_pk_bf16(o[2], o[3]); *(u32x2v*)(h2 + off + bj * HALF + n * 16) = w; }
                asm volatile("" ::: "memory"); }
    }
};
struct EpiF32 {
    static constexpr bool PERM = true, AFTER_DRAIN = false;
    float* O; int ldc;
    __device__ __forceinline__ void operator()(const f32x4 (&acc)[2][2][4][2], const Unit& u, int wr, int wc, int fr, int fq) const {
        const int row0 = u.pm * BM + wr * 64 + fr, col0 = u.pn * BM + wc * 32 + 8 * fq;
#pragma unroll
        for (int ai = 0; ai < 2; ++ai)
#pragma unroll
            for (int m = 0; m < 4; ++m) { float* rowp = O + (size_t)(row0 + ai * HALF + m * 16) * ldc + col0;
#pragma unroll
                for (int bj = 0; bj < 2; ++bj) { *(f32x4*)(rowp + bj * HALF) = acc[ai][bj][m][0]; *(f32x4*)(rowp + bj * HALF + 4) = acc[ai][bj][m][1]; } }
    }
};
struct EpiSwiglu {
    static constexpr bool PERM = true, AFTER_DRAIN = false;
    bf16_t* O;
    __device__ __forceinline__ void operator()(const f32x4 (&acc)[2][2][4][2], const Unit& u, int wr, int wc, int fr, int fq) const {
        const int row0 = u.pm * BM + wr * 64 + fr, col0 = u.pn * HALF + wc * 32 + 8 * fq;
        const __amdgpu_buffer_rsrc_t rs = wt_rsrc(O, (unsigned)((size_t)16384 * DFF * 2));
#pragma unroll
        for (int ai = 0; ai < 2; ++ai)
#pragma unroll
            for (int m = 0; m < 4; ++m) { const unsigned rowb = (unsigned)(((size_t)(row0 + ai * HALF + m * 16) * DFF + col0) * 2);
                float r[8];
#pragma unroll
                for (int n = 0; n < 2; ++n)
#pragma unroll
                    for (int e = 0; e < 4; ++e) { const float g = acc[ai][0][m][n][e], up = acc[ai][1][m][n][e];
                        r[4 * n + e] = g * __builtin_amdgcn_rcpf(1.f + __expf(-g)) * up; }
                u32x4 w; w.x = cvt_pk_bf16(r[0], r[1]); w.y = cvt_pk_bf16(r[2], r[3]); w.z = cvt_pk_bf16(r[4], r[5]); w.w = cvt_pk_bf16(r[6], r[7]);
                wt16(rs, rowb, w); }
    }
};
}

struct Args {
    const float* x; const float* pre_mix_gain; const float* w_in; const float* conv_w; const float* conv_b; const float* dt_bias; const float* a_log; const float* d_skip;
    const float* ssd_norm_gain; const float* sb_norm_gain; const float* w_out; const float* post_mix_gain; const float* pre_ffn_gain; const float* w_gate; const float* w_up;
    const float* w_down; const float* post_ffn_gain; float* out; unsigned char* ws; int ph_lo, ph_hi;
};

__device__ __forceinline__ void transpose_item(const float* src, int ldw, bf16* dst, int K, LAS float* scr, int lane, __amdgpu_buffer_rsrc_t wr, const bf16* wbase) {
    float tv[32];
#pragma unroll
    for (int i = 0; i < 32; ++i) tv[i] = src[(size_t)(2 * i + (lane >> 5)) * ldw + (lane & 31)];
#pragma unroll
    for (int i = 0; i < 32; ++i) scr[(2 * i + (lane >> 5)) * 33 + (lane & 31)] = tv[i];
    asm volatile("s_waitcnt lgkmcnt(0)" ::: "memory");
    const int c = lane & 7;
#pragma unroll
    for (int j = 0; j < 4; ++j) { const int n = (lane >> 3) + 8 * j; const LAS float* s = scr + (8 * c) * 33 + n;
        v4u o; o.x = pk2(s[0 * 33], s[1 * 33]); o.y = pk2(s[2 * 33], s[3 * 33]); o.z = pk2(s[4 * 33], s[5 * 33]); o.w = pk2(s[6 * 33], s[7 * 33]);
        wt16(wr, (unsigned)((dst + (size_t)n * K + 8 * c - wbase) * 2), o); }
    asm volatile("s_waitcnt lgkmcnt(0)" ::: "memory");
}

__device__ __forceinline__ void phase_p0(const Args& a, LAS unsigned char* lds, bool defer_w4) {
    const int tid = threadIdx.x, lane = tid & 63, wave = tid >> 6;
    const int gw = blockIdx.x * NWAVES + wave, NGW = gridDim.x * NWAVES;
    unsigned char* ws = a.ws;
    LAS float* scr = (LAS float*)(lds + wave * 8704);
    LAS float* wdt = (LAS float*)(lds + 73728);
    for (int i = tid; i < 8192; i += NTHR) { const int hd = i & 7, k = i >> 3; wdt[hd * 1024 + k] = a.w_in[(size_t)k * DIN + 1536 + hd]; }
    __syncthreads();
    bf16* W1 = (bf16*)(ws + WS_W1); bf16* W2 = (bf16*)(ws + WS_W2); bf16* W3 = (bf16*)(ws + WS_W3); bf16* W4 = (bf16*)(ws + WS_W4);
    const __amdgpu_buffer_rsrc_t wrs = wt_rsrc(W1, 25u << 20);
    constexpr int I1 = 16 * 48, I2 = 16 * 32, I3 = 16 * 88, I4 = 44 * 32;
    const int NITEMS = 2 * I1 + I2 + 2 * I3 + (defer_w4 ? 0 : I4);
    for (int _rp = 0; _rp < 1 + (((REPMASK) >> 12) & 1); ++_rp)
    for (int it = gw; it < NITEMS; it += NGW) {
        int r = it;
        if (r < I1) { const int kb = r / 48, nb = r % 48; transpose_item(a.w_in + (size_t)(64 * kb) * DIN + 32 * nb, DIN, W1 + (size_t)(32 * nb) * 1024 + 64 * kb, 1024, scr, lane, wrs, W1); continue; } r -= I1;
        if (r < I1) { const int kb = r / 48, nb = r % 48; transpose_item(a.w_in + (size_t)(64 * kb) * DIN + 1544 + 32 * nb, DIN, W1 + (size_t)(1536 + 32 * nb) * 1024 + 64 * kb, 1024, scr, lane, wrs, W1); continue; } r -= I1;
        if (r < I2) { const int kb = r / 32, nb = r % 32; transpose_item(a.w_out + (size_t)(64 * kb) * 1024 + 32 * nb, 1024, W2 + (size_t)(32 * nb) * 1024 + 64 * kb, 1024, scr, lane, wrs, W1); continue; } r -= I2;
        if (r < I3) { const int kb = r / 88, nb = r % 88, n0 = 32 * nb; transpose_item(a.w_gate + (size_t)(64 * kb) * DFF + n0, DFF, W3 + (size_t)(256 * (n0 >> 7) + (n0 & 127)) * 1024 + 64 * kb, 1024, scr, lane, wrs, W1); continue; } r -= I3;
        if (r < I3) { const int kb = r / 88, nb = r % 88, n0 = 32 * nb; transpose_item(a.w_up + (size_t)(64 * kb) * DFF + n0, DFF, W3 + (size_t)(256 * (n0 >> 7) + 128 + (n0 & 127)) * 1024 + 64 * kb, 1024, scr, lane, wrs, W1); continue; } r -= I3;
        { const int kb = r / 32, nb = r % 32; transpose_item(a.w_down + (size_t)(64 * kb) * 1024 + 32 * nb, 1024, W4 + (size_t)(32 * nb) * DFF + 64 * kb, DFF, scr, lane, wrs, W1); }
    }
    bf16* H = (bf16*)(ws + WS_H); float* DT = (float*)(ws + WS_DT);
    const int hh = lane >> 5, b4 = (lane >> 4) & 1, b3 = (lane >> 3) & 1;
    v4f gpm[4];
#pragma unroll
    for (int j = 0; j < 4; ++j) gpm[j] = ((const v4f*)a.pre_mix_gain)[lane + 64 * j];
    v4f v[4], vn[4];
    if (gw < M) {
#pragma unroll
        for (int j = 0; j < 4; ++j) v[j] = ((const v4f*)(a.x + (size_t)gw * DM))[lane + 64 * j];
    }
    for (int _rq = 0; _rq < 1 + (((REPMASK) >> 13) & 1); ++_rq)
    for (int m = gw; m < M; m += NGW) {
        const int mn = m + NGW < M ? m + NGW : gw;
        if (true) {
#pragma unroll
            for (int j = 0; j < 4; ++j) vn[j] = ((const v4f*)(a.x + (size_t)mn * DM))[lane + 64 * j];
        }
        float s = 0.f;
#pragma unroll
        for (int j = 0; j < 4; ++j) s += (v[j].x * v[j].x + v[j].y * v[j].y) + (v[j].z * v[j].z + v[j].w * v[j].w);
        const float rstd = rsqrtf(wave_sum(s) * (1.f / DM) + EPS);
        float da[8];
#pragma unroll
        for (int hd = 0; hd < 8; ++hd) da[hd] = 0.f;
        unsigned long long* o8 = (unsigned long long*)(H + (size_t)m * DM) + lane;
#pragma unroll
        for (int j = 0; j < 4; ++j) {
            const v4f hv = v[j] * rstd * gpm[j];
            wt8(o8 + 64 * j, pk2(hv.x, hv.y), pk2(hv.z, hv.w));
#pragma unroll
            for (int hd = 0; hd < 8; ++hd) { const v4f w = *(const LAS v4f*)(wdt + hd * 1024 + 4 * lane + 256 * j); da[hd] += (hv.x * w.x + hv.y * w.y) + (hv.z * w.z + hv.w * w.w); }
        }
        float k4[4], k2[2], k1;
#pragma unroll
        for (int i = 0; i < 4; ++i) { const float keep = hh ? da[4 + i] : da[i], send = hh ? da[i] : da[4 + i]; k4[i] = keep + __shfl_xor(send, 32); }
#pragma unroll
        for (int i = 0; i < 2; ++i) { const float keep = b4 ? k4[2 + i] : k4[i], send = b4 ? k4[i] : k4[2 + i]; k2[i] = keep + __shfl_xor(send, 16); }
        { const float keep = b3 ? k2[1] : k2[0], send = b3 ? k2[0] : k2[1]; k1 = keep + __shfl_xor(send, 8); }
        k1 += __shfl_xor(k1, 4); k1 += __shfl_xor(k1, 2); k1 += __shfl_xor(k1, 1);
        if ((lane & 7) == 0) DT[(size_t)m * 8 + (lane >> 3)] = k1;
#pragma unroll
        for (int j = 0; j < 4; ++j) v[j] = vn[j];
    }
}

__device__ __forceinline__ void phase_w4(const Args& a, LAS unsigned char* lds) {
    if (blockIdx.x < 128) return;
    const int lane = threadIdx.x & 63, wave = threadIdx.x >> 6, gw = (blockIdx.x - 128) * NWAVES + wave, NGW = 128 * NWAVES;
    LAS float* scr = (LAS float*)(lds + wave * 8704);
    bf16* W1 = (bf16*)(a.ws + WS_W1); bf16* W4 = (bf16*)(a.ws + WS_W4);
    const __amdgpu_buffer_rsrc_t wrs = wt_rsrc(W1, 25u << 20);
    for (int r = gw; r < 44 * 32; r += NGW) { const int kb = r / 32, nb = r % 32; transpose_item(a.w_down + (size_t)(64 * kb) * 1024 + 32 * nb, 1024, W4 + (size_t)(32 * nb) * DFF + 64 * kb, DFF, scr, lane, wrs, W1); }
}

__device__ __forceinline__ void phase_conv_naive(const Args& a) {
    const bf16* PROJ = (const bf16*)(a.ws + WS_PROJ); float* XC = (float*)(a.ws + WS_CS);
    const size_t total = (size_t)M * 1024, stride = (size_t)gridDim.x * NTHR;
    for (size_t idx = (size_t)blockIdx.x * NTHR + threadIdx.x; idx < total; idx += stride) {
        const int m = (int)(idx >> 10), ch = (int)(idx & 1023), t = m & (SEQ - 1);
        float acc = a.conv_b[ch];
#pragma unroll
        for (int j = 0; j < 4; ++j) { const int tt = t - 3 + j; if (tt >= 0) acc += a.conv_w[j * 1024 + ch] * bf2f(PROJ[(size_t)(m - 3 + j) * N1 + PX + ch]); }
        XC[idx] = siluf(acc);
    }
}

__device__ __forceinline__ void phase_ssd_naive(const Args& a, LAS unsigned char* lds) {
    if (blockIdx.x >= 16) return;
    const int tid = threadIdx.x, lane = tid & 63, wave = tid >> 6;
    const int b = blockIdx.x >> 1, g = blockIdx.x & 1;
    const bool act = tid < 256;
    const int hl = (tid >> 6) & 3, p = tid & 63, h = 4 * g + hl;
    const bf16* PROJ = (const bf16*)(a.ws + WS_PROJ); const float* XC = (const float*)(a.ws + WS_CS); const float* DT = (const float*)(a.ws + WS_DT);
    bf16* YC = (bf16*)(a.ws + WS_H);
    LAS float* sBC = (LAS float*)lds; LAS float* red = (LAS float*)(lds + 1024);
    float st[128];
#pragma unroll
    for (int n = 0; n < 128; ++n) st[n] = 0.f;
    const float av = -__expf(a.a_log[h]), dtb = a.dt_bias[h], dsk = a.d_skip[h], gain = a.ssd_norm_gain[g * 256 + hl * 64 + p];
    for (int t = 0; t < SEQ; ++t) {
        const size_t m = (size_t)b * SEQ + t;
        if (act) sBC[tid] = XC[m * 1024 + (tid < 128 ? 512 + g * 128 + tid : 768 + g * 128 + (tid - 128))];
        __syncthreads();
        float y = 0.f;
        if (act) {
            const float dt = softplusf(DT[m * 8 + h] + dtb), dA = __expf(dt * av), xv = XC[m * 1024 + h * 64 + p], dx = dt * xv;
#pragma unroll
            for (int n = 0; n < 128; ++n) { st[n] = st[n] * dA + dx * sBC[n]; y += sBC[128 + n] * st[n]; }
            y += dsk * xv;
            y *= siluf(bf2f(PROJ[m * N1 + PZ + h * 64 + p]));
        }
        const float ss = wave_sum(y * y);
        if (lane == 0) red[wave] = ss;
        __syncthreads();
        const float tot = (red[0] + red[1]) + (red[2] + red[3]);
        if (act) YC[m * 1024 + h * 64 + p] = (bf16)f2bf(y * rsqrtf(tot * (1.f / 256.f) + EPS) * gain);
    }
}

__device__ __forceinline__ void phase_attn_naive(const Args& a, LAS unsigned char* lds) {
    const int tid = threadIdx.x;
    const bf16* PROJ = (const bf16*)(a.ws + WS_PROJ); bf16* YC = (bf16*)(a.ws + WS_H);
    LAS float* sK = (LAS float*)(lds + 4096); LAS float* sV = (LAS float*)(lds + 4096 + 16384);
    for (int unit = blockIdx.x; unit < 256; unit += gridDim.x) {
        const int b = unit >> 5, h = (unit >> 2) & 7, qb = unit & 3;
        const int t = qb * 512 + tid; const size_t m = (size_t)b * SEQ + t;
        float q[64], o[64];
#pragma unroll
        for (int d = 0; d < 64; ++d) { q[d] = bf2f(PROJ[m * N1 + PQ + h * 64 + d]); o[d] = 0.f; }
        float P = 1.f;
        for (int kt = qb * 8 + 7; kt >= 0; --kt) {
            __syncthreads();
#pragma unroll
            for (int i = 0; i < 8; ++i) { const int idx = tid + 512 * i, key = idx >> 6, d = idx & 63; const size_t mk = (size_t)b * SEQ + kt * 64 + key;
                sK[idx] = bf2f(PROJ[mk * N1 + PK + h * 64 + d]); sV[idx] = bf2f(PROJ[mk * N1 + PV + h * 64 + d]); }
            __syncthreads();
            for (int kk = 63; kk >= 0; --kk) {
                const int s = kt * 64 + kk;
                if (s < t) {
                    float z = 0.f;
#pragma unroll
                    for (int d = 0; d < 64; ++d) z += q[d] * sK[kk * 64 + d];
                    z = fminf(z, 100.f);
                    const float e = exp2f(z), r = 1.f / (1.f + e);
                    P *= r;
                    const float w = e * P;
#pragma unroll
                    for (int d = 0; d < 64; ++d) o[d] += w * sV[kk * 64 + d];
                }
            }
        }
        float ss = 0.f;
#pragma unroll
        for (int d = 0; d < 64; ++d) ss += o[d] * o[d];
        const float rstd = rsqrtf(ss * (1.f / 64.f) + EPS);
#pragma unroll
        for (int d = 0; d < 64; ++d) YC[m * 1024 + 512 + h * 64 + d] = (bf16)f2bf(o[d] * rstd * a.sb_norm_gain[h * 64 + d]);
    }
}


typedef short v4i16 __attribute__((ext_vector_type(4)));
typedef short bf16x8v __attribute__((ext_vector_type(8)));
constexpr int AT_KSTR = 144, AT_KBYTES = 64 * AT_KSTR, AT_VBYTES = 64 * 128, AT_BUF = AT_KBYTES + AT_VBYTES;
#define MFMA32(a, b, c) __builtin_amdgcn_mfma_f32_32x32x16_bf16((a), (b), (c), 0, 0, 0)

template <bool DIAG>
__device__ __forceinline__ void attn_tile(LAS const unsigned char* Kb, LAS const unsigned char* Vb, const bf16x8v (&qf)[4], f32x16& o0, f32x16& o1, float& carry,
                                          int qrel, int l32, int hh, unsigned vbase0, unsigned vbase1) {
    f32x16 p[2];
    bf16x8v kf[2][4];
#pragma unroll
    for (int blk = 0; blk < 2; ++blk)
#pragma unroll
        for (int s = 0; s < 4; ++s) kf[blk][s] = *(LAS const bf16x8v*)(Kb + (32 * blk + l32) * AT_KSTR + 32 * s + 16 * hh);
    asm volatile("s_waitcnt lgkmcnt(0)" ::: "memory");
#pragma unroll
    for (int bi = 0; bi < 2; ++bi) {
        const int blk = 1 - bi;
#pragma unroll
        for (int i = 0; i < 16; ++i) p[blk][i] = 0.f;
#pragma unroll
        for (int s = 0; s < 4; ++s) p[blk] = MFMA32(kf[blk][s], qf[s], p[blk]);
    }
#pragma unroll
    for (int bi = 0; bi < 2; ++bi) {
        const int blk = 1 - bi;
        float R[16];
#pragma unroll
        for (int i = 0; i < 16; ++i) {
            float rv = __builtin_amdgcn_rcpf(1.f + __builtin_amdgcn_exp2f(p[blk][i]));
            if (DIAG) { const int krel = 32 * blk + (i & 3) + 8 * (i >> 2) + 4 * hh; if (krel >= qrel) rv = 1.f; }
            R[i] = rv;
        }
        float GG[4], sel[4];
#pragma unroll
        for (int g = 0; g < 4; ++g) { R[4 * g + 2] *= R[4 * g + 3]; R[4 * g + 1] *= R[4 * g + 2]; R[4 * g] *= R[4 * g + 1]; }
#pragma unroll
        for (int g = 0; g < 4; g += 2) {
            const unsigned ua = __builtin_bit_cast(unsigned, R[4 * g]), ub = __builtin_bit_cast(unsigned, R[4 * g + 4]);
            auto s1 = __builtin_amdgcn_permlane32_swap(ua, ub, false, false);
            auto s2 = __builtin_amdgcn_permlane32_swap(ub, ua, false, false);
            const float pa = __builtin_bit_cast(float, hh ? s2[0] : s1[1]), pb2 = __builtin_bit_cast(float, hh ? s1[0] : s2[1]);
            GG[g] = R[4 * g] * pa; GG[g + 1] = R[4 * g + 4] * pb2;
            sel[g] = hh ? 1.f : pa; sel[g + 1] = hh ? 1.f : pb2;
        }
        float T3 = carry, T2 = T3 * GG[3], T1 = T2 * GG[2], T0 = T1 * GG[1];
        carry = T0 * GG[0];
        const float base[4] = {T0 * sel[0], T1 * sel[1], T2 * sel[2], T3 * sel[3]};
        float w[16];
#pragma unroll
        for (int g = 0; g < 4; ++g) {
            w[4 * g + 3] = base[g] * (1.f - R[4 * g + 3]); w[4 * g + 2] = base[g] * (R[4 * g + 3] - R[4 * g + 2]);
            w[4 * g + 1] = base[g] * (R[4 * g + 2] - R[4 * g + 1]); w[4 * g] = base[g] * (R[4 * g + 1] - R[4 * g]);
        }
#pragma unroll
        for (int s = 0; s < 2; ++s) {
            v4u pk; pk.x = cvtpk(w[8 * s], w[8 * s + 1]); pk.y = cvtpk(w[8 * s + 2], w[8 * s + 3]); pk.z = cvtpk(w[8 * s + 4], w[8 * s + 5]); pk.w = cvtpk(w[8 * s + 6], w[8 * s + 7]);
            const bf16x8v pb = __builtin_bit_cast(bf16x8v, pk);
            const int rowoff = (32 * blk + 16 * s) * 128;
            const v4i16 a0l = __builtin_amdgcn_ds_read_tr16_b64_v4i16((LAS v4i16*)(Vb + vbase0 + rowoff));
            const v4i16 a0h = __builtin_amdgcn_ds_read_tr16_b64_v4i16((LAS v4i16*)(Vb + vbase0 + rowoff + 8 * 128));
            const v4i16 a1l = __builtin_amdgcn_ds_read_tr16_b64_v4i16((LAS v4i16*)(Vb + vbase1 + rowoff));
            const v4i16 a1h = __builtin_amdgcn_ds_read_tr16_b64_v4i16((LAS v4i16*)(Vb + vbase1 + rowoff + 8 * 128));
            const bf16x8v va0 = __builtin_shufflevector(a0l, a0h, 0, 1, 2, 3, 4, 5, 6, 7), va1 = __builtin_shufflevector(a1l, a1h, 0, 1, 2, 3, 4, 5, 6, 7);
            o0 = MFMA32(va0, pb, o0); o1 = MFMA32(va1, pb, o1);
        }
    }
}

__device__ __forceinline__ void attn_unit(const Args& a, LAS unsigned char* lds, int b, int h, int qb) {
    const int tid = threadIdx.x, lane = tid & 63, w = __builtin_amdgcn_readfirstlane(tid >> 6), l32 = lane & 31, hh = lane >> 5;
    const bf16* PROJ = (const bf16*)(a.ws + WS_PROJ); bf16* YC = (bf16*)(a.ws + WS_H);
    const size_t rowbase = (size_t)b * SEQ;
    const int q0 = qb * 256 + 32 * w, ktd = q0 >> 6, ktmax = 4 * qb + 3, qrel = 32 * (w & 1) + l32;
    bf16x8v qf[4];
    { const bf16* qp = PROJ + (rowbase + q0 + l32) * N1 + PQ + h * 64 + 8 * hh;
#pragma unroll
      for (int s = 0; s < 4; ++s) qf[s] = *(const bf16x8v*)(qp + 16 * s); }
    f32x16 o0, o1;
#pragma unroll
    for (int i = 0; i < 16; ++i) { o0[i] = 0.f; o1[i] = 0.f; }
    float carry = 1.f;
    const int skey = tid >> 3, sc = tid & 7;
    const bf16* kg = PROJ + (rowbase + skey) * N1 + PK + h * 64 + 8 * sc;
    const unsigned kwoff = skey * AT_KSTR + sc * 16, vwoff = AT_KBYTES + skey * 128 + ((sc * 16) ^ (((skey >> 1) & 1) << 6));
    const int gi = (lane >> 4) & 1, q4 = (lane & 15) >> 2, pp = lane & 3;
    const unsigned vb = (4 * hh + q4) * 128 + 32 * gi + 8 * pp, xq = (q4 >> 1) << 6;
    const unsigned vbase0 = vb + xq, vbase1 = vb + (64 ^ xq);
    LAS unsigned* dflag = (LAS unsigned*)(lds + 6 * AT_BUF);
    bool wdone = false;
    const int tlo = ktmax >= 5 ? ktmax - 5 : 0, nwin = ktmax - tlo + 1;
    {
        v4u kr[6], vr[6];
#pragma unroll
        for (int i = 0; i < 6; ++i) if (i < nwin) { const size_t t = (size_t)(tlo + i) * 64 * N1; kr[i] = *(const v4u*)(kg + t); vr[i] = *(const v4u*)(kg + t + (PV - PK)); }
#pragma unroll
        for (int i = 0; i < 6; ++i) if (i < nwin) { *(LAS v4u*)(lds + i * AT_BUF + kwoff) = kr[i]; *(LAS v4u*)(lds + i * AT_BUF + vwoff) = vr[i]; }
    }
    __syncthreads();
#pragma unroll 1
    for (int kt = ktd; kt >= tlo; --kt) {
        if (!wdone) {
            LAS unsigned char* bt = lds + (kt - tlo) * AT_BUF;
            if (kt == ktd) attn_tile<true>(bt, bt + AT_KBYTES, qf, o0, o1, carry, qrel, l32, hh, vbase0, vbase1);
            else attn_tile<false>(bt, bt + AT_KBYTES, qf, o0, o1, carry, qrel, l32, hh, vbase0, vbase1);
            wdone = __builtin_amdgcn_ballot_w64(carry >= 3.5527137e-15f) == 0ull;
        }
    }
    if (lane == 0) dflag[16 + w] = wdone ? 1u : 0u;
    __syncthreads();
    bool alldone;
    { const v4u f0 = *(const LAS v4u*)(dflag + 16), f1 = *(const LAS v4u*)(dflag + 20);
      alldone = __builtin_amdgcn_readfirstlane((f0.x & f0.y & f0.z & f0.w) & (f1.x & f1.y & f1.z & f1.w)) != 0u; }
    if (!alldone && tlo > 0) {
        const int npair = tlo >> 1;
        const bf16* kg2 = kg + (size_t)64 * N1;
        v4u kr0, vr0, kr1, vr1;
        { const size_t t = (size_t)(npair - 1) * 128 * N1;
          kr0 = *(const v4u*)(kg + t); vr0 = *(const v4u*)(kg + t + (PV - PK)); kr1 = *(const v4u*)(kg2 + t); vr1 = *(const v4u*)(kg2 + t + (PV - PK)); }
        *(LAS v4u*)(lds + AT_BUF + kwoff) = kr0; *(LAS v4u*)(lds + AT_BUF + vwoff) = vr0; *(LAS v4u*)(lds + kwoff) = kr1; *(LAS v4u*)(lds + vwoff) = vr1;
        __syncthreads();
        int cur = 0, it = 0;
        for (int pj = npair - 1; pj >= 0; --pj, ++it) {
            if (pj > 0) { const size_t t = (size_t)(pj - 1) * 128 * N1;
                kr0 = *(const v4u*)(kg + t); vr0 = *(const v4u*)(kg + t + (PV - PK)); kr1 = *(const v4u*)(kg2 + t); vr1 = *(const v4u*)(kg2 + t + (PV - PK)); }
            LAS unsigned char* bh = lds + cur * (2 * AT_BUF); LAS unsigned char* bl = bh + AT_BUF;
            if (!wdone) {
                attn_tile<false>(bh, bh + AT_KBYTES, qf, o0, o1, carry, qrel, l32, hh, vbase0, vbase1);
                if (__builtin_amdgcn_ballot_w64(carry >= 3.5527137e-15f) != 0ull)
                    attn_tile<false>(bl, bl + AT_KBYTES, qf, o0, o1, carry, qrel, l32, hh, vbase0, vbase1);
                wdone = __builtin_amdgcn_ballot_w64(carry >= 3.5527137e-15f) == 0ull;
            }
            if (lane == 0) dflag[(it & 1) * 8 + w] = wdone ? 1u : 0u;
            if (pj > 0) { LAS unsigned char* nb = lds + (cur ^ 1) * (2 * AT_BUF);
                *(LAS v4u*)(nb + AT_BUF + kwoff) = kr0; *(LAS v4u*)(nb + AT_BUF + vwoff) = vr0; *(LAS v4u*)(nb + kwoff) = kr1; *(LAS v4u*)(nb + vwoff) = vr1; }
            __syncthreads();
            cur ^= 1;
            const v4u f0 = *(const LAS v4u*)(dflag + (it & 1) * 8), f1 = *(const LAS v4u*)(dflag + (it & 1) * 8 + 4);
            if (__builtin_amdgcn_readfirstlane((f0.x & f0.y & f0.z & f0.w) & (f1.x & f1.y & f1.z & f1.w)) != 0u) break;
        }
    }
    float ss = 0.f;
#pragma unroll
    for (int i = 0; i < 16; ++i) ss += o0[i] * o0[i] + o1[i] * o1[i];
    ss += __shfl_xor(ss, 32);
    const float rstd = rsqrtf(ss * (1.f / 64.f) + EPS);
    bf16* yp = YC + (rowbase + q0 + l32) * 1024 + 512 + h * 64 + 4 * hh;
    const float* gp = a.sb_norm_gain + h * 64 + 4 * hh;
#pragma unroll
    for (int g = 0; g < 4; ++g) {
        const v4f g0 = *(const v4f*)(gp + 8 * g), g1 = *(const v4f*)(gp + 32 + 8 * g);
        v2u s0, s1;
        s0.x = pk2(o0[4 * g] * rstd * g0.x, o0[4 * g + 1] * rstd * g0.y); s0.y = pk2(o0[4 * g + 2] * rstd * g0.z, o0[4 * g + 3] * rstd * g0.w);
        s1.x = pk2(o1[4 * g] * rstd * g1.x, o1[4 * g + 1] * rstd * g1.y); s1.y = pk2(o1[4 * g + 2] * rstd * g1.z, o1[4 * g + 3] * rstd * g1.w);
        *(v2u*)(yp + 8 * g) = s0; *(v2u*)(yp + 32 + 8 * g) = s1;
    }
}

__device__ __forceinline__ void phase_attn(const Args& a, LAS unsigned char* lds) {
    for (int pid = blockIdx.x; pid < 256; pid += gridDim.x) {
        int bh, qp;
        if (gridDim.x == 256) { const int xcd = pid & 7, j = pid >> 3; bh = xcd * 8 + (j >> 2); qp = j & 3; }
        else { bh = pid >> 2; qp = pid & 3; }
        attn_unit(a, lds, bh >> 3, bh & 7, 7 - qp);
        attn_unit(a, lds, bh >> 3, bh & 7, qp);
    }
}

constexpr int SD_DT = 0, SD_ACS = 1024, SD_WB = 2048, SD_X = 4096, SD_XS = 576, SD_B = 40960, SD_BS = 320, SD_C = 61440, SD_Z = 81920, SD_ZS = 528;

__device__ __forceinline__ float ssd_dt_load(const Args& a, int b, int c, int g) {
    const int tid = threadIdx.x;
    if (tid >= 256) return 0.f;
    return ((const float*)(a.ws + WS_DT))[((size_t)b * SEQ + 64 * c + (tid & 63)) * 8 + 4 * g + (tid >> 6)];
}
template <bool S1>
__device__ __forceinline__ void ssd_dt(const Args& a, LAS unsigned char* lds, int b, int c, int g, float dtraw) {
    const int tid = threadIdx.x, lane = tid & 63;
    if (tid < 256) {
        const int hl = tid >> 6, h = 4 * g + hl;
        const float dtv = softplusf(dtraw + a.dt_bias[h]);
        float cs = dtv * (-__expf(a.a_log[h]));
#pragma unroll
        for (int o = 1; o < 64; o <<= 1) { const float t = __shfl_up(cs, o); if (lane >= o) cs += t; }
        ((LAS float*)(lds + SD_DT))[hl * 64 + lane] = dtv;
        ((LAS float*)(lds + SD_ACS))[hl * 64 + lane] = cs;
        if (S1) {
            const float tot = __shfl(cs, 63);
            ((LAS float*)(lds + SD_WB))[hl * 64 + lane] = __expf(tot - cs) * dtv;
            if (lane == 63) ((float*)(a.ws + WS_CD))[((size_t)b * NCH + c) * 8 + h] = __expf(tot);
        }
    }
}

struct ConvIn { unsigned halo[3]; unsigned vin[32]; };
__device__ __forceinline__ void ssd_conv_load(const Args& a, ConvIn& r, int b, int c, int th, int col) {
    const bf16* PROJ = (const bf16*)(a.ws + WS_PROJ);
    const int t0 = 64 * c + 32 * th;
    const bf16* src = PROJ + ((size_t)b * SEQ + t0) * N1 + PX + col;
#pragma unroll
    for (int j = 0; j < 3; ++j) { unsigned v = 0u; if (t0 - 3 + j >= 0) v = *(const unsigned*)(src + (ptrdiff_t)(j - 3) * N1); r.halo[j] = v; }
#pragma unroll
    for (int i = 0; i < 32; ++i) r.vin[i] = *(const unsigned*)(src + (size_t)i * N1);
}
template <bool SCALE>
__device__ __forceinline__ void ssd_conv_compute(const Args& a, const ConvIn& r, LAS unsigned char* dst, int dstride, int th, int col, const LAS float* wsc) {
    float w0[4], w1[4];
#pragma unroll
    for (int j = 0; j < 4; ++j) { w0[j] = a.conv_w[j * 1024 + col]; w1[j] = a.conv_w[j * 1024 + col + 1]; }
    const float b0 = a.conv_b[col], b1 = a.conv_b[col + 1];
    float u0[3], u1[3];
#pragma unroll
    for (int j = 0; j < 3; ++j) { u0[j] = bflo(r.halo[j]); u1[j] = bfhi(r.halo[j]); }
#pragma unroll
    for (int i = 0; i < 32; ++i) {
        const unsigned v = r.vin[i];
        const float c0 = bflo(v), c1 = bfhi(v);
        float y0 = b0 + w0[0] * u0[0] + w0[1] * u0[1] + w0[2] * u0[2] + w0[3] * c0;
        float y1 = b1 + w1[0] * u1[0] + w1[1] * u1[1] + w1[2] * u1[2] + w1[3] * c1;
        u0[0] = u0[1]; u0[1] = u0[2]; u0[2] = c0; u1[0] = u1[1]; u1[1] = u1[2]; u1[2] = c1;
        y0 = silu_fast(y0); y1 = silu_fast(y1);
        if (SCALE) { const float s = wsc[32 * th + i]; y0 *= s; y1 *= s; }
        *(LAS unsigned*)(dst + (32 * th + i) * dstride) = pk2(y0, y1);
    }
}

__device__ __forceinline__ bf16x8v tr_pair(LAS const unsigned char* p, int rowstride4) {
    const v4i16 lo = __builtin_amdgcn_ds_read_tr16_b64_v4i16((LAS v4i16*)p);
    const v4i16 hi = __builtin_amdgcn_ds_read_tr16_b64_v4i16((LAS v4i16*)(p + rowstride4));
    return __builtin_shufflevector(lo, hi, 0, 1, 2, 3, 4, 5, 6, 7);
}

__device__ __forceinline__ int ssd_item(int item);
__device__ __forceinline__ void phase_ssd_s1(const Args& a, LAS unsigned char* lds) {
    const int tid = threadIdx.x, lane = tid & 63, w = __builtin_amdgcn_readfirstlane(tid >> 6), l32 = lane & 31, hh = lane >> 5;
    const int hl = w >> 1, half = w & 1;
    const int gi = (lane >> 4) & 1, q4 = (lane & 15) >> 2, pp = lane & 3;
    bf16* CS = (bf16*)(a.ws + WS_CS);
    ConvIn cin; float dtraw = 0.f;
    const int cp = tid % 192, th = tid / 192;
    if (blockIdx.x < NB * NCH * 2) { const int it0 = ssd_item(blockIdx.x), g0 = it0 & 1, c0 = (it0 >> 1) & (NCH - 1), b0 = it0 >> 6;
        if (tid < 384) ssd_conv_load(a, cin, b0, c0, th, cp < 128 ? 256 * g0 + 2 * cp : 512 + 128 * g0 + 2 * (cp - 128));
        dtraw = ssd_dt_load(a, b0, c0, g0); }
    for (int item = blockIdx.x; item < NB * NCH * 2; item += gridDim.x) {
        const int it2 = ssd_item(item), g = it2 & 1, c = (it2 >> 1) & (NCH - 1), b = it2 >> 6;
        const int ccol = cp < 128 ? 256 * g + 2 * cp : 512 + 128 * g + 2 * (cp - 128);
        __syncthreads();
        ssd_dt<true>(a, lds, b, c, g, dtraw);
        __syncthreads();
        if (tid < 384) {
            if (cp < 128) ssd_conv_compute<true>(a, cin, lds + SD_X + 4 * cp, SD_XS, th, ccol, (const LAS float*)(lds + SD_WB) + (cp >> 5) * 64);
            else ssd_conv_compute<false>(a, cin, lds + SD_B + 4 * (cp - 128), SD_BS, th, ccol, nullptr);
        }
        __syncthreads();
        { const int itn = item + gridDim.x;
          if (itn < NB * NCH * 2) { const int in2 = ssd_item(itn), gn = in2 & 1, cn = (in2 >> 1) & (NCH - 1), bn = in2 >> 6;
              if (tid < 384) ssd_conv_load(a, cin, bn, cn, th, cp < 128 ? 256 * gn + 2 * cp : 512 + 128 * gn + 2 * (cp - 128));
              dtraw = ssd_dt_load(a, bn, cn, gn); } }
        f32x16 acc[2][2];
#pragma unroll
        for (int i = 0; i < 16; ++i) { acc[0][0][i] = 0.f; acc[0][1][i] = 0.f; acc[1][0][i] = 0.f; acc[1][1][i] = 0.f; }
#pragma unroll
        for (int s = 0; s < 4; ++s) {
            const int l0 = 16 * s + 8 * hh + q4;
            bf16x8v af[2], bfr[2];
#pragma unroll
            for (int nb = 0; nb < 2; ++nb) af[nb] = tr_pair(lds + SD_B + l0 * SD_BS + (32 * (2 * half + nb) + 16 * gi + 4 * pp) * 2, 4 * SD_BS);
#pragma unroll
            for (int pb = 0; pb < 2; ++pb) bfr[pb] = tr_pair(lds + SD_X + l0 * SD_XS + (64 * hl + 32 * pb + 16 * gi + 4 * pp) * 2, 4 * SD_XS);
#pragma unroll
            for (int nb = 0; nb < 2; ++nb)
#pragma unroll
                for (int pb = 0; pb < 2; ++pb) acc[nb][pb] = MFMA32(bfr[pb], af[nb], acc[nb][pb]);
        }
        bf16* dst = CS + ((((size_t)b * NCH + c) * 8 + 4 * g + hl) * 64) * 128;
#pragma unroll
        for (int nb = 0; nb < 2; ++nb)
#pragma unroll
            for (int pb = 0; pb < 2; ++pb)
#pragma unroll
                for (int i = 0; i < 16; ++i) { const int p = 32 * pb + (i & 3) + 8 * (i >> 2) + 4 * hh; dst[p * 128 + 32 * (2 * half + nb) + l32] = (bf16)f2bf(acc[nb][pb][i]); }
    }
}

__device__ __forceinline__ void phase_ssd_s2(const Args& a) {
    const bf16* CS = (const bf16*)(a.ws + WS_CS); const float* CD = (const float*)(a.ws + WS_CD);
    for (int gid = blockIdx.x * NTHR + threadIdx.x; gid < 64 * 2048; gid += gridDim.x * NTHR) {
        int bh = gid >> 11, e4 = gid & 2047;
        if (gridDim.x == 256) { const int blk = gid >> 9, grp = blk & 7, j = blk >> 3; bh = grp * 8 + (j >> 2); e4 = (j & 3) * 512 + (gid & 511); }
        const int b = bh >> 3, h = bh & 7;
        const v2u* p = (const v2u*)(CS + (((size_t)b * NCH) * 8 + h) * 8192) + e4;
        const float* cd = CD + (size_t)b * NCH * 8 + h;
        v2u* o = (v2u*)((bf16*)(a.ws + WS_PB) + (((size_t)b * NCH) * 8 + h) * 8192) + e4;
        v4f st = {0.f, 0.f, 0.f, 0.f};
        for (int c0 = 0; c0 < NCH; c0 += 16) {
            v2u v[16]; float d[16];
#pragma unroll
            for (int j = 0; j < 16; ++j) { v[j] = p[(size_t)(c0 + j) * 16384]; d[j] = cd[(c0 + j) * 8]; }
#pragma unroll
            for (int j = 0; j < 16; ++j) { v2u w2; w2.x = cvtpk(st.x, st.y); w2.y = cvtpk(st.z, st.w); wt8(o + (size_t)(c0 + j) * 16384, w2.x, w2.y);
                const v4f vv = {bflo(v[j].x), bfhi(v[j].x), bflo(v[j].y), bfhi(v[j].y)}; st = st * d[j] + vv; }
        }
    }
}

__device__ __forceinline__ void phase_ssd_s3(const Args& a, LAS unsigned char* lds) {
    const int tid = threadIdx.x, lane = tid & 63, w = __builtin_amdgcn_readfirstlane(tid >> 6), l32 = lane & 31, hh = lane >> 5;
    const int hl = w >> 1, half = w & 1;
    const int gi = (lane >> 4) & 1, q4 = (lane & 15) >> 2, pp = lane & 3;
    const bf16* PROJ = (const bf16*)(a.ws + WS_PROJ); bf16* YC = (bf16*)(a.ws + WS_H);
    for (int item = blockIdx.x; item < NB * NCH * 2; item += gridDim.x) {
        const int it2 = ssd_item(item), g = it2 & 1, c = (it2 >> 1) & (NCH - 1), b = it2 >> 6, h = 4 * g + hl;
        const size_t m0 = (size_t)b * SEQ + 64 * c;
        __syncthreads();
        bf16x8v pvf[8][2];
        { const bf16* pvb = (const bf16*)(a.ws + WS_PB) + ((((size_t)b * NCH + c) * 8 + h) * 64 + l32) * 128 + 8 * hh;
#pragma unroll
          for (int s = 0; s < 8; ++s) { pvf[s][0] = *(const bf16x8v*)(pvb + 16 * s); pvf[s][1] = *(const bf16x8v*)(pvb + 32 * 128 + 16 * s); } }
        ConvIn cin; v4u zr[4];
        {
            const int cp = tid & 255, th = tid >> 8;
            const int ccol = cp < 128 ? 256 * g + 2 * cp : (cp < 192 ? 512 + 128 * g + 2 * (cp - 128) : 768 + 128 * g + 2 * (cp - 192));
            ssd_conv_load(a, cin, b, c, th, ccol);
#pragma unroll
            for (int i = 0; i < 4; ++i) { const int id = tid + 512 * i, row = id >> 5, ck = id & 31; zr[i] = *(const v4u*)(PROJ + (m0 + row) * N1 + PZ + 256 * g + 8 * ck); }
            ssd_dt<false>(a, lds, b, c, g, ssd_dt_load(a, b, c, g));
            LAS unsigned char* cdst = cp < 128 ? lds + SD_X + 4 * cp : (cp < 192 ? lds + SD_B + 4 * (cp - 128) : lds + SD_C + 4 * (cp - 192));
            ssd_conv_compute<false>(a, cin, cdst, cp < 128 ? SD_XS : SD_BS, th, ccol, nullptr);
#pragma unroll
            for (int i = 0; i < 4; ++i) { const int id = tid + 512 * i, row = id >> 5, ck = id & 31; *(LAS v4u*)(lds + SD_Z + row * SD_ZS + 16 * ck) = zr[i]; }
        }
        __syncthreads();
        const int lcol = 32 * half + l32;
        bf16x8v cf[8];
        f32x16 yo[2], yd[2];
#pragma unroll
        for (int i = 0; i < 16; ++i) { yo[0][i] = 0.f; yo[1][i] = 0.f; yd[0][i] = 0.f; yd[1][i] = 0.f; }
#pragma unroll
        for (int s = 0; s < 8; ++s) {
            cf[s] = *(LAS const bf16x8v*)(lds + SD_C + lcol * SD_BS + (16 * s + 8 * hh) * 2);
            yo[0] = MFMA32(pvf[s][0], cf[s], yo[0]); yo[1] = MFMA32(pvf[s][1], cf[s], yo[1]);
        }
        const float acs_l = ((const LAS float*)(lds + SD_ACS))[hl * 64 + lcol];
#pragma unroll
        for (int sb = 0; sb < 2; ++sb) {
            if (sb <= half) {
                f32x16 cb;
#pragma unroll
                for (int i = 0; i < 16; ++i) cb[i] = 0.f;
#pragma unroll
                for (int s = 0; s < 8; ++s) { const bf16x8v bfrag = *(LAS const bf16x8v*)(lds + SD_B + (32 * sb + l32) * SD_BS + (16 * s + 8 * hh) * 2); cb = MFMA32(bfrag, cf[s], cb); }
                float mv[16];
#pragma unroll
                for (int gq = 0; gq < 4; ++gq) {
                    const v4f as4 = *(const LAS v4f*)(lds + SD_ACS + (hl * 64 + 32 * sb + 8 * gq + 4 * hh) * 4), dt4 = *(const LAS v4f*)(lds + SD_DT + (hl * 64 + 32 * sb + 8 * gq + 4 * hh) * 4);
#pragma unroll
                    for (int j = 0; j < 4; ++j) { const int srow = 32 * sb + 8 * gq + 4 * hh + j;
                        const float dec = __expf(fminf(acs_l - as4[j], 0.f)) * dt4[j];
                        mv[4 * gq + j] = (srow <= lcol) ? cb[4 * gq + j] * dec : 0.f; }
                }
#pragma unroll
                for (int k2 = 0; k2 < 2; ++k2) {
                    v4u pk; pk.x = cvtpk(mv[8 * k2], mv[8 * k2 + 1]); pk.y = cvtpk(mv[8 * k2 + 2], mv[8 * k2 + 3]); pk.z = cvtpk(mv[8 * k2 + 4], mv[8 * k2 + 5]); pk.w = cvtpk(mv[8 * k2 + 6], mv[8 * k2 + 7]);
                    const bf16x8v mf = __builtin_bit_cast(bf16x8v, pk);
#pragma unroll
                    for (int pb = 0; pb < 2; ++pb) {
                        const bf16x8v xf = tr_pair(lds + SD_X + (32 * sb + 16 * k2 + 4 * hh + q4) * SD_XS + (64 * hl + 32 * pb + 16 * gi + 4 * pp) * 2, 8 * SD_XS);
                        yd[pb] = MFMA32(xf, mf, yd[pb]);
                    }
                }
            }
        }
        const float eal = __expf(acs_l), dsk = a.d_skip[h];
        float y[2][16]; float ss = 0.f;
#pragma unroll
        for (int pb = 0; pb < 2; ++pb)
#pragma unroll
            for (int gq = 0; gq < 4; ++gq) {
                const int ch = 64 * hl + 32 * pb + 8 * gq + 4 * hh;
                const v2u xv = *(const LAS v2u*)(lds + SD_X + lcol * SD_XS + ch * 2), zv = *(const LAS v2u*)(lds + SD_Z + lcol * SD_ZS + ch * 2);
                const float xs[4] = {bflo(xv.x), bfhi(xv.x), bflo(xv.y), bfhi(xv.y)}, zs[4] = {bflo(zv.x), bfhi(zv.x), bflo(zv.y), bfhi(zv.y)};
#pragma unroll
                for (int j = 0; j < 4; ++j) { float t = yd[pb][4 * gq + j] + yo[pb][4 * gq + j] * eal + dsk * xs[j]; t *= silu_fast(zs[j]); y[pb][4 * gq + j] = t; ss += t * t; }
            }
        ss += __shfl_xor(ss, 32);
        if (hh == 0) ((LAS float*)(lds + SD_WB))[hl * 64 + lcol] = ss;
        __syncthreads();
        const LAS float* sred = (const LAS float*)(lds + SD_WB);
        const float tot = (sred[lcol] + sred[64 + lcol]) + (sred[128 + lcol] + sred[192 + lcol]);
        const float rstd = rsqrtf(tot * (1.f / 256.f) + EPS);
        bf16* yp = YC + (m0 + lcol) * 1024 + 256 * g + 64 * hl + 4 * hh;
        const float* gp = a.ssd_norm_gain + 256 * g + 64 * hl + 4 * hh;
#pragma unroll
        for (int pb = 0; pb < 2; ++pb)
#pragma unroll
            for (int gq = 0; gq < 4; ++gq) {
                const v4f gn = *(const v4f*)(gp + 32 * pb + 8 * gq);
                v2u o; o.x = pk2(y[pb][4 * gq] * rstd * gn.x, y[pb][4 * gq + 1] * rstd * gn.y); o.y = pk2(y[pb][4 * gq + 2] * rstd * gn.z, y[pb][4 * gq + 3] * rstd * gn.w);
                *(v2u*)(yp + 32 * pb + 8 * gq) = o;
            }
    }
}

__device__ __forceinline__ void phase_norm1(const Args& a) {
    const int lane = threadIdx.x & 63, wave = threadIdx.x >> 6, gw = blockIdx.x * NWAVES + wave, NGW = gridDim.x * NWAVES;
    const bf16* MIX = (const bf16*)(a.ws + WS_PROJ); bf16* H = (bf16*)(a.ws + WS_H);
    v4f g1[4], g2[4];
#pragma unroll
    for (int j = 0; j < 4; ++j) { g1[j] = ((const v4f*)a.post_mix_gain)[lane + 64 * j]; g2[j] = ((const v4f*)a.pre_ffn_gain)[lane + 64 * j]; }
    v2u mv[4], mvn[4]; v4f xv[4], xvn[4];
    if (gw < M) {
#pragma unroll
        for (int j = 0; j < 4; ++j) { mv[j] = ((const v2u*)(MIX + (size_t)gw * DM))[lane + 64 * j]; xv[j] = ((const v4f*)(a.x + (size_t)gw * DM))[lane + 64 * j]; }
    }
    for (int m = gw; m < M; m += NGW) {
        const int mn = m + NGW;
        if (mn < M) {
#pragma unroll
            for (int j = 0; j < 4; ++j) { mvn[j] = ((const v2u*)(MIX + (size_t)mn * DM))[lane + 64 * j]; xvn[j] = ((const v4f*)(a.x + (size_t)mn * DM))[lane + 64 * j]; }
        }
        v4f* orow = (v4f*)(a.out + (size_t)m * DM) + lane;
        v4f v[4]; float s = 0.f;
#pragma unroll
        for (int j = 0; j < 4; ++j) { v[j] = (v4f){bflo(mv[j].x), bfhi(mv[j].x), bflo(mv[j].y), bfhi(mv[j].y)}; s += (v[j].x * v[j].x + v[j].y * v[j].y) + (v[j].z * v[j].z + v[j].w * v[j].w); }
        const float rstd = rsqrtf(wave_sum(s) * (1.f / DM) + EPS);
        float s2 = 0.f;
#pragma unroll
        for (int j = 0; j < 4; ++j) { xv[j] = xv[j] + v[j] * rstd * g1[j]; orow[64 * j] = xv[j];
            s2 += (xv[j].x * xv[j].x + xv[j].y * xv[j].y) + (xv[j].z * xv[j].z + xv[j].w * xv[j].w); }
        const float rstd2 = rsqrtf(wave_sum(s2) * (1.f / DM) + EPS);
        unsigned long long* o8 = (unsigned long long*)(H + (size_t)m * DM) + lane;
#pragma unroll
        for (int j = 0; j < 4; ++j) { const v4f hv = xv[j] * rstd2 * g2[j];
            o8[64 * j] = (unsigned long long)pk2(hv.x, hv.y) | ((unsigned long long)pk2(hv.z, hv.w) << 32); }
#pragma unroll
        for (int j = 0; j < 4; ++j) { mv[j] = mvn[j]; xv[j] = xvn[j]; }
    }
}
__device__ __forceinline__ void phase_norm2(const Args& a) {
    const int lane = threadIdx.x & 63, wave = threadIdx.x >> 6, gw = blockIdx.x * NWAVES + wave, NGW = gridDim.x * NWAVES;
    const bf16* F = (const bf16*)(a.ws + WS_CS);
    v4f g1[4];
#pragma unroll
    for (int j = 0; j < 4; ++j) g1[j] = ((const v4f*)a.post_ffn_gain)[lane + 64 * j];
    v2u fv[4], fvn[4]; v4f xv[4], xvn[4];
    if (gw < M) {
#pragma unroll
        for (int j = 0; j < 4; ++j) { fv[j] = ((const v2u*)(F + (size_t)gw * DM))[lane + 64 * j]; xv[j] = ((const v4f*)(a.out + (size_t)gw * DM))[lane + 64 * j]; }
    }
    for (int m = gw; m < M; m += NGW) {
        const int mn = m + NGW;
        if (mn < M) {
#pragma unroll
            for (int j = 0; j < 4; ++j) { fvn[j] = ((const v2u*)(F + (size_t)mn * DM))[lane + 64 * j]; xvn[j] = ((const v4f*)(a.out + (size_t)mn * DM))[lane + 64 * j]; }
        }
        v4f* orow = (v4f*)(a.out + (size_t)m * DM) + lane;
        v4f v[4]; float s = 0.f;
#pragma unroll
        for (int j = 0; j < 4; ++j) { v[j] = (v4f){bflo(fv[j].x), bfhi(fv[j].x), bflo(fv[j].y), bfhi(fv[j].y)}; s += (v[j].x * v[j].x + v[j].y * v[j].y) + (v[j].z * v[j].z + v[j].w * v[j].w); }
        const float rstd = rsqrtf(wave_sum(s) * (1.f / DM) + EPS);
#pragma unroll
        for (int j = 0; j < 4; ++j) orow[64 * j] = xv[j] + v[j] * rstd * g1[j];
#pragma unroll
        for (int j = 0; j < 4; ++j) { fv[j] = fvn[j]; xv[j] = xvn[j]; }
    }
}

#define XB_TMO      128
#define XB_XCNT(j)  (256  + 64 * (j))
#define XB_XSUB(j)  (1280 + 64 * (j))
#define XB_XGEN(j)  (2304 + 64 * (j))
#define XB_TOP      3328
#define XB_TOPGEN   3392
#define XCD_BAR_WORDS 3456
#define XB_SPIN_CAP (1u << 18)

__device__ __forceinline__ unsigned xb_ld(unsigned* p)              { return __hip_atomic_load(p, __ATOMIC_RELAXED, __HIP_MEMORY_SCOPE_AGENT); }
__device__ __forceinline__ unsigned xb_add(unsigned* p, unsigned v) { return __hip_atomic_fetch_add(p, v, __ATOMIC_RELAXED, __HIP_MEMORY_SCOPE_AGENT); }
__device__ __forceinline__ unsigned xb_xcc_id() { return (unsigned)__builtin_amdgcn_s_getreg((3 << 11) | 20) & 0xFu; }
#define XB_SPIN(cond, bar) do { unsigned _sp = 0; while (cond) { __builtin_amdgcn_s_sleep(1); \
    if ((++_sp & 255u) == 0u) { if (xb_ld(&(bar)[XB_TMO])) break; if (_sp > XB_SPIN_CAP) { atomicAdd(&(bar)[XB_TMO], 1u); break; } } } } while (0)

struct XcdBarrier {
    unsigned* bar; unsigned x;
    volatile LAS unsigned* st;
};

__device__ __forceinline__ XcdBarrier xcd_barrier_post(unsigned* bar, volatile LAS unsigned* st) {
    XcdBarrier b; b.bar = bar; b.x = xb_xcc_id(); b.st = st;
    if (threadIdx.x == 0) (void)xb_add(&bar[XB_XCNT(b.x)], 1u);
    return b;
}
__device__ __forceinline__ void xcd_barrier_complete(unsigned* bar, unsigned x, unsigned& nloc, unsigned& nx) {
    const unsigned G = gridDim.x * gridDim.y * gridDim.z;
    unsigned sum, cnt, mine, sp = 0u;
    for (;;) {
        sum = 0u; cnt = 0u; mine = 0u;
#pragma unroll
        for (unsigned j = 0; j < 16; ++j) { const unsigned c = xb_ld(&bar[XB_XCNT(j)]); sum += c; cnt += (c > 0u) ? 1u : 0u; mine = (j == x) ? c : mine; }
        if (sum == G) break;
        __builtin_amdgcn_s_sleep(1);
        if ((++sp & 255u) == 0u) { if (xb_ld(&bar[XB_TMO])) break; if (sp > XB_SPIN_CAP) { atomicAdd(&bar[XB_TMO], 1u); break; } }
    }
    nloc = mine > 0u ? mine : 1u; nx = cnt > 0u ? cnt : 1u;
}

__device__ __forceinline__ void xcd_barrier(const XcdBarrier& b) {
    asm volatile("s_waitcnt vmcnt(0)" ::: "memory");
    __syncthreads();
    if (threadIdx.x == 0) {
        unsigned* bar = b.bar;
        __builtin_amdgcn_s_waitcnt(0);
        unsigned nloc = b.st[0], nx = b.st[1];
        if (nloc == 0u) { xcd_barrier_complete(bar, b.x, nloc, nx); b.st[0] = nloc; b.st[1] = nx; }
        const unsigned old = xb_add(&bar[XB_XSUB(b.x)], 1u);
        const unsigned gen = old / nloc;
        if (old + 1u == (gen + 1u) * nloc) {
            __builtin_amdgcn_fence(__ATOMIC_RELEASE, "agent");
            asm volatile("s_waitcnt vmcnt(0)" ::: "memory");
            const unsigned og = xb_add(&bar[XB_TOP], 1u);
            const unsigned tg = og / nx;
            if (og + 1u == (tg + 1u) * nx) xb_add(&bar[XB_TOPGEN], 1u);
            else XB_SPIN(xb_ld(&bar[XB_TOPGEN]) == tg, bar);
            __builtin_amdgcn_fence(__ATOMIC_ACQUIRE, "agent");
            xb_add(&bar[XB_XGEN(b.x)], 1u);
            asm volatile("s_waitcnt vmcnt(0)" ::: "memory");
        } else {
            XB_SPIN(xb_ld(&bar[XB_XGEN(b.x)]) == gen, bar);
            __builtin_amdgcn_fence(__ATOMIC_ACQUIRE, "agent");
            asm volatile("s_waitcnt vmcnt(0)" ::: "memory");
        }
    }
    __syncthreads();
}


__device__ __forceinline__ int ssd_item(int item) {
    if (gridDim.x != 256) return item;
    const int blk = item & 255, k = item >> 8, grp = blk & 7, j = blk >> 3;
    return (grp << 6) | (j + 32 * k);
}
#define XL_SUB(g) (3472 + 16 * (g))
#define XL_GEN(g) (3600 + 16 * (g))
#define XL_MASK(g) (3456 + (g))
__device__ __forceinline__ void local_barrier(unsigned* ctl, int g) {
    asm volatile("s_waitcnt vmcnt(0)" ::: "memory");
    __syncthreads();
    if (threadIdx.x == 0) {
        const unsigned old = xb_add(&ctl[XL_SUB(g)], 1u), gen = old / 32u;
        if (old + 1u == (gen + 1u) * 32u) xb_add(&ctl[XL_GEN(g)], 1u);
        else { unsigned sp = 0u; while (xb_ld(&ctl[XL_GEN(g)]) == gen) { __builtin_amdgcn_s_sleep(1); if (++sp > (1u << 22)) break; } }
        __builtin_amdgcn_fence(__ATOMIC_ACQUIRE, "agent");
        asm volatile("s_waitcnt vmcnt(0)" ::: "memory");
    }
    __syncthreads();
}
constexpr int NPHASE = 10;
__global__ void __launch_bounds__(NTHR, 2) fwd(Args a) {
    extern __shared__ __attribute__((aligned(16))) unsigned char lds_raw[];
    LAS unsigned char* lds = (LAS unsigned char*)lds_raw;
    const int lo = a.ph_lo, hi = a.ph_hi;
#ifndef REPMASK
#define REPMASK 0
#endif
#define REP(k) for (int _r = 0; _r < (((REPMASK) >> (k)) & 1) + 1; ++_r)
#define IN(k) (lo <= (k) && (k) < hi)
#define SEAM(k) do { if (IN(k) && IN((k) + 1)) xcd_barrier(bar); } while (0)
    unsigned char* ws = a.ws;
    volatile LAS unsigned* misc = (volatile LAS unsigned*)(lds + 131072);
    if (threadIdx.x < 2) misc[threadIdx.x] = 0u;
    __syncthreads();
    XcdBarrier bar = xcd_barrier_post((unsigned*)(ws + WS_CTL), misc);
    unsigned* ctlw = (unsigned*)(ws + WS_CTL);
    if (threadIdx.x == 0) __hip_atomic_fetch_or(&ctlw[XL_MASK(blockIdx.x & 7)], 1u << bar.x, __ATOMIC_RELAXED, __HIP_MEMORY_SCOPE_AGENT);
    if ((REPMASK) & 16384) { for (int i = 0; i < 10; ++i) xcd_barrier(bar); }
    const bool defer_w4 = (gridDim.x == 256) && lo == 0 && hi > 7;
    if (IN(0)) REP(0) { phase_p0(a, lds, defer_w4); __syncthreads(); }
    SEAM(0);
    bool colo = false;
    if ((gridDim.x == 256) && lo == 0 && hi > 5) {
        unsigned seen = 0u; colo = true;
#pragma unroll
        for (int g8 = 0; g8 < 8; ++g8) { const unsigned mk = xb_ld(&ctlw[XL_MASK(g8)]); colo = colo && mk != 0u && (mk & (mk - 1u)) == 0u && (seen & mk) == 0u; seen |= mk; }
        colo = __builtin_amdgcn_readfirstlane(colo ? 1 : 0) != 0;
    }
#define SEAM_L(k) do { if (IN(k) && IN((k) + 1)) { if (colo) local_barrier(ctlw, blockIdx.x & 7); else xcd_barrier(bar); } } while (0)
    if (IN(1)) REP(1) { pg8::Gemm g{(const bf16*)(ws + WS_H), (const bf16*)(ws + WS_W1), M, N1, DM}; pg8::StaticOrder S; S.init(M, N1, gridDim.x, blockIdx.x);
        pg8::EpiProj E{(bf16*)(ws + WS_PROJ)}; pg8::gemm_phase<pg8::EpiProj, pg8::StaticOrder, true, true>(lds, g, S, E); }
    SEAM_L(1);
    if (IN(2)) REP(2) { phase_ssd_s1(a, lds); }
    SEAM_L(2);
    if (IN(3)) REP(3) { phase_ssd_s2(a); }
    SEAM_L(3);
    if (IN(4)) { REP(10) { phase_ssd_s3(a, lds); __syncthreads(); } REP(11) { phase_attn(a, lds); __syncthreads(); } }
    SEAM_L(4);
    const bool fuse_n1 = (gridDim.x == 256) && lo <= 5 && hi > 7;
    if (IN(5)) { pg8::Gemm g{(const bf16*)(ws + WS_H), (const bf16*)(ws + WS_W2), M, DM, DM}; pg8::StaticOrder S; S.init(M, DM, gridDim.x, blockIdx.x);
        if (fuse_n1) {
            pg8::EpiRmsResRms E{a.x, (bf16*)(ws + WS_CS), (bf16*)(ws + WS_PB), a.post_mix_gain, a.pre_ffn_gain, (float*)(ws + WS_CTL + 65536 + 262144), (unsigned*)(ws + WS_CTL + 32768), (float*)(ws + WS_CTL + 65536 + 524288), (unsigned*)(ws + WS_CTL + 49152)};
            pg8::gemm_phase<pg8::EpiRmsResRms, pg8::StaticOrder, false, true>(lds, g, S, E);
        } else {
            pg8::EpiBf16 E{(bf16*)(ws + WS_PROJ), DM}; pg8::gemm_phase<pg8::EpiBf16, pg8::StaticOrder, true, true>(lds, g, S, E);
        }
    }
    if (!fuse_n1) {
    SEAM(5);
    if (IN(6)) REP(6) { phase_norm1(a); }
    }
    SEAM(6);
    if (IN(7)) REP(7) { pg8::Gemm g{(const bf16*)(ws + (fuse_n1 ? WS_PB : WS_H)), (const bf16*)(ws + WS_W3), M, N3, DM}; pg8::StaticOrder S; S.init(M, N3, gridDim.x, blockIdx.x);
        pg8::EpiSwiglu E{(bf16*)(ws + WS_PROJ)}; pg8::gemm_phase<pg8::EpiSwiglu, pg8::StaticOrder, true, true>(lds, g, S, E);
        if (defer_w4) { __syncthreads(); phase_w4(a, lds); } }
    SEAM(7);
    if (IN(8)) { pg8::Gemm g{(const bf16*)(ws + WS_PROJ), (const bf16*)(ws + WS_W4), M, DM, DFF}; pg8::StaticOrder S; S.init(M, DM, gridDim.x, blockIdx.x);
        if (gridDim.x == 256 && hi > 9 && lo <= 5) {
            pg8::EpiRmsRes E{(const bf16*)(ws + WS_CS), a.out, a.post_ffn_gain, (float*)(ws + WS_CTL + 65536), (unsigned*)(ws + WS_CTL + 16384)};
            pg8::gemm_phase<pg8::EpiRmsRes, pg8::StaticOrder, false, true>(lds, g, S, E);
        } else {
            pg8::EpiBf16 E{(bf16*)(ws + WS_CS), DM}; pg8::gemm_phase<pg8::EpiBf16, pg8::StaticOrder, true, true>(lds, g, S, E);
            SEAM(8);
            if (IN(9)) { phase_norm2(a); }
        }
    }
#undef IN
#undef SEAM
}

#ifndef N_LAUNCHES
#define N_LAUNCHES 1
#endif
extern "C" void kernel_launch(void* const* d_in, const int* in_sizes, int n_in, void* d_out, int out_size, void* d_ws, size_t ws_size, hipStream_t stream) {
    static int grid = 0;
    if (grid == 0) {
        if (n_in != 17 || out_size != M * DM || ws_size < WS_END) { fprintf(stderr, "kernel_launch: unexpected problem (n_in %d out %d ws %zu)\n", n_in, out_size, ws_size); grid = -1; return; }
        int dev = 0, cus = 0, per_cu = 0;
        hipGetDevice(&dev); hipDeviceGetAttribute(&cus, hipDeviceAttributeMultiprocessorCount, dev);
        if (hipFuncSetAttribute((const void*)fwd, hipFuncAttributeMaxDynamicSharedMemorySize, LDS_BYTES) != hipSuccess) { fprintf(stderr, "kernel_launch: hipFuncSetAttribute failed\n"); grid = -1; return; }
        if (hipOccupancyMaxActiveBlocksPerMultiprocessor(&per_cu, (const void*)fwd, NTHR, LDS_BYTES) != hipSuccess || per_cu < 1) { fprintf(stderr, "kernel_launch: occupancy query says %d blocks per CU\n", per_cu); per_cu = 1; }
        (void)hipGetLastError();
        grid = cus;
    }
    if (grid < 0) return;
    if (hipMemsetAsync((char*)d_ws + WS_CTL, 0, 65536, stream) != hipSuccess) { fprintf(stderr, "kernel_launch: memset failed\n"); return; }
    Args a{};
    const float** ap = (const float**)&a;
    for (int i = 0; i < 17; ++i) ap[i] = (const float*)d_in[i];
    a.out = (float*)d_out; a.ws = (unsigned char*)d_ws;
#if N_LAUNCHES == 1
    a.ph_lo = 0; a.ph_hi = NPHASE;
    void* args[] = {&a};
    hipError_t e = hipLaunchCooperativeKernel((const void*)fwd, dim3(grid), dim3(NTHR), args, LDS_BYTES, stream);
    if (e != hipSuccess) fprintf(stderr, "cooperative launch failed: %s (grid %d)\n", hipGetErrorString(e), grid);
#else
    for (int ph = 0; ph < NPHASE; ++ph) { a.ph_lo = ph; a.ph_hi = ph + 1; hipLaunchKernelGGL(fwd, dim3(grid), dim3(NTHR), LDS_BYTES, stream, a); }
#endif
}
```

```cpp
#define REPMASK 0
#include <hip/hip_runtime.h>
#include <hip/hip_cooperative_groups.h>
#include <cstdio>
#include <cstdint>
namespace cg = cooperative_groups;
#ifndef REPMASK
#define REPMASK 0
#endif

constexpr int NB = 8, SEQ = 2048, DM = 1024, M = NB * SEQ;
constexpr int DIN = 3080;
constexpr int N1 = 3072;
constexpr int PZ = 0, PX = 512, PQ = 1536, PK = 2048, PV = 2560;
constexpr int DFF = 2816, N3 = 2 * DFF;
constexpr int NH = 8, HD = 64, NST = 128, CH = 64, NCH = SEQ / CH;
constexpr float EPS = 1e-6f;
constexpr float LOG2E = 1.4426950408889634f;
constexpr float QSCALE = 0.125f * LOG2E;

constexpr size_t MiB = 1u << 20;
constexpr size_t WS_W1 = 0, WS_W2 = 6 * MiB, WS_W3 = 8 * MiB, WS_W4 = 19 * MiB;
constexpr size_t WS_DT = 25 * MiB;
constexpr size_t WS_CD = 25 * MiB + 512 * 1024;
constexpr size_t WS_H = 26 * MiB;
constexpr size_t WS_PROJ = 58 * MiB;
constexpr size_t WS_CS = 154 * MiB;
constexpr size_t WS_CTL = 218 * MiB;
constexpr size_t WS_PB = 219 * MiB;
constexpr size_t WS_END = 251 * MiB;

constexpr int LDS_BYTES = 147456;
constexpr int NTHR = 512, NWAVES = 8;

#define LAS __attribute__((address_space(3)))
typedef unsigned short bf16;
typedef unsigned v4u __attribute__((ext_vector_type(4)));
typedef unsigned v2u __attribute__((ext_vector_type(2)));
typedef float v4f __attribute__((ext_vector_type(4)));
typedef float f32x16 __attribute__((ext_vector_type(16)));

__device__ __forceinline__ unsigned f2bf(float f) { unsigned u = __builtin_bit_cast(unsigned, f); return (u + 0x7fffu + ((u >> 16) & 1u)) >> 16; }
typedef float f32x2_t __attribute__((ext_vector_type(2)));
typedef __bf16 bf16x2_t __attribute__((ext_vector_type(2)));
__device__ __forceinline__ unsigned cvtpk(float lo, float hi) { f32x2_t v = {lo, hi}; bf16x2_t b = __builtin_convertvector(v, bf16x2_t); return __builtin_bit_cast(unsigned, b); }
__device__ __forceinline__ unsigned pk2(float lo, float hi) { return cvtpk(lo, hi); }
__device__ __forceinline__ void wt8(void* p, unsigned lo, unsigned hi) { __hip_atomic_store((unsigned long long*)p, (unsigned long long)lo | ((unsigned long long)hi << 32), __ATOMIC_RELAXED, __HIP_MEMORY_SCOPE_AGENT); }
__device__ __forceinline__ __amdgpu_buffer_rsrc_t wt_rsrc(void* base, unsigned bytes) { return __builtin_amdgcn_make_buffer_rsrc(base, 0, (int)bytes, 0x00020000); }
__device__ __forceinline__ void wt16(__amdgpu_buffer_rsrc_t r, unsigned byte_off, v4u v) { __builtin_amdgcn_raw_buffer_store_b128(v, r, (int)byte_off, 0, 16); }
__device__ __forceinline__ float bf2f(unsigned b) { return __builtin_bit_cast(float, b << 16); }
__device__ __forceinline__ float bflo(unsigned w) { return __builtin_bit_cast(float, w << 16); }
__device__ __forceinline__ float bfhi(unsigned w) { return __builtin_bit_cast(float, w & 0xffff0000u); }
__device__ __forceinline__ float wave_sum(float v) {
#pragma unroll
    for (int o = 1; o < 64; o <<= 1) v += __shfl_xor(v, o);
    return v;
}
__device__ __forceinline__ float siluf(float v) { return v / (1.f + __expf(-v)); }
__device__ __forceinline__ float silu_fast(float v) { return v * __builtin_amdgcn_rcpf(1.f + __builtin_amdgcn_exp2f(-LOG2E * v)); }
__device__ __forceinline__ float softplusf(float v) { return fmaxf(v, 0.f) + log1pf(__expf(-fabsf(v))); }

namespace pg8 {
#define PG8_LAS __attribute__((address_space(3)))
typedef unsigned short bf16_t;
typedef short bf16x8 __attribute__((ext_vector_type(8)));
typedef float f32x4 __attribute__((ext_vector_type(4)));
typedef unsigned u32x4 __attribute__((ext_vector_type(4)));
constexpr int BM = 256, BK = 64, HALF = 128, HTB = HALF * BK * 2  , STAGE_BYTES = 8 * HTB, NXCD = 8, WGM = 8;

__host__ __device__ __forceinline__ int lds_byte(int r, int c) { const int st = (r >> 4) * 2 + (c >> 5), rr = r & 15, cc = c & 31, ob = rr * 64 + cc * 2; return st * 1024 + (ob ^ (((ob >> 9) & 1) << 5)); }
__host__ __device__ __forceinline__ void stage_rc(int b, int& R, int& C) { const int st = b / 1024, sb = b % 1024, swz = sb ^ (((sb >> 9) & 1) << 5); R = (st >> 1) * 16 + swz / 64; C = (st & 1) * 32 + (swz % 64) / 2; }
__host__ __device__ __forceinline__ int perm32(int rho) { const int n = rho >> 4, i = rho & 15; return 8 * (i >> 2) + 4 * n + (i & 3); }

struct Unit { int pm, pn; };
struct Gemm { const bf16_t* A; const bf16_t* Bt; int M, N, K; size_t agap; };

struct StaticOrder {
    int nM, nN, nwg, G, c;
    __host__ __device__ void init(int M, int N, int G_, int c_) { nM = M / BM; nN = N / BM; nwg = nM * nN; G = G_; c = c_; }
    __host__ __device__ bool next(int i, Unit& u) const {
        const long L = (long)i * G + c; if (L >= nwg) return false;
        int wgid = (int)L; { const int q = nwg / NXCD, r = nwg % NXCD, xcd = wgid % NXCD, off = wgid / NXCD; wgid = (xcd < r ? xcd * (q + 1) : r * (q + 1) + (xcd - r) * q) + off; }
        const int nig = WGM * nN, gid = wgid / nig, fm = gid * WGM, gsz = (nM - fm) < WGM ? (nM - fm) : WGM;
        u.pm = fm + ((wgid % nig) % gsz); u.pn = (wgid % nig) / gsz; return true;
    }
    __device__ __forceinline__ void a_ready(const Unit&) const {}
    __device__ __forceinline__ void done(const Unit&) const {}
};

__device__ __forceinline__ unsigned cvt_pk_bf16(float lo, float hi) { unsigned r; asm volatile("v_cvt_pk_bf16_f32 %0, %1, %2" : "=v"(r) : "v"(lo), "v"(hi)); return r; }
template <class Epi, class Sched, bool ALIGN_EPI = false, bool SP2 = false>
__device__ __forceinline__ void gemm_phase(PG8_LAS unsigned char* lds, const Gemm g, const Sched& S, const Epi& E) {
    const int tid = threadIdx.x, wid = __builtin_amdgcn_readfirstlane(tid >> 6), lane = tid & 63, wr = wid >> 2, wc = wid & 3, fr = lane & 15, fq = lane >> 4;
    const int K = g.K, nt = K / BK;
    unsigned voffA[2], voffB[2];
#pragma unroll
    for (int i = 0; i < 2; ++i) { int R, C; stage_rc(tid * 16 + i * 8192, R, C); const int Rb = Epi::PERM ? ((R & ~31) + perm32(R & 31)) : R;
        voffA[i] = (unsigned)(R * K + C) * 2u; voffB[i] = (unsigned)(Rb * K + C) * 2u; }
    const size_t kstep = (size_t)(BK * 2);
    const size_t hstep = (size_t)HALF * K * 2;
    const size_t tstep = 2 * hstep;
    const unsigned ldsw = (unsigned)wid * 1024u;
    const int aoff = lds_byte(wr * 64 + fr, fq * 8), boff = lds_byte(wc * 32 + fr, fq * 8);
#define PG8_SA(b, h) (((b) * 2 + (h)) * HTB)
#define PG8_SB(b, h) ((4 + (b) * 2 + (h)) * HTB)
#define PG8_STAGE(bufoff, gbase, voff) do { _Pragma("unroll") for (int _i = 0; _i < 2; ++_i) \
        __builtin_amdgcn_global_load_lds((const unsigned*)((const char*)(gbase) + (voff)[_i]), (PG8_LAS unsigned*)(lds + (bufoff) + ldsw + _i * 8192), 16, 0, 0); } while (0)
#define PG8_LDA(dst, b, h) do { _Pragma("unroll") for (int m = 0; m < 4; ++m) _Pragma("unroll") for (int k = 0; k < 2; ++k) dst[m][k] = *(const PG8_LAS bf16x8*)(lds + PG8_SA(b, h) + aoff + m * 2048 + k * 1024); } while (0)
#define PG8_LDB(dst, b, h) do { _Pragma("unroll") for (int n = 0; n < 2; ++n) _Pragma("unroll") for (int k = 0; k < 2; ++k) dst[n][k] = *(const PG8_LAS bf16x8*)(lds + PG8_SB(b, h) + boff + n * 2048 + k * 1024); } while (0)
#define PG8_MMA(ai, bj, At, Bt) do { __builtin_amdgcn_s_setprio(1); _Pragma("unroll") for (int m = 0; m < 4; ++m) _Pragma("unroll") for (int n = 0; n < 2; ++n) _Pragma("unroll") for (int k = 0; k < 2; ++k) \
        acc[ai][bj][m][n] = __builtin_amdgcn_mfma_f32_16x16x32_bf16(Bt[n][k], At[m][k], acc[ai][bj][m][n], 0, 0, 0); __builtin_amdgcn_s_setprio(0); } while (0)
#define PG8_WAIT_V(n) asm volatile("s_waitcnt vmcnt(" #n ")" ::: "memory")
#define PG8_WAIT_L(n) asm volatile("s_waitcnt lgkmcnt(" #n ")" ::: "memory")
#define PG8_BAR __builtin_amdgcn_s_barrier()
#define PG8_SCHED __builtin_amdgcn_sched_barrier(0)
    Unit cur, nxt; int ui = 0;
    if (!S.next(0, cur)) return;
    f32x4 acc[2][2][4][2];
#pragma unroll
    for (int a = 0; a < 2; ++a)
#pragma unroll
        for (int b = 0; b < 2; ++b)
#pragma unroll
            for (int m = 0; m < 4; ++m)
#pragma unroll
                for (int n = 0; n < 2; ++n) acc[a][b][m][n] = (f32x4){0.f, 0.f, 0.f, 0.f};
    bf16x8 At[4][2], B0[2][2], B1[2][2];
    const char* cA = (const char*)g.A + (size_t)cur.pm * tstep + (size_t)(cur.pm >> 3) * g.agap; const char* cB = (const char*)g.Bt + (size_t)cur.pn * tstep;
    S.a_ready(cur);
    if constexpr (SP2) {
        PG8_STAGE(PG8_SB(0, 0), cB, voffB); PG8_STAGE(PG8_SB(0, 1), cB + hstep, voffB); PG8_STAGE(PG8_SA(0, 0), cA, voffA); PG8_STAGE(PG8_SA(0, 1), cA + hstep, voffA);
        if (wr == 1) PG8_BAR;
        PG8_WAIT_V(2); PG8_BAR;
        PG8_STAGE(PG8_SB(1, 0), cB + kstep, voffB); PG8_STAGE(PG8_SA(1, 0), cA + kstep, voffA); PG8_STAGE(PG8_SB(1, 1), cB + hstep + kstep, voffB);
        PG8_WAIT_V(6); PG8_BAR;
    } else {
        PG8_STAGE(PG8_SB(0, 0), cB, voffB); PG8_STAGE(PG8_SA(0, 0), cA, voffA); PG8_STAGE(PG8_SB(0, 1), cB + hstep, voffB); PG8_STAGE(PG8_SA(0, 1), cA + hstep, voffA);
        if (wr == 1) PG8_BAR;
        PG8_WAIT_V(4); PG8_BAR;
        PG8_STAGE(PG8_SB(1, 0), cB + kstep, voffB); PG8_STAGE(PG8_SA(1, 0), cA + kstep, voffA); PG8_STAGE(PG8_SB(1, 1), cB + hstep + kstep, voffB);
        PG8_WAIT_V(6); PG8_BAR;
    }
    for (;;) {
        const bool has_next = S.next(ui + 1, nxt);
        const char* nA = has_next ? (const char*)g.A + (size_t)nxt.pm * tstep + (size_t)(nxt.pm >> 3) * g.agap : cA; const char* nB = has_next ? (const char*)g.Bt + (size_t)nxt.pn * tstep : cB;
        for (int t = 0; t < nt; t += 2) {
            const bool last = (t == nt - 2);
            const char* a1 = cA + (size_t)(t + 1) * kstep;
            const char* a2 = last ? nA : cA + (size_t)(t + 2) * kstep; const char* b2 = last ? nB : cB + (size_t)(t + 2) * kstep;
            const char* a3 = a2 + kstep; const char* b3 = b2 + kstep;
            if (last && has_next) S.a_ready(nxt);
            if constexpr (SP2) {
            PG8_LDB(B0, 0, 0); PG8_LDB(B1, 0, 1); PG8_SCHED; PG8_LDA(At, 0, 0); PG8_STAGE(PG8_SA(1, 1), a1 + hstep, voffA);
            PG8_WAIT_V(8); PG8_WAIT_L(0); PG8_BAR; PG8_MMA(0, 0, At, B0); PG8_MMA(0, 1, At, B1); PG8_BAR; PG8_SCHED;
            PG8_LDA(At, 0, 1); PG8_STAGE(PG8_SB(0, 0), b2, voffB); PG8_STAGE(PG8_SB(0, 1), b2 + hstep, voffB); PG8_STAGE(PG8_SA(0, 0), a2, voffA);
            PG8_WAIT_V(8); PG8_WAIT_L(0); PG8_BAR; PG8_MMA(1, 0, At, B0); PG8_MMA(1, 1, At, B1); PG8_BAR; PG8_SCHED;
            PG8_LDB(B0, 1, 0); PG8_LDB(B1, 1, 1); PG8_SCHED; PG8_LDA(At, 1, 0); PG8_STAGE(PG8_SA(0, 1), a2 + hstep, voffA);
            PG8_WAIT_V(8); PG8_WAIT_L(0); PG8_BAR; PG8_MMA(0, 0, At, B0); PG8_MMA(0, 1, At, B1); PG8_BAR; PG8_SCHED;
            PG8_LDA(At, 1, 1); PG8_STAGE(PG8_SB(1, 0), b3, voffB); PG8_STAGE(PG8_SB(1, 1), b3 + hstep, voffB); PG8_STAGE(PG8_SA(1, 0), a3, voffA);
            PG8_WAIT_V(8); PG8_WAIT_L(0); PG8_BAR; PG8_MMA(1, 0, At, B0); PG8_MMA(1, 1, At, B1); PG8_BAR; PG8_SCHED;
            } else {
            PG8_LDB(B0, 0, 0); PG8_SCHED; PG8_LDA(At, 0, 0); PG8_STAGE(PG8_SA(1, 1), a1 + hstep, voffA);
            PG8_WAIT_L(8); PG8_BAR; PG8_WAIT_L(0); PG8_MMA(0, 0, At, B0); PG8_BAR; PG8_SCHED;
            PG8_LDB(B1, 0, 1); PG8_STAGE(PG8_SB(0, 0), b2, voffB);
            PG8_BAR; PG8_WAIT_L(0); PG8_MMA(0, 1, At, B1); PG8_BAR;
            PG8_LDA(At, 0, 1); PG8_STAGE(PG8_SA(0, 0), a2, voffA);
            PG8_BAR; PG8_WAIT_L(0); PG8_MMA(1, 0, At, B0); PG8_BAR; PG8_SCHED;
            PG8_STAGE(PG8_SB(0, 1), b2 + hstep, voffB);
            PG8_WAIT_V(6); PG8_BAR; PG8_MMA(1, 1, At, B1); PG8_BAR;
            PG8_LDB(B0, 1, 0); PG8_SCHED; PG8_LDA(At, 1, 0); PG8_STAGE(PG8_SA(0, 1), a2 + hstep, voffA);
            PG8_WAIT_L(8); PG8_BAR; PG8_WAIT_L(0); PG8_MMA(0, 0, At, B0); PG8_BAR; PG8_SCHED;
            PG8_LDB(B1, 1, 1); PG8_STAGE(PG8_SB(1, 0), b3, voffB);
            PG8_BAR; PG8_WAIT_L(0); PG8_MMA(0, 1, At, B1); PG8_BAR;
            PG8_LDA(At, 1, 1); PG8_STAGE(PG8_SA(1, 0), a3, voffA);
            PG8_BAR; PG8_WAIT_L(0); PG8_MMA(1, 0, At, B0); PG8_BAR; PG8_SCHED;
            PG8_STAGE(PG8_SB(1, 1), b3 + hstep, voffB);
            PG8_WAIT_V(6); PG8_BAR; PG8_MMA(1, 1, At, B1); PG8_BAR;
            }
        }
        if constexpr (ALIGN_EPI) { if (wr == 0) PG8_BAR; }
        if constexpr (!Epi::AFTER_DRAIN) { E(acc, cur, wr, wc, fr, fq); S.done(cur); }
        if (!has_next) break;
#pragma unroll
        for (int a = 0; a < 2; ++a)
#pragma unroll
            for (int b = 0; b < 2; ++b)
#pragma unroll
                for (int m = 0; m < 4; ++m)
#pragma unroll
                    for (int n = 0; n < 2; ++n) acc[a][b][m][n] = (f32x4){0.f, 0.f, 0.f, 0.f};
        cur = nxt; cA = nA; cB = nB; ++ui;
        if constexpr (ALIGN_EPI) { if (wr == 1) PG8_BAR; }
    }
    PG8_WAIT_V(0);
    if constexpr (!ALIGN_EPI) { if (wr == 0) PG8_BAR; }
    PG8_BAR;
    if constexpr (Epi::AFTER_DRAIN) { E.fused(acc, cur, wr, wc, fr, fq, lds, wid, lane); S.done(cur); }
#undef PG8_SA
#undef PG8_SB
#undef PG8_STAGE
#undef PG8_LDA
#undef PG8_LDB
#undef PG8_MMA
#undef PG8_WAIT_V
#undef PG8_WAIT_L
#undef PG8_BAR
#undef PG8_SCHED
}
}

namespace pg8 {
struct EpiProj {
    static constexpr bool PERM = true, AFTER_DRAIN = false;
    bf16_t* O;
    __device__ __forceinline__ void operator()(const f32x4 (&acc)[2][2][4][2], const Unit& u, int wr, int wc, int fr, int fq) const {
        const int row0 = u.pm * BM + wr * 64 + fr, col0 = u.pn * BM + wc * 32 + 8 * fq;
        const float sc = (u.pn == 6 || u.pn == 7) ? QSCALE : 1.f;
        const __amdgpu_buffer_rsrc_t rs = wt_rsrc(O, (unsigned)((size_t)16384 * N1 * 2));
#pragma unroll
        for (int ai = 0; ai < 2; ++ai)
#pragma unroll
            for (int m = 0; m < 4; ++m) { const unsigned rowb = (unsigned)(((size_t)(row0 + ai * HALF + m * 16) * N1 + col0) * 2);
#pragma unroll
                for (int bj = 0; bj < 2; ++bj) { const f32x4 v0 = acc[ai][bj][m][0] * sc, v1 = acc[ai][bj][m][1] * sc;
                    u32x4 w; w.x = cvt_pk_bf16(v0[0], v0[1]); w.y = cvt_pk_bf16(v0[2], v0[3]); w.z = cvt_pk_bf16(v1[0], v1[1]); w.w = cvt_pk_bf16(v1[2], v1[3]);
                    wt16(rs, rowb + bj * HALF * 2, w); } }
    }
};
struct EpiBf16 {
    static constexpr bool PERM = true, AFTER_DRAIN = false;
    bf16_t* O; int ldc;
    __device__ __forceinline__ void operator()(const f32x4 (&acc)[2][2][4][2], const Unit& u, int wr, int wc, int fr, int fq) const {
        const int row0 = u.pm * BM + wr * 64 + fr, col0 = u.pn * BM + wc * 32 + 8 * fq;
#pragma unroll
        for (int ai = 0; ai < 2; ++ai)
#pragma unroll
            for (int m = 0; m < 4; ++m) { bf16_t* rowp = O + (size_t)(row0 + ai * HALF + m * 16) * ldc + col0;
#pragma unroll
                for (int bj = 0; bj < 2; ++bj) { const f32x4 v0 = acc[ai][bj][m][0], v1 = acc[ai][bj][m][1];
                    u32x4 w; w.x = cvt_pk_bf16(v0[0], v0[1]); w.y = cvt_pk_bf16(v0[2], v0[3]); w.z = cvt_pk_bf16(v1[0], v1[1]); w.w = cvt_pk_bf16(v1[2], v1[3]);
                    *(u32x4*)(rowp + bj * HALF) = w; } }
    }
};
__device__ __forceinline__ void rms_exchange(const f32x4 (&v)[2][2][4][2], const Unit& u, int wr, int wc, int fr, int fq, PG8_LAS unsigned char* lds, int wid, int lane, float* xbuf, unsigned* cnt) {
    PG8_LAS float* P = (PG8_LAS float*)lds;
    PG8_LAS float* S = (PG8_LAS float*)(lds + 4096);
#pragma unroll
    for (int ai = 0; ai < 2; ++ai)
#pragma unroll
        for (int m = 0; m < 4; ++m) {
            float s = 0.f;
#pragma unroll
            for (int bj = 0; bj < 2; ++bj)
#pragma unroll
                for (int n = 0; n < 2; ++n) { const f32x4 x = v[ai][bj][m][n]; s += (x[0] * x[0] + x[1] * x[1]) + (x[2] * x[2] + x[3] * x[3]); }
            s += __shfl_xor(s, 16); s += __shfl_xor(s, 32);
            if (fq == 0) P[(ai * HALF + wr * 64 + m * 16 + fr) * 4 + wc] = s;
        }
    asm volatile("s_waitcnt lgkmcnt(0)" ::: "memory"); __builtin_amdgcn_s_barrier(); asm volatile("" ::: "memory");
    const int row = wid * 32 + (lane & 31);
    if (lane < 32) {
        const float tot = (P[row * 4 + 0] + P[row * 4 + 1]) + (P[row * 4 + 2] + P[row * 4 + 3]);
        __hip_atomic_store((unsigned*)xbuf + (size_t)(u.pm * BM + row) * 4 + u.pn, __builtin_bit_cast(unsigned, tot), __ATOMIC_RELAXED, __HIP_MEMORY_SCOPE_AGENT);
    }
    asm volatile("s_waitcnt vmcnt(0)" ::: "memory");
    if (lane == 0) __hip_atomic_fetch_add(cnt + 64 * u.pm, 1u, __ATOMIC_RELAXED, __HIP_MEMORY_SCOPE_AGENT);
    if (wid == 0) {
        unsigned sp = 0u;
        while ((unsigned)__builtin_amdgcn_readfirstlane(__hip_atomic_load(cnt + 64 * u.pm, __ATOMIC_RELAXED, __HIP_MEMORY_SCOPE_AGENT)) < 32u) { __builtin_amdgcn_s_sleep(2); if (++sp > (1u << 22)) break; }
        __builtin_amdgcn_fence(__ATOMIC_ACQUIRE, "agent");
    }
    asm volatile("s_waitcnt vmcnt(0) lgkmcnt(0)" ::: "memory"); __builtin_amdgcn_s_barrier(); asm volatile("" ::: "memory");
    if (lane < 32) {
        const unsigned* slot = (const unsigned*)xbuf + (size_t)(u.pm * BM + row) * 4; float q = 0.f;
#pragma unroll
        for (int t = 0; t < 4; ++t) q += __builtin_bit_cast(float, __hip_atomic_load(slot + t, __ATOMIC_RELAXED, __HIP_MEMORY_SCOPE_AGENT));
        S[row] = rsqrtf(q * (1.f / 1024.f) + 1e-6f);
    }
    asm volatile("s_waitcnt vmcnt(0) lgkmcnt(0)" ::: "memory"); __builtin_amdgcn_s_barrier(); asm volatile("" ::: "memory");
}
struct EpiRmsRes {
    static constexpr bool PERM = false, AFTER_DRAIN = true;
    const bf16_t* x1b; float* out; const float* gain; float* xbuf; unsigned* cnt;
    __device__ __forceinline__ void fused(f32x4 (&acc)[2][2][4][2], const Unit& u, int wr, int wc, int fr, int fq, PG8_LAS unsigned char* lds, int wid, int lane) const {
        typedef unsigned u32x2v __attribute__((ext_vector_type(2)));
        const PG8_LAS float* S = (const PG8_LAS float*)(lds + 4096);
        const int col0 = u.pn * BM + wc * 32 + 4 * fq;
        u32x2v pre[2][4][2][2];
#pragma unroll
        for (int ai = 0; ai < 2; ++ai)
#pragma unroll
            for (int m = 0; m < 4; ++m) { const size_t off = (size_t)(u.pm * BM + ai * HALF + wr * 64 + m * 16 + fr) * 1024 + col0;
#pragma unroll
                for (int bj = 0; bj < 2; ++bj)
#pragma unroll
                    for (int n = 0; n < 2; ++n) pre[ai][m][bj][n] = *(const u32x2v*)(x1b + off + bj * HALF + n * 16); }
        rms_exchange(acc, u, wr, wc, fr, fq, lds, wid, lane, xbuf, cnt);
        f32x4 gv[2][2];
#pragma unroll
        for (int bj = 0; bj < 2; ++bj)
#pragma unroll
            for (int n = 0; n < 2; ++n) gv[bj][n] = *(const f32x4*)(gain + col0 + bj * HALF + n * 16);
#pragma unroll
        for (int ai = 0; ai < 2; ++ai)
#pragma unroll
            for (int m = 0; m < 4; ++m) { const int r = ai * HALF + wr * 64 + m * 16 + fr; const float rs = S[r]; const size_t off = (size_t)(u.pm * BM + r) * 1024 + col0;
#pragma unroll
                for (int bj = 0; bj < 2; ++bj)
#pragma unroll
                    for (int n = 0; n < 2; ++n) { const u32x2v pv = pre[ai][m][bj][n];
                        const f32x4 bs = {__builtin_bit_cast(float, pv.x << 16), __builtin_bit_cast(float, pv.x & 0xffff0000u), __builtin_bit_cast(float, pv.y << 16), __builtin_bit_cast(float, pv.y & 0xffff0000u)};
                        *(f32x4*)(out + off + bj * HALF + n * 16) = bs + acc[ai][bj][m][n] * rs * gv[bj][n]; } }
    }
};
struct EpiRmsResRms {
    static constexpr bool PERM = false, AFTER_DRAIN = true;
    const float* x; bf16_t* x1b; bf16_t* h2; const float* g1; const float* g2; float* xbuf1; unsigned* cnt1; float* xbuf2; unsigned* cnt2;
    __device__ __forceinline__ void fused(f32x4 (&acc)[2][2][4][2], const Unit& u, int wr, int wc, int fr, int fq, PG8_LAS unsigned char* lds, int wid, int lane) const {
        typedef unsigned u32x2v __attribute__((ext_vector_type(2)));
        const PG8_LAS float* S = (const PG8_LAS float*)(lds + 4096);
        const int col0 = u.pn * BM + wc * 32 + 4 * fq;
        rms_exchange(acc, u, wr, wc, fr, fq, lds, wid, lane, xbuf1, cnt1);
        {
            f32x4 gv[2][2];
#pragma unroll
            for (int bj = 0; bj < 2; ++bj)
#pragma unroll
                for (int n = 0; n < 2; ++n) gv[bj][n] = *(const f32x4*)(g1 + col0 + bj * HALF + n * 16);
#pragma unroll
            for (int ai = 0; ai < 2; ++ai)
#pragma unroll
                for (int m = 0; m < 4; ++m) { const int r = ai * HALF + wr * 64 + m * 16 + fr; const float rs = S[r]; const size_t off = (size_t)(u.pm * BM + r) * 1024 + col0;
#pragma unroll
                    for (int bj = 0; bj < 2; ++bj)
#pragma unroll
                        for (int n = 0; n < 2; ++n) { const f32x4 bs = *(const f32x4*)(x + off + bj * HALF + n * 16); acc[ai][bj][m][n] = bs + acc[ai][bj][m][n] * rs * gv[bj][n]; }
                    asm volatile("" : "+v"(acc[ai][0][m][0]), "+v"(acc[ai][0][m][1]), "+v"(acc[ai][1][m][0]), "+v"(acc[ai][1][m][1]));
                    if (m & 1) asm volatile("" ::: "memory"); }
        }
        rms_exchange(acc, u, wr, wc, fr, fq, lds, wid, lane, xbuf2, cnt2);
        f32x4 gv[2][2];
#pragma unroll
        for (int bj = 0; bj < 2; ++bj)
#pragma unroll
            for (int n = 0; n < 2; ++n) gv[bj][n] = *(const f32x4*)(g2 + col0 + bj * HALF + n * 16);
#pragma unroll
        for (int ai = 0; ai < 2; ++ai)
#pragma unroll
            for (int m = 0; m < 4; ++m) { const int r = ai * HALF + wr * 64 + m * 16 + fr; const float rs = S[r]; const size_t off = (size_t)(u.pm * BM + r) * 1024 + col0;
#pragma unroll
                for (int bj = 0; bj < 2; ++bj)
#pragma unroll
                    for (int n = 0; n < 2; ++n) { const f32x4 x1 = acc[ai][bj][m][n]; { u32x2v xw; xw.x = cvt_pk_bf16(x1[0], x1[1]); xw.y = cvt_pk_bf16(x1[2], x1[3]); *(u32x2v*)(x1b + off + bj * HALF + n * 16) = xw; }
                        const f32x4 o = x1 * rs * gv[bj][n]; u32x2v w; w.x = cvt_pk_bf16(o[0], o[1]); w.y = cvt_pk_bf16(o[2], o[3]); *(u32x2v*)(h2 + off + bj * HALF + n * 16) = w; }
                asm volatile("" ::: "memory"); }
    }
};
struct EpiF32 {
    static constexpr bool PERM = true, AFTER_DRAIN = false;
    float* O; int ldc;
    __device__ __forceinline__ void operator()(const f32x4 (&acc)[2][2][4][2], const Unit& u, int wr, int wc, int fr, int fq) const {
        const int row0 = u.pm * BM + wr * 64 + fr, col0 = u.pn * BM + wc * 32 + 8 * fq;
#pragma unroll
        for (int ai = 0; ai < 2; ++ai)
#pragma unroll
            for (int m = 0; m < 4; ++m) { float* rowp = O + (size_t)(row0 + ai * HALF + m * 16) * ldc + col0;
#pragma unroll
                for (int bj = 0; bj < 2; ++bj) { *(f32x4*)(rowp + bj * HALF) = acc[ai][bj][m][0]; *(f32x4*)(rowp + bj * HALF + 4) = acc[ai][bj][m][1]; } }
    }
};
struct EpiSwiglu {
    static constexpr bool PERM = true, AFTER_DRAIN = false;
    bf16_t* O;
    __device__ __forceinline__ void operator()(const f32x4 (&acc)[2][2][4][2], const Unit& u, int wr, int wc, int fr, int fq) const {
        const int row0 = u.pm * BM + wr * 64 + fr, col0 = u.pn * HALF + wc * 32 + 8 * fq;
        const __amdgpu_buffer_rsrc_t rs = wt_rsrc(O, 96u << 20);
        const unsigned bshift = (unsigned)(u.pm >> 3) << 20;
#pragma unroll
        for (int ai = 0; ai < 2; ++ai)
#pragma unroll
            for (int m = 0; m < 4; ++m) { const unsigned rowb = (unsigned)(((size_t)(row0 + ai * HALF + m * 16) * DFF + col0) * 2) + bshift;
                float r[8];
#pragma unroll
                for (int n = 0; n < 2; ++n)
#pragma unroll
                    for (int e = 0; e < 4; ++e) { const float g = acc[ai][0][m][n][e], up = acc[ai][1][m][n][e];
                        r[4 * n + e] = g * __builtin_amdgcn_rcpf(1.f + __expf(-g)) * up; }
                u32x4 w; w.x = cvt_pk_bf16(r[0], r[1]); w.y = cvt_pk_bf16(r[2], r[3]); w.z = cvt_pk_bf16(r[4], r[5]); w.w = cvt_pk_bf16(r[6], r[7]);
                wt16(rs, rowb, w); }
    }
};
}

struct Args {
    const float* x; const float* pre_mix_gain; const float* w_in; const float* conv_w; const float* conv_b; const float* dt_bias; const float* a_log; const float* d_skip;
    const float* ssd_norm_gain; const float* sb_norm_gain; const float* w_out; const float* post_mix_gain; const float* pre_ffn_gain; const float* w_gate; const float* w_up;
    const float* w_down; const float* post_ffn_gain; float* out; unsigned char* ws; int ph_lo, ph_hi;
};

__device__ __forceinline__ void transpose_item(const float* src, int ldw, bf16* dst, int K, LAS float* scr, int lane, __amdgpu_buffer_rsrc_t wr, const bf16* wbase) {
    float tv[32];
#pragma unroll
    for (int i = 0; i < 32; ++i) tv[i] = src[(size_t)(2 * i + (lane >> 5)) * ldw + (lane & 31)];
#pragma unroll
    for (int i = 0; i < 32; ++i) scr[(2 * i + (lane >> 5)) * 33 + (lane & 31)] = tv[i];
    asm volatile("s_waitcnt lgkmcnt(0)" ::: "memory");
    const int c = lane & 7;
#pragma unroll
    for (int j = 0; j < 4; ++j) { const int n = (lane >> 3) + 8 * j; const LAS float* s = scr + (8 * c) * 33 + n;
        v4u o; o.x = pk2(s[0 * 33], s[1 * 33]); o.y = pk2(s[2 * 33], s[3 * 33]); o.z = pk2(s[4 * 33], s[5 * 33]); o.w = pk2(s[6 * 33], s[7 * 33]);
        wt16(wr, (unsigned)((dst + (size_t)n * K + 8 * c - wbase) * 2), o); }
    asm volatile("s_waitcnt lgkmcnt(0)" ::: "memory");
}

__device__ __forceinline__ void phase_p0(const Args& a, LAS unsigned char* lds, bool defer_w4) {
    const int tid = threadIdx.x, lane = tid & 63, wave = tid >> 6;
    const int gw = blockIdx.x * NWAVES + wave, NGW = gridDim.x * NWAVES;
    unsigned char* ws = a.ws;
    LAS float* scr = (LAS float*)(lds + wave * 8704);
    LAS float* wdt = (LAS float*)(lds + 73728);
    for (int i = tid; i < 8192; i += NTHR) { const int hd = i & 7, k = i >> 3; wdt[hd * 1024 + k] = a.w_in[(size_t)k * DIN + 1536 + hd]; }
    __syncthreads();
    bf16* W1 = (bf16*)(ws + WS_W1); bf16* W2 = (bf16*)(ws + WS_W2); bf16* W3 = (bf16*)(ws + WS_W3); bf16* W4 = (bf16*)(ws + WS_W4);
    const __amdgpu_buffer_rsrc_t wrs = wt_rsrc(W1, 25u << 20);
    constexpr int I1 = 16 * 48, I2 = 16 * 32, I3 = 16 * 88, I4 = 44 * 32;
    const int NITEMS = 2 * I1 + I2 + 2 * I3 + (defer_w4 ? 0 : I4);
    for (int _rp = 0; _rp < 1 + (((REPMASK) >> 12) & 1); ++_rp)
    for (int it = gw; it < NITEMS; it += NGW) {
        int r = it;
        if (r < I1) { const int kb = r / 48, nb = r % 48; transpose_item(a.w_in + (size_t)(64 * kb) * DIN + 32 * nb, DIN, W1 + (size_t)(32 * nb) * 1024 + 64 * kb, 1024, scr, lane, wrs, W1); continue; } r -= I1;
        if (r < I1) { const int kb = r / 48, nb = r % 48; transpose_item(a.w_in + (size_t)(64 * kb) * DIN + 1544 + 32 * nb, DIN, W1 + (size_t)(1536 + 32 * nb) * 1024 + 64 * kb, 1024, scr, lane, wrs, W1); continue; } r -= I1;
        if (r < I2) { const int kb = r / 32, nb = r % 32; transpose_item(a.w_out + (size_t)(64 * kb) * 1024 + 32 * nb, 1024, W2 + (size_t)(32 * nb) * 1024 + 64 * kb, 1024, scr, lane, wrs, W1); continue; } r -= I2;
        if (r < I3) { const int kb = r / 88, nb = r % 88, n0 = 32 * nb; transpose_item(a.w_gate + (size_t)(64 * kb) * DFF + n0, DFF, W3 + (size_t)(256 * (n0 >> 7) + (n0 & 127)) * 1024 + 64 * kb, 1024, scr, lane, wrs, W1); continue; } r -= I3;
        if (r < I3) { const int kb = r / 88, nb = r % 88, n0 = 32 * nb; transpose_item(a.w_up + (size_t)(64 * kb) * DFF + n0, DFF, W3 + (size_t)(256 * (n0 >> 7) + 128 + (n0 & 127)) * 1024 + 64 * kb, 1024, scr, lane, wrs, W1); continue; } r -= I3;
        { const int kb = r / 32, nb = r % 32; transpose_item(a.w_down + (size_t)(64 * kb) * 1024 + 32 * nb, 1024, W4 + (size_t)(32 * nb) * DFF + 64 * kb, DFF, scr, lane, wrs, W1); }
    }
    bf16* H = (bf16*)(ws + WS_H); float* DT = (float*)(ws + WS_DT);
    const int hh = lane >> 5, b4 = (lane >> 4) & 1, b3 = (lane >> 3) & 1;
    v4f gpm[4];
#pragma unroll
    for (int j = 0; j < 4; ++j) gpm[j] = ((const v4f*)a.pre_mix_gain)[lane + 64 * j];
    v4f v[4], vn[4];
    if (gw < M) {
#pragma unroll
        for (int j = 0; j < 4; ++j) v[j] = ((const v4f*)(a.x + (size_t)gw * DM))[lane + 64 * j];
    }
    for (int _rq = 0; _rq < 1 + (((REPMASK) >> 13) & 1); ++_rq)
    for (int m = gw; m < M; m += NGW) {
        const int mn = m + NGW < M ? m + NGW : gw;
        if (true) {
#pragma unroll
            for (int j = 0; j < 4; ++j) vn[j] = ((const v4f*)(a.x + (size_t)mn * DM))[lane + 64 * j];
        }
        float s = 0.f;
#pragma unroll
        for (int j = 0; j < 4; ++j) s += (v[j].x * v[j].x + v[j].y * v[j].y) + (v[j].z * v[j].z + v[j].w * v[j].w);
        const float rstd = rsqrtf(wave_sum(s) * (1.f / DM) + EPS);
        float da[8];
#pragma unroll
        for (int hd = 0; hd < 8; ++hd) da[hd] = 0.f;
        unsigned long long* o8 = (unsigned long long*)(H + (size_t)m * DM) + lane;
#pragma unroll
        for (int j = 0; j < 4; ++j) {
            const v4f hv = v[j] * rstd * gpm[j];
            wt8(o8 + 64 * j, pk2(hv.x, hv.y), pk2(hv.z, hv.w));
#pragma unroll
            for (int hd = 0; hd < 8; ++hd) { const v4f w = *(const LAS v4f*)(wdt + hd * 1024 + 4 * lane + 256 * j); da[hd] += (hv.x * w.x + hv.y * w.y) + (hv.z * w.z + hv.w * w.w); }
        }
        float k4[4], k2[2], k1;
#pragma unroll
        for (int i = 0; i < 4; ++i) { const float keep = hh ? da[4 + i] : da[i], send = hh ? da[i] : da[4 + i]; k4[i] = keep + __shfl_xor(send, 32); }
#pragma unroll
        for (int i = 0; i < 2; ++i) { const float keep = b4 ? k4[2 + i] : k4[i], send = b4 ? k4[i] : k4[2 + i]; k2[i] = keep + __shfl_xor(send, 16); }
        { const float keep = b3 ? k2[1] : k2[0], send = b3 ? k2[0] : k2[1]; k1 = keep + __shfl_xor(send, 8); }
        k1 += __shfl_xor(k1, 4); k1 += __shfl_xor(k1, 2); k1 += __shfl_xor(k1, 1);
        if ((lane & 7) == 0) DT[(size_t)m * 8 + (lane >> 3)] = k1;
#pragma unroll
        for (int j = 0; j < 4; ++j) v[j] = vn[j];
    }
}

__device__ __forceinline__ void phase_w4(const Args& a, LAS unsigned char* lds) {
    if (blockIdx.x < 128) return;
    const int lane = threadIdx.x & 63, wave = threadIdx.x >> 6, gw = (blockIdx.x - 128) * NWAVES + wave, NGW = 128 * NWAVES;
    LAS float* scr = (LAS float*)(lds + wave * 8704);
    bf16* W1 = (bf16*)(a.ws + WS_W1); bf16* W4 = (bf16*)(a.ws + WS_W4);
    const __amdgpu_buffer_rsrc_t wrs = wt_rsrc(W1, 25u << 20);
    for (int r = gw; r < 44 * 32; r += NGW) { const int kb = r / 32, nb = r % 32; transpose_item(a.w_down + (size_t)(64 * kb) * 1024 + 32 * nb, 1024, W4 + (size_t)(32 * nb) * DFF + 64 * kb, DFF, scr, lane, wrs, W1); }
}

__device__ __forceinline__ void phase_conv_naive(const Args& a) {
    const bf16* PROJ = (const bf16*)(a.ws + WS_PROJ); float* XC = (float*)(a.ws + WS_CS);
    const size_t total = (size_t)M * 1024, stride = (size_t)gridDim.x * NTHR;
    for (size_t idx = (size_t)blockIdx.x * NTHR + threadIdx.x; idx < total; idx += stride) {
        const int m = (int)(idx >> 10), ch = (int)(idx & 1023), t = m & (SEQ - 1);
        float acc = a.conv_b[ch];
#pragma unroll
        for (int j = 0; j < 4; ++j) { const int tt = t - 3 + j; if (tt >= 0) acc += a.conv_w[j * 1024 + ch] * bf2f(PROJ[(size_t)(m - 3 + j) * N1 + PX + ch]); }
        XC[idx] = siluf(acc);
    }
}

__device__ __forceinline__ void phase_ssd_naive(const Args& a, LAS unsigned char* lds) {
    if (blockIdx.x >= 16) return;
    const int tid = threadIdx.x, lane = tid & 63, wave = tid >> 6;
    const int b = blockIdx.x >> 1, g = blockIdx.x & 1;
    const bool act = tid < 256;
    const int hl = (tid >> 6) & 3, p = tid & 63, h = 4 * g + hl;
    const bf16* PROJ = (const bf16*)(a.ws + WS_PROJ); const float* XC = (const float*)(a.ws + WS_CS); const float* DT = (const float*)(a.ws + WS_DT);
    bf16* YC = (bf16*)(a.ws + WS_H);
    LAS float* sBC = (LAS float*)lds; LAS float* red = (LAS float*)(lds + 1024);
    float st[128];
#pragma unroll
    for (int n = 0; n < 128; ++n) st[n] = 0.f;
    const float av = -__expf(a.a_log[h]), dtb = a.dt_bias[h], dsk = a.d_skip[h], gain = a.ssd_norm_gain[g * 256 + hl * 64 + p];
    for (int t = 0; t < SEQ; ++t) {
        const size_t m = (size_t)b * SEQ + t;
        if (act) sBC[tid] = XC[m * 1024 + (tid < 128 ? 512 + g * 128 + tid : 768 + g * 128 + (tid - 128))];
        __syncthreads();
        float y = 0.f;
        if (act) {
            const float dt = softplusf(DT[m * 8 + h] + dtb), dA = __expf(dt * av), xv = XC[m * 1024 + h * 64 + p], dx = dt * xv;
#pragma unroll
            for (int n = 0; n < 128; ++n) { st[n] = st[n] * dA + dx * sBC[n]; y += sBC[128 + n] * st[n]; }
            y += dsk * xv;
            y *= siluf(bf2f(PROJ[m * N1 + PZ + h * 64 + p]));
        }
        const float ss = wave_sum(y * y);
        if (lane == 0) red[wave] = ss;
        __syncthreads();
        const float tot = (red[0] + red[1]) + (red[2] + red[3]);
        if (act) YC[m * 1024 + h * 64 + p] = (bf16)f2bf(y * rsqrtf(tot * (1.f / 256.f) + EPS) * gain);
    }
}

__device__ __forceinline__ void phase_attn_naive(const Args& a, LAS unsigned char* lds) {
    const int tid = threadIdx.x;
    const bf16* PROJ = (const bf16*)(a.ws + WS_PROJ); bf16* YC = (bf16*)(a.ws + WS_H);
    LAS float* sK = (LAS float*)(lds + 4096); LAS float* sV = (LAS float*)(lds + 4096 + 16384);
    for (int unit = blockIdx.x; unit < 256; unit += gridDim.x) {
        const int b = unit >> 5, h = (unit >> 2) & 7, qb = unit & 3;
        const int t = qb * 512 + tid; const size_t m = (size_t)b * SEQ + t;
        float q[64], o[64];
#pragma unroll
        for (int d = 0; d < 64; ++d) { q[d] = bf2f(PROJ[m * N1 + PQ + h * 64 + d]); o[d] = 0.f; }
        float P = 1.f;
        for (int kt = qb * 8 + 7; kt >= 0; --kt) {
            __syncthreads();
#pragma unroll
            for (int i = 0; i < 8; ++i) { const int idx = tid + 512 * i, key = idx >> 6, d = idx & 63; const size_t mk = (size_t)b * SEQ + kt * 64 + key;
                sK[idx] = bf2f(PROJ[mk * N1 + PK + h * 64 + d]); sV[idx] = bf2f(PROJ[mk * N1 + PV + h * 64 + d]); }
            __syncthreads();
            for (int kk = 63; kk >= 0; --kk) {
                const int s = kt * 64 + kk;
                if (s < t) {
                    float z = 0.f;
#pragma unroll
                    for (int d = 0; d < 64; ++d) z += q[d] * sK[kk * 64 + d];
                    z = fminf(z, 100.f);
                    const float e = exp2f(z), r = 1.f / (1.f + e);
                    P *= r;
                    const float w = e * P;
#pragma unroll
                    for (int d = 0; d < 64; ++d) o[d] += w * sV[kk * 64 + d];
                }
            }
        }
        float ss = 0.f;
#pragma unroll
        for (int d = 0; d < 64; ++d) ss += o[d] * o[d];
        const float rstd = rsqrtf(ss * (1.f / 64.f) + EPS);
#pragma unroll
        for (int d = 0; d < 64; ++d) YC[m * 1024 + 512 + h * 64 + d] = (bf16)f2bf(o[d] * rstd * a.sb_norm_gain[h * 64 + d]);
    }
}


typedef short v4i16 __attribute__((ext_vector_type(4)));
typedef short bf16x8v __attribute__((ext_vector_type(8)));
constexpr int AT_KSTR = 144, AT_KBYTES = 64 * AT_KSTR, AT_VBYTES = 64 * 128, AT_BUF = AT_KBYTES + AT_VBYTES;
#define MFMA32(a, b, c) __builtin_amdgcn_mfma_f32_32x32x16_bf16((a), (b), (c), 0, 0, 0)

template <bool DIAG>
__device__ __forceinline__ void attn_tile(LAS const unsigned char* Kb, LAS const unsigned char* Vb, const bf16x8v (&qf)[4], f32x16& o0, f32x16& o1, float& carry,
                                          int qrel, int l32, int hh, unsigned vbase0, unsigned vbase1) {
    f32x16 p[2];
    bf16x8v kf[2][4];
#pragma unroll
    for (int blk = 0; blk < 2; ++blk)
#pragma unroll
        for (int s = 0; s < 4; ++s) kf[blk][s] = *(LAS const bf16x8v*)(Kb + (32 * blk + l32) * AT_KSTR + 32 * s + 16 * hh);
    asm volatile("s_waitcnt lgkmcnt(0)" ::: "memory");
#pragma unroll
    for (int bi = 0; bi < 2; ++bi) {
        const int blk = 1 - bi;
#pragma unroll
        for (int i = 0; i < 16; ++i) p[blk][i] = 0.f;
#pragma unroll
        for (int s = 0; s < 4; ++s) p[blk] = MFMA32(kf[blk][s], qf[s], p[blk]);
    }
#pragma unroll
    for (int bi = 0; bi < 2; ++bi) {
        const int blk = 1 - bi;
        float R[16];
#pragma unroll
        for (int i = 0; i < 16; ++i) {
            float rv = __builtin_amdgcn_rcpf(1.f + __builtin_amdgcn_exp2f(p[blk][i]));
            if (DIAG) { const int krel = 32 * blk + (i & 3) + 8 * (i >> 2) + 4 * hh; if (krel >= qrel) rv = 1.f; }
            R[i] = rv;
        }
        float GG[4], sel[4];
#pragma unroll
        for (int g = 0; g < 4; ++g) { R[4 * g + 2] *= R[4 * g + 3]; R[4 * g + 1] *= R[4 * g + 2]; R[4 * g] *= R[4 * g + 1]; }
#pragma unroll
        for (int g = 0; g < 4; g += 2) {
            const unsigned ua = __builtin_bit_cast(unsigned, R[4 * g]), ub = __builtin_bit_cast(unsigned, R[4 * g + 4]);
            auto s1 = __builtin_amdgcn_permlane32_swap(ua, ub, false, false);
            auto s2 = __builtin_amdgcn_permlane32_swap(ub, ua, false, false);
            const float pa = __builtin_bit_cast(float, hh ? s2[0] : s1[1]), pb2 = __builtin_bit_cast(float, hh ? s1[0] : s2[1]);
            GG[g] = R[4 * g] * pa; GG[g + 1] = R[4 * g + 4] * pb2;
            sel[g] = hh ? 1.f : pa; sel[g + 1] = hh ? 1.f : pb2;
        }
        float T3 = carry, T2 = T3 * GG[3], T1 = T2 * GG[2], T0 = T1 * GG[1];
        carry = T0 * GG[0];
        const float base[4] = {T0 * sel[0], T1 * sel[1], T2 * sel[2], T3 * sel[3]};
        float w[16];
#pragma unroll
        for (int g = 0; g < 4; ++g) {
            w[4 * g + 3] = base[g] * (1.f - R[4 * g + 3]); w[4 * g + 2] = base[g] * (R[4 * g + 3] - R[4 * g + 2]);
            w[4 * g + 1] = base[g] * (R[4 * g + 2] - R[4 * g + 1]); w[4 * g] = base[g] * (R[4 * g + 1] - R[4 * g]);
        }
#pragma unroll
        for (int s = 0; s < 2; ++s) {
            v4u pk; pk.x = cvtpk(w[8 * s], w[8 * s + 1]); pk.y = cvtpk(w[8 * s + 2], w[8 * s + 3]); pk.z = cvtpk(w[8 * s + 4], w[8 * s + 5]); pk.w = cvtpk(w[8 * s + 6], w[8 * s + 7]);
            const bf16x8v pb = __builtin_bit_cast(bf16x8v, pk);
            const int rowoff = (32 * blk + 16 * s) * 128;
            const v4i16 a0l = __builtin_amdgcn_ds_read_tr16_b64_v4i16((LAS v4i16*)(Vb + vbase0 + rowoff));
            const v4i16 a0h = __builtin_amdgcn_ds_read_tr16_b64_v4i16((LAS v4i16*)(Vb + vbase0 + rowoff + 8 * 128));
            const v4i16 a1l = __builtin_amdgcn_ds_read_tr16_b64_v4i16((LAS v4i16*)(Vb + vbase1 + rowoff));
            const v4i16 a1h = __builtin_amdgcn_ds_read_tr16_b64_v4i16((LAS v4i16*)(Vb + vbase1 + rowoff + 8 * 128));
            const bf16x8v va0 = __builtin_shufflevector(a0l, a0h, 0, 1, 2, 3, 4, 5, 6, 7), va1 = __builtin_shufflevector(a1l, a1h, 0, 1, 2, 3, 4, 5, 6, 7);
            o0 = MFMA32(va0, pb, o0); o1 = MFMA32(va1, pb, o1);
        }
    }
}

__device__ __forceinline__ void attn_unit(const Args& a, LAS unsigned char* lds, int b, int h, int qb) {
    const int tid = threadIdx.x, lane = tid & 63, w = __builtin_amdgcn_readfirstlane(tid >> 6), l32 = lane & 31, hh = lane >> 5;
    const bf16* PROJ = (const bf16*)(a.ws + WS_PROJ); bf16* YC = (bf16*)(a.ws + WS_H);
    const size_t rowbase = (size_t)b * SEQ;
    const int q0 = qb * 256 + 32 * w, ktd = q0 >> 6, ktmax = 4 * qb + 3, qrel = 32 * (w & 1) + l32;
    bf16x8v qf[4];
    { const bf16* qp = PROJ + (rowbase + q0 + l32) * N1 + PQ + h * 64 + 8 * hh;
#pragma unroll
      for (int s = 0; s < 4; ++s) qf[s] = *(const bf16x8v*)(qp + 16 * s); }
    f32x16 o0, o1;
#pragma unroll
    for (int i = 0; i < 16; ++i) { o0[i] = 0.f; o1[i] = 0.f; }
    float carry = 1.f;
    const int skey = tid >> 3, sc = tid & 7;
    const bf16* kg = PROJ + (rowbase + skey) * N1 + PK + h * 64 + 8 * sc;
    const unsigned kwoff = skey * AT_KSTR + sc * 16, vwoff = AT_KBYTES + skey * 128 + ((sc * 16) ^ (((skey >> 1) & 1) << 6));
    const int gi = (lane >> 4) & 1, q4 = (lane & 15) >> 2, pp = lane & 3;
    const unsigned vb = (4 * hh + q4) * 128 + 32 * gi + 8 * pp, xq = (q4 >> 1) << 6;
    const unsigned vbase0 = vb + xq, vbase1 = vb + (64 ^ xq);
    LAS unsigned* dflag = (LAS unsigned*)(lds + 6 * AT_BUF);
    bool wdone = false;
    const int tlo = ktmax >= 5 ? ktmax - 5 : 0, nwin = ktmax - tlo + 1;
    {
        v4u kr[6], vr[6];
#pragma unroll
        for (int i = 0; i < 6; ++i) if (i < nwin) { const size_t t = (size_t)(tlo + i) * 64 * N1; kr[i] = *(const v4u*)(kg + t); vr[i] = *(const v4u*)(kg + t + (PV - PK)); }
#pragma unroll
        for (int i = 0; i < 6; ++i) if (i < nwin) { *(LAS v4u*)(lds + i * AT_BUF + kwoff) = kr[i]; *(LAS v4u*)(lds + i * AT_BUF + vwoff) = vr[i]; }
    }
    __syncthreads();
#pragma unroll 1
    for (int kt = ktd; kt >= tlo; --kt) {
        if (!wdone) {
            LAS unsigned char* bt = lds + (kt - tlo) * AT_BUF;
            if (kt == ktd) attn_tile<true>(bt, bt + AT_KBYTES, qf, o0, o1, carry, qrel, l32, hh, vbase0, vbase1);
            else attn_tile<false>(bt, bt + AT_KBYTES, qf, o0, o1, carry, qrel, l32, hh, vbase0, vbase1);
            wdone = __builtin_amdgcn_ballot_w64(carry >= 3.5527137e-15f) == 0ull;
        }
    }
    if (lane == 0) dflag[16 + w] = wdone ? 1u : 0u;
    __syncthreads();
    bool alldone;
    { const v4u f0 = *(const LAS v4u*)(dflag + 16), f1 = *(const LAS v4u*)(dflag + 20);
      alldone = __builtin_amdgcn_readfirstlane((f0.x & f0.y & f0.z & f0.w) & (f1.x & f1.y & f1.z & f1.w)) != 0u; }
    if (!alldone && tlo > 0) {
        const int npair = tlo >> 1;
        const bf16* kg2 = kg + (size_t)64 * N1;
        v4u kr0, vr0, kr1, vr1;
        { const size_t t = (size_t)(npair - 1) * 128 * N1;
          kr0 = *(const v4u*)(kg + t); vr0 = *(const v4u*)(kg + t + (PV - PK)); kr1 = *(const v4u*)(kg2 + t); vr1 = *(const v4u*)(kg2 + t + (PV - PK)); }
        *(LAS v4u*)(lds + AT_BUF + kwoff) = kr0; *(LAS v4u*)(lds + AT_BUF + vwoff) = vr0; *(LAS v4u*)(lds + kwoff) = kr1; *(LAS v4u*)(lds + vwoff) = vr1;
        __syncthreads();
        int cur = 0, it = 0;
        for (int pj = npair - 1; pj >= 0; --pj, ++it) {
            if (pj > 0) { const size_t t = (size_t)(pj - 1) * 128 * N1;
                kr0 = *(const v4u*)(kg + t); vr0 = *(const v4u*)(kg + t + (PV - PK)); kr1 = *(const v4u*)(kg2 + t); vr1 = *(const v4u*)(kg2 + t + (PV - PK)); }
            LAS unsigned char* bh = lds + cur * (2 * AT_BUF); LAS unsigned char* bl = bh + AT_BUF;
            if (!wdone) {
                attn_tile<false>(bh, bh + AT_KBYTES, qf, o0, o1, carry, qrel, l32, hh, vbase0, vbase1);
                if (__builtin_amdgcn_ballot_w64(carry >= 3.5527137e-15f) != 0ull)
                    attn_tile<false>(bl, bl + AT_KBYTES, qf, o0, o1, carry, qrel, l32, hh, vbase0, vbase1);
                wdone = __builtin_amdgcn_ballot_w64(carry >= 3.5527137e-15f) == 0ull;
            }
            if (lane == 0) dflag[(it & 1) * 8 + w] = wdone ? 1u : 0u;
            if (pj > 0) { LAS unsigned char* nb = lds + (cur ^ 1) * (2 * AT_BUF);
                *(LAS v4u*)(nb + AT_BUF + kwoff) = kr0; *(LAS v4u*)(nb + AT_BUF + vwoff) = vr0; *(LAS v4u*)(nb + kwoff) = kr1; *(LAS v4u*)(nb + vwoff) = vr1; }
            __syncthreads();
            cur ^= 1;
            const v4u f0 = *(const LAS v4u*)(dflag + (it & 1) * 8), f1 = *(const LAS v4u*)(dflag + (it & 1) * 8 + 4);
            if (__builtin_amdgcn_readfirstlane((f0.x & f0.y & f0.z & f0.w) & (f1.x & f1.y & f1.z & f1.w)) != 0u) break;
        }
    }
    float ss = 0.f;
#pragma unroll
    for (int i = 0; i < 16; ++i) ss += o0[i] * o0[i] + o1[i] * o1[i];
    ss += __shfl_xor(ss, 32);
    const float rstd = rsqrtf(ss * (1.f / 64.f) + EPS);
    bf16* yp = YC + (rowbase + q0 + l32) * 1024 + 512 + h * 64 + 4 * hh;
    const float* gp = a.sb_norm_gain + h * 64 + 4 * hh;
#pragma unroll
    for (int g = 0; g < 4; ++g) {
        const v4f g0 = *(const v4f*)(gp + 8 * g), g1 = *(const v4f*)(gp + 32 + 8 * g);
        v2u s0, s1;
        s0.x = pk2(o0[4 * g] * rstd * g0.x, o0[4 * g + 1] * rstd * g0.y); s0.y = pk2(o0[4 * g + 2] * rstd * g0.z, o0[4 * g + 3] * rstd * g0.w);
        s1.x = pk2(o1[4 * g] * rstd * g1.x, o1[4 * g + 1] * rstd * g1.y); s1.y = pk2(o1[4 * g + 2] * rstd * g1.z, o1[4 * g + 3] * rstd * g1.w);
        *(v2u*)(yp + 8 * g) = s0; *(v2u*)(yp + 32 + 8 * g) = s1;
    }
}

__device__ __forceinline__ void phase_attn(const Args& a, LAS unsigned char* lds) {
    for (int pid = blockIdx.x; pid < 256; pid += gridDim.x) {
        int bh, qp;
        if (gridDim.x == 256) { const int xcd = pid & 7, j = pid >> 3; bh = xcd * 8 + (j >> 2); qp = j & 3; }
        else { bh = pid >> 2; qp = pid & 3; }
        attn_unit(a, lds, bh >> 3, bh & 7, 7 - qp);
        attn_unit(a, lds, bh >> 3, bh & 7, qp);
    }
}

constexpr int SD_DT = 0, SD_ACS = 1024, SD_WB = 2048, SD_X = 4096, SD_XS = 576, SD_B = 40960, SD_BS = 320, SD_C = 61440, SD_Z = 81920, SD_ZS = 528;

__device__ __forceinline__ float ssd_dt_load(const Args& a, int b, int c, int g) {
    const int tid = threadIdx.x;
    if (tid >= 256) return 0.f;
    return ((const float*)(a.ws + WS_DT))[((size_t)b * SEQ + 64 * c + (tid & 63)) * 8 + 4 * g + (tid >> 6)];
}
template <bool S1>
__device__ __forceinline__ void ssd_dt(const Args& a, LAS unsigned char* lds, int b, int c, int g, float dtraw) {
    const int tid = threadIdx.x, lane = tid & 63;
    if (tid < 256) {
        const int hl = tid >> 6, h = 4 * g + hl;
        const float dtv = softplusf(dtraw + a.dt_bias[h]);
        float cs = dtv * (-__expf(a.a_log[h]));
#pragma unroll
        for (int o = 1; o < 64; o <<= 1) { const float t = __shfl_up(cs, o); if (lane >= o) cs += t; }
        ((LAS float*)(lds + SD_DT))[hl * 64 + lane] = dtv;
        ((LAS float*)(lds + SD_ACS))[hl * 64 + lane] = cs;
        if (S1) {
            const float tot = __shfl(cs, 63);
            ((LAS float*)(lds + SD_WB))[hl * 64 + lane] = __expf(tot - cs) * dtv;
            if (lane == 63) ((float*)(a.ws + WS_CD))[((size_t)b * NCH + c) * 8 + h] = __expf(tot);
        }
    }
}

struct ConvIn { unsigned halo[3]; unsigned vin[32]; };
__device__ __forceinline__ void ssd_conv_load(const Args& a, ConvIn& r, int b, int c, int th, int col) {
    const bf16* PROJ = (const bf16*)(a.ws + WS_PROJ);
    const int t0 = 64 * c + 32 * th;
    const bf16* src = PROJ + ((size_t)b * SEQ + t0) * N1 + PX + col;
#pragma unroll
    for (int j = 0; j < 3; ++j) { unsigned v = 0u; if (t0 - 3 + j >= 0) v = *(const unsigned*)(src + (ptrdiff_t)(j - 3) * N1); r.halo[j] = v; }
#pragma unroll
    for (int i = 0; i < 32; ++i) r.vin[i] = *(const unsigned*)(src + (size_t)i * N1);
}
template <bool SCALE>
__device__ __forceinline__ void ssd_conv_compute(const Args& a, const ConvIn& r, LAS unsigned char* dst, int dstride, int th, int col, const LAS float* wsc) {
    float w0[4], w1[4];
#pragma unroll
    for (int j = 0; j < 4; ++j) { w0[j] = a.conv_w[j * 1024 + col]; w1[j] = a.conv_w[j * 1024 + col + 1]; }
    const float b0 = a.conv_b[col], b1 = a.conv_b[col + 1];
    float u0[3], u1[3];
#pragma unroll
    for (int j = 0; j < 3; ++j) { u0[j] = bflo(r.halo[j]); u1[j] = bfhi(r.halo[j]); }
#pragma unroll
    for (int i = 0; i < 32; ++i) {
        const unsigned v = r.vin[i];
        const float c0 = bflo(v), c1 = bfhi(v);
        float y0 = b0 + w0[0] * u0[0] + w0[1] * u0[1] + w0[2] * u0[2] + w0[3] * c0;
        float y1 = b1 + w1[0] * u1[0] + w1[1] * u1[1] + w1[2] * u1[2] + w1[3] * c1;
        u0[0] = u0[1]; u0[1] = u0[2]; u0[2] = c0; u1[0] = u1[1]; u1[1] = u1[2]; u1[2] = c1;
        y0 = silu_fast(y0); y1 = silu_fast(y1);
        if (SCALE) { const float s = wsc[32 * th + i]; y0 *= s; y1 *= s; }
        *(LAS unsigned*)(dst + (32 * th + i) * dstride) = pk2(y0, y1);
    }
}

__device__ __forceinline__ bf16x8v tr_pair(LAS const unsigned char* p, int rowstride4) {
    const v4i16 lo = __builtin_amdgcn_ds_read_tr16_b64_v4i16((LAS v4i16*)p);
    const v4i16 hi = __builtin_amdgcn_ds_read_tr16_b64_v4i16((LAS v4i16*)(p + rowstride4));
    return __builtin_shufflevector(lo, hi, 0, 1, 2, 3, 4, 5, 6, 7);
}

__device__ __forceinline__ int ssd_item(int item);
__device__ __forceinline__ void phase_ssd_s1(const Args& a, LAS unsigned char* lds) {
    const int tid = threadIdx.x, lane = tid & 63, w = __builtin_amdgcn_readfirstlane(tid >> 6), l32 = lane & 31, hh = lane >> 5;
    const int hl = w >> 1, half = w & 1;
    const int gi = (lane >> 4) & 1, q4 = (lane & 15) >> 2, pp = lane & 3;
    bf16* CS = (bf16*)(a.ws + WS_CS);
    ConvIn cin; float dtraw = 0.f;
    const int cp = tid % 192, th = tid / 192;
    if (blockIdx.x < NB * NCH * 2) { const int it0 = ssd_item(blockIdx.x), g0 = it0 & 1, c0 = (it0 >> 1) & (NCH - 1), b0 = it0 >> 6;
        if (tid < 384) ssd_conv_load(a, cin, b0, c0, th, cp < 128 ? 256 * g0 + 2 * cp : 512 + 128 * g0 + 2 * (cp - 128));
        dtraw = ssd_dt_load(a, b0, c0, g0); }
    for (int item = blockIdx.x; item < NB * NCH * 2; item += gridDim.x) {
        const int it2 = ssd_item(item), g = it2 & 1, c = (it2 >> 1) & (NCH - 1), b = it2 >> 6;
        const int ccol = cp < 128 ? 256 * g + 2 * cp : 512 + 128 * g + 2 * (cp - 128);
        __syncthreads();
        ssd_dt<true>(a, lds, b, c, g, dtraw);
        __syncthreads();
        if (tid < 384) {
            if (cp < 128) ssd_conv_compute<true>(a, cin, lds + SD_X + 4 * cp, SD_XS, th, ccol, (const LAS float*)(lds + SD_WB) + (cp >> 5) * 64);
            else ssd_conv_compute<false>(a, cin, lds + SD_B + 4 * (cp - 128), SD_BS, th, ccol, nullptr);
        }
        __syncthreads();
        { const int itn = item + gridDim.x;
          if (itn < NB * NCH * 2) { const int in2 = ssd_item(itn), gn = in2 & 1, cn = (in2 >> 1) & (NCH - 1), bn = in2 >> 6;
              if (tid < 384) ssd_conv_load(a, cin, bn, cn, th, cp < 128 ? 256 * gn + 2 * cp : 512 + 128 * gn + 2 * (cp - 128));
              dtraw = ssd_dt_load(a, bn, cn, gn); } }
        f32x16 acc[2][2];
#pragma unroll
        for (int i = 0; i < 16; ++i) { acc[0][0][i] = 0.f; acc[0][1][i] = 0.f; acc[1][0][i] = 0.f; acc[1][1][i] = 0.f; }
#pragma unroll
        for (int s = 0; s < 4; ++s) {
            const int l0 = 16 * s + 8 * hh + q4;
            bf16x8v af[2], bfr[2];
#pragma unroll
            for (int nb = 0; nb < 2; ++nb) af[nb] = tr_pair(lds + SD_B + l0 * SD_BS + (32 * (2 * half + nb) + 16 * gi + 4 * pp) * 2, 4 * SD_BS);
#pragma unroll
            for (int pb = 0; pb < 2; ++pb) bfr[pb] = tr_pair(lds + SD_X + l0 * SD_XS + (64 * hl + 32 * pb + 16 * gi + 4 * pp) * 2, 4 * SD_XS);
#pragma unroll
            for (int nb = 0; nb < 2; ++nb)
#pragma unroll
                for (int pb = 0; pb < 2; ++pb) acc[nb][pb] = MFMA32(bfr[pb], af[nb], acc[nb][pb]);
        }
        bf16* dst = CS + ((((size_t)b * NCH + c) * 8 + 4 * g + hl) * 64) * 128;
#pragma unroll
        for (int nb = 0; nb < 2; ++nb)
#pragma unroll
            for (int pb = 0; pb < 2; ++pb)
#pragma unroll
                for (int i = 0; i < 16; ++i) { const int p = 32 * pb + (i & 3) + 8 * (i >> 2) + 4 * hh; dst[p * 128 + 32 * (2 * half + nb) + l32] = (bf16)f2bf(acc[nb][pb][i]); }
    }
}

__device__ __forceinline__ void phase_ssd_s2(const Args& a) {
    const bf16* CS = (const bf16*)(a.ws + WS_CS); const float* CD = (const float*)(a.ws + WS_CD);
    for (int gid = blockIdx.x * NTHR + threadIdx.x; gid < 64 * 2048; gid += gridDim.x * NTHR) {
        int bh = gid >> 11, e4 = gid & 2047;
        if (gridDim.x == 256) { const int blk = gid >> 9, grp = blk & 7, j = blk >> 3; bh = grp * 8 + (j >> 2); e4 = (j & 3) * 512 + (gid & 511); }
        const int b = bh >> 3, h = bh & 7;
        const v2u* p = (const v2u*)(CS + (((size_t)b * NCH) * 8 + h) * 8192) + e4;
        const float* cd = CD + (size_t)b * NCH * 8 + h;
        v2u* o = (v2u*)((bf16*)(a.ws + WS_PB) + (((size_t)b * NCH) * 8 + h) * 8192) + e4;
        v4f st = {0.f, 0.f, 0.f, 0.f};
        for (int c0 = 0; c0 < NCH; c0 += 16) {
            v2u v[16]; float d[16];
#pragma unroll
            for (int j = 0; j < 16; ++j) { v[j] = p[(size_t)(c0 + j) * 16384]; d[j] = cd[(c0 + j) * 8]; }
#pragma unroll
            for (int j = 0; j < 16; ++j) { v2u w2; w2.x = cvtpk(st.x, st.y); w2.y = cvtpk(st.z, st.w); wt8(o + (size_t)(c0 + j) * 16384, w2.x, w2.y);
                const v4f vv = {bflo(v[j].x), bfhi(v[j].x), bflo(v[j].y), bfhi(v[j].y)}; st = st * d[j] + vv; }
        }
    }
}

__device__ __forceinline__ void phase_ssd_s3(const Args& a, LAS unsigned char* lds) {
    const int tid = threadIdx.x, lane = tid & 63, w = __builtin_amdgcn_readfirstlane(tid >> 6), l32 = lane & 31, hh = lane >> 5;
    const int hl = w >> 1, half = w & 1;
    const int gi = (lane >> 4) & 1, q4 = (lane & 15) >> 2, pp = lane & 3;
    const bf16* PROJ = (const bf16*)(a.ws + WS_PROJ); bf16* YC = (bf16*)(a.ws + WS_H);
    for (int item = blockIdx.x; item < NB * NCH * 2; item += gridDim.x) {
        const int it2 = ssd_item(item), g = it2 & 1, c = (it2 >> 1) & (NCH - 1), b = it2 >> 6, h = 4 * g + hl;
        const size_t m0 = (size_t)b * SEQ + 64 * c;
        __syncthreads();
        bf16x8v pvf[8][2];
        { const bf16* pvb = (const bf16*)(a.ws + WS_PB) + ((((size_t)b * NCH + c) * 8 + h) * 64 + l32) * 128 + 8 * hh;
#pragma unroll
          for (int s = 0; s < 8; ++s) { pvf[s][0] = *(const bf16x8v*)(pvb + 16 * s); pvf[s][1] = *(const bf16x8v*)(pvb + 32 * 128 + 16 * s); } }
        ConvIn cin; v4u zr[4];
        {
            const int cp = tid & 255, th = tid >> 8;
            const int ccol = cp < 128 ? 256 * g + 2 * cp : (cp < 192 ? 512 + 128 * g + 2 * (cp - 128) : 768 + 128 * g + 2 * (cp - 192));
            ssd_conv_load(a, cin, b, c, th, ccol);
#pragma unroll
            for (int i = 0; i < 4; ++i) { const int id = tid + 512 * i, row = id >> 5, ck = id & 31; zr[i] = *(const v4u*)(PROJ + (m0 + row) * N1 + PZ + 256 * g + 8 * ck); }
            ssd_dt<false>(a, lds, b, c, g, ssd_dt_load(a, b, c, g));
            LAS unsigned char* cdst = cp < 128 ? lds + SD_X + 4 * cp : (cp < 192 ? lds + SD_B + 4 * (cp - 128) : lds + SD_C + 4 * (cp - 192));
            ssd_conv_compute<false>(a, cin, cdst, cp < 128 ? SD_XS : SD_BS, th, ccol, nullptr);
#pragma unroll
            for (int i = 0; i < 4; ++i) { const int id = tid + 512 * i, row = id >> 5, ck = id & 31; *(LAS v4u*)(lds + SD_Z + row * SD_ZS + 16 * ck) = zr[i]; }
        }
        __syncthreads();
        const int lcol = 32 * half + l32;
        bf16x8v cf[8];
        f32x16 yo[2], yd[2];
#pragma unroll
        for (int i = 0; i < 16; ++i) { yo[0][i] = 0.f; yo[1][i] = 0.f; yd[0][i] = 0.f; yd[1][i] = 0.f; }
#pragma unroll
        for (int s = 0; s < 8; ++s) {
            cf[s] = *(LAS const bf16x8v*)(lds + SD_C + lcol * SD_BS + (16 * s + 8 * hh) * 2);
            yo[0] = MFMA32(pvf[s][0], cf[s], yo[0]); yo[1] = MFMA32(pvf[s][1], cf[s], yo[1]);
        }
        const float acs_l = ((const LAS float*)(lds + SD_ACS))[hl * 64 + lcol];
#pragma unroll
        for (int sb = 0; sb < 2; ++sb) {
            if (sb <= half) {
                f32x16 cb;
#pragma unroll
                for (int i = 0; i < 16; ++i) cb[i] = 0.f;
#pragma unroll
                for (int s = 0; s < 8; ++s) { const bf16x8v bfrag = *(LAS const bf16x8v*)(lds + SD_B + (32 * sb + l32) * SD_BS + (16 * s + 8 * hh) * 2); cb = MFMA32(bfrag, cf[s], cb); }
                float mv[16];
#pragma unroll
                for (int gq = 0; gq < 4; ++gq) {
                    const v4f as4 = *(const LAS v4f*)(lds + SD_ACS + (hl * 64 + 32 * sb + 8 * gq + 4 * hh) * 4), dt4 = *(const LAS v4f*)(lds + SD_DT + (hl * 64 + 32 * sb + 8 * gq + 4 * hh) * 4);
#pragma unroll
                    for (int j = 0; j < 4; ++j) { const int srow = 32 * sb + 8 * gq + 4 * hh + j;
                        const float dec = __expf(fminf(acs_l - as4[j], 0.f)) * dt4[j];
                        mv[4 * gq + j] = (srow <= lcol) ? cb[4 * gq + j] * dec : 0.f; }
                }
#pragma unroll
                for (int k2 = 0; k2 < 2; ++k2) {
                    v4u pk; pk.x = cvtpk(mv[8 * k2], mv[8 * k2 + 1]); pk.y = cvtpk(mv[8 * k2 + 2], mv[8 * k2 + 3]); pk.z = cvtpk(mv[8 * k2 + 4], mv[8 * k2 + 5]); pk.w = cvtpk(mv[8 * k2 + 6], mv[8 * k2 + 7]);
                    const bf16x8v mf = __builtin_bit_cast(bf16x8v, pk);
#pragma unroll
                    for (int pb = 0; pb < 2; ++pb) {
                        const bf16x8v xf = tr_pair(lds + SD_X + (32 * sb + 16 * k2 + 4 * hh + q4) * SD_XS + (64 * hl + 32 * pb + 16 * gi + 4 * pp) * 2, 8 * SD_XS);
                        yd[pb] = MFMA32(xf, mf, yd[pb]);
                    }
                }
            }
        }
        const float eal = __expf(acs_l), dsk = a.d_skip[h];
        float y[2][16]; float ss = 0.f;
#pragma unroll
        for (int pb = 0; pb < 2; ++pb)
#pragma unroll
            for (int gq = 0; gq < 4; ++gq) {
                const int ch = 64 * hl + 32 * pb + 8 * gq + 4 * hh;
                const v2u xv = *(const LAS v2u*)(lds + SD_X + lcol * SD_XS + ch * 2), zv = *(const LAS v2u*)(lds + SD_Z + lcol * SD_ZS + ch * 2);
                const float xs[4] = {bflo(xv.x), bfhi(xv.x), bflo(xv.y), bfhi(xv.y)}, zs[4] = {bflo(zv.x), bfhi(zv.x), bflo(zv.y), bfhi(zv.y)};
#pragma unroll
                for (int j = 0; j < 4; ++j) { float t = yd[pb][4 * gq + j] + yo[pb][4 * gq + j] * eal + dsk * xs[j]; t *= silu_fast(zs[j]); y[pb][4 * gq + j] = t; ss += t * t; }
            }
        ss += __shfl_xor(ss, 32);
        if (hh == 0) ((LAS float*)(lds + SD_WB))[hl * 64 + lcol] = ss;
        __syncthreads();
        const LAS float* sred = (const LAS float*)(lds + SD_WB);
        const float tot = (sred[lcol] + sred[64 + lcol]) + (sred[128 + lcol] + sred[192 + lcol]);
        const float rstd = rsqrtf(tot * (1.f / 256.f) + EPS);
        bf16* yp = YC + (m0 + lcol) * 1024 + 256 * g + 64 * hl + 4 * hh;
        const float* gp = a.ssd_norm_gain + 256 * g + 64 * hl + 4 * hh;
#pragma unroll
        for (int pb = 0; pb < 2; ++pb)
#pragma unroll
            for (int gq = 0; gq < 4; ++gq) {
                const v4f gn = *(const v4f*)(gp + 32 * pb + 8 * gq);
                v2u o; o.x = pk2(y[pb][4 * gq] * rstd * gn.x, y[pb][4 * gq + 1] * rstd * gn.y); o.y = pk2(y[pb][4 * gq + 2] * rstd * gn.z, y[pb][4 * gq + 3] * rstd * gn.w);
                *(v2u*)(yp + 32 * pb + 8 * gq) = o;
            }
    }
}

__device__ __forceinline__ void phase_norm1(const Args& a) {
    const int lane = threadIdx.x & 63, wave = threadIdx.x >> 6, gw = blockIdx.x * NWAVES + wave, NGW = gridDim.x * NWAVES;
    const bf16* MIX = (const bf16*)(a.ws + WS_PROJ); bf16* H = (bf16*)(a.ws + WS_H);
    v4f g1[4], g2[4];
#pragma unroll
    for (int j = 0; j < 4; ++j) { g1[j] = ((const v4f*)a.post_mix_gain)[lane + 64 * j]; g2[j] = ((const v4f*)a.pre_ffn_gain)[lane + 64 * j]; }
    v2u mv[4], mvn[4]; v4f xv[4], xvn[4];
    if (gw < M) {
#pragma unroll
        for (int j = 0; j < 4; ++j) { mv[j] = ((const v2u*)(MIX + (size_t)gw * DM))[lane + 64 * j]; xv[j] = ((const v4f*)(a.x + (size_t)gw * DM))[lane + 64 * j]; }
    }
    for (int m = gw; m < M; m += NGW) {
        const int mn = m + NGW;
        if (mn < M) {
#pragma unroll
            for (int j = 0; j < 4; ++j) { mvn[j] = ((const v2u*)(MIX + (size_t)mn * DM))[lane + 64 * j]; xvn[j] = ((const v4f*)(a.x + (size_t)mn * DM))[lane + 64 * j]; }
        }
        v4f* orow = (v4f*)(a.out + (size_t)m * DM) + lane;
        v4f v[4]; float s = 0.f;
#pragma unroll
        for (int j = 0; j < 4; ++j) { v[j] = (v4f){bflo(mv[j].x), bfhi(mv[j].x), bflo(mv[j].y), bfhi(mv[j].y)}; s += (v[j].x * v[j].x + v[j].y * v[j].y) + (v[j].z * v[j].z + v[j].w * v[j].w); }
        const float rstd = rsqrtf(wave_sum(s) * (1.f / DM) + EPS);
        float s2 = 0.f;
#pragma unroll
        for (int j = 0; j < 4; ++j) { xv[j] = xv[j] + v[j] * rstd * g1[j]; orow[64 * j] = xv[j];
            s2 += (xv[j].x * xv[j].x + xv[j].y * xv[j].y) + (xv[j].z * xv[j].z + xv[j].w * xv[j].w); }
        const float rstd2 = rsqrtf(wave_sum(s2) * (1.f / DM) + EPS);
        unsigned long long* o8 = (unsigned long long*)(H + (size_t)m * DM) + lane;
#pragma unroll
        for (int j = 0; j < 4; ++j) { const v4f hv = xv[j] * rstd2 * g2[j];
            o8[64 * j] = (unsigned long long)pk2(hv.x, hv.y) | ((unsigned long long)pk2(hv.z, hv.w) << 32); }
#pragma unroll
        for (int j = 0; j < 4; ++j) { mv[j] = mvn[j]; xv[j] = xvn[j]; }
    }
}
__device__ __forceinline__ void phase_norm2(const Args& a) {
    const int lane = threadIdx.x & 63, wave = threadIdx.x >> 6, gw = blockIdx.x * NWAVES + wave, NGW = gridDim.x * NWAVES;
    const bf16* F = (const bf16*)(a.ws + WS_CS);
    v4f g1[4];
#pragma unroll
    for (int j = 0; j < 4; ++j) g1[j] = ((const v4f*)a.post_ffn_gain)[lane + 64 * j];
    v2u fv[4], fvn[4]; v4f xv[4], xvn[4];
    if (gw < M) {
#pragma unroll
        for (int j = 0; j < 4; ++j) { fv[j] = ((const v2u*)(F + (size_t)gw * DM))[lane + 64 * j]; xv[j] = ((const v4f*)(a.out + (size_t)gw * DM))[lane + 64 * j]; }
    }
    for (int m = gw; m < M; m += NGW) {
        const int mn = m + NGW;
        if (mn < M) {
#pragma unroll
            for (int j = 0; j < 4; ++j) { fvn[j] = ((const v2u*)(F + (size_t)mn * DM))[lane + 64 * j]; xvn[j] = ((const v4f*)(a.out + (size_t)mn * DM))[lane + 64 * j]; }
        }
        v4f* orow = (v4f*)(a.out + (size_t)m * DM) + lane;
        v4f v[4]; float s = 0.f;
#pragma unroll
        for (int j = 0; j < 4; ++j) { v[j] = (v4f){bflo(fv[j].x), bfhi(fv[j].x), bflo(fv[j].y), bfhi(fv[j].y)}; s += (v[j].x * v[j].x + v[j].y * v[j].y) + (v[j].z * v[j].z + v[j].w * v[j].w); }
        const float rstd = rsqrtf(wave_sum(s) * (1.f / DM) + EPS);
#pragma unroll
        for (int j = 0; j < 4; ++j) orow[64 * j] = xv[j] + v[j] * rstd * g1[j];
#pragma unroll
        for (int j = 0; j < 4; ++j) { fv[j] = fvn[j]; xv[j] = xvn[j]; }
    }
}

#define XB_TMO      128
#define XB_XCNT(j)  (256  + 64 * (j))
#define XB_XSUB(j)  (1280 + 64 * (j))
#define XB_XGEN(j)  (2304 + 64 * (j))
#define XB_TOP      3328
#define XB_TOPGEN   3392
#define XCD_BAR_WORDS 3456
#define XB_SPIN_CAP (1u << 18)

__device__ __forceinline__ unsigned xb_ld(unsigned* p)              { return __hip_atomic_load(p, __ATOMIC_RELAXED, __HIP_MEMORY_SCOPE_AGENT); }
__device__ __forceinline__ unsigned xb_add(unsigned* p, unsigned v) { return __hip_atomic_fetch_add(p, v, __ATOMIC_RELAXED, __HIP_MEMORY_SCOPE_AGENT); }
__device__ __forceinline__ unsigned xb_xcc_id() { return (unsigned)__builtin_amdgcn_s_getreg((3 << 11) | 20) & 0xFu; }
#define XB_SPIN(cond, bar) do { unsigned _sp = 0; while (cond) { __builtin_amdgcn_s_sleep(1); \
    if ((++_sp & 255u) == 0u) { if (xb_ld(&(bar)[XB_TMO])) break; if (_sp > XB_SPIN_CAP) { atomicAdd(&(bar)[XB_TMO], 1u); break; } } } } while (0)

struct XcdBarrier {
    unsigned* bar; unsigned x;
    volatile LAS unsigned* st;
};

__device__ __forceinline__ XcdBarrier xcd_barrier_post(unsigned* bar, volatile LAS unsigned* st) {
    XcdBarrier b; b.bar = bar; b.x = xb_xcc_id(); b.st = st;
    if (threadIdx.x == 0) (void)xb_add(&bar[XB_XCNT(b.x)], 1u);
    return b;
}
__device__ __forceinline__ void xcd_barrier_complete(unsigned* bar, unsigned x, unsigned& nloc, unsigned& nx) {
    const unsigned G = gridDim.x * gridDim.y * gridDim.z;
    unsigned sum, cnt, mine, sp = 0u;
    for (;;) {
        sum = 0u; cnt = 0u; mine = 0u;
#pragma unroll
        for (unsigned j = 0; j < 16; ++j) { const unsigned c = xb_ld(&bar[XB_XCNT(j)]); sum += c; cnt += (c > 0u) ? 1u : 0u; mine = (j == x) ? c : mine; }
        if (sum == G) break;
        __builtin_amdgcn_s_sleep(1);
        if ((++sp & 255u) == 0u) { if (xb_ld(&bar[XB_TMO])) break; if (sp > XB_SPIN_CAP) { atomicAdd(&bar[XB_TMO], 1u); break; } }
    }
    nloc = mine > 0u ? mine : 1u; nx = cnt > 0u ? cnt : 1u;
}

__device__ __forceinline__ void xcd_barrier(const XcdBarrier& b) {
    asm volatile("s_waitcnt vmcnt(0)" ::: "memory");
    __syncthreads();
    if (threadIdx.x == 0) {
        unsigned* bar = b.bar;
        __builtin_amdgcn_s_waitcnt(0);
        unsigned nloc = b.st[0], nx = b.st[1];
        if (nloc == 0u) { xcd_barrier_complete(bar, b.x, nloc, nx); b.st[0] = nloc; b.st[1] = nx; }
        const unsigned old = xb_add(&bar[XB_XSUB(b.x)], 1u);
        const unsigned gen = old / nloc;
        if (old + 1u == (gen + 1u) * nloc) {
            __builtin_amdgcn_fence(__ATOMIC_RELEASE, "agent");
            asm volatile("s_waitcnt vmcnt(0)" ::: "memory");
            const unsigned og = xb_add(&bar[XB_TOP], 1u);
            const unsigned tg = og / nx;
            if (og + 1u == (tg + 1u) * nx) xb_add(&bar[XB_TOPGEN], 1u);
            else XB_SPIN(xb_ld(&bar[XB_TOPGEN]) == tg, bar);
            __builtin_amdgcn_fence(__ATOMIC_ACQUIRE, "agent");
            xb_add(&bar[XB_XGEN(b.x)], 1u);
            asm volatile("s_waitcnt vmcnt(0)" ::: "memory");
        } else {
            XB_SPIN(xb_ld(&bar[XB_XGEN(b.x)]) == gen, bar);
            __builtin_amdgcn_fence(__ATOMIC_ACQUIRE, "agent");
            asm volatile("s_waitcnt vmcnt(0)" ::: "memory");
        }
    }
    __syncthreads();
}


__device__ __forceinline__ int ssd_item(int item) {
    if (gridDim.x != 256) return item;
    const int blk = item & 255, k = item >> 8, grp = blk & 7, j = blk >> 3;
    return (grp << 6) | (j + 32 * k);
}
#define XL_SUB(g) (3472 + 16 * (g))
#define XL_GEN(g) (3600 + 16 * (g))
#define XL_MASK(g) (3456 + (g))
__device__ __forceinline__ void local_barrier(unsigned* ctl, int g) {
    asm volatile("s_waitcnt vmcnt(0)" ::: "memory");
    __syncthreads();
    if (threadIdx.x == 0) {
        const unsigned old = xb_add(&ctl[XL_SUB(g)], 1u), gen = old / 32u;
        if (old + 1u == (gen + 1u) * 32u) xb_add(&ctl[XL_GEN(g)], 1u);
        else { unsigned sp = 0u; while (xb_ld(&ctl[XL_GEN(g)]) == gen) { __builtin_amdgcn_s_sleep(1); if (++sp > (1u << 22)) break; } }
        __builtin_amdgcn_fence(__ATOMIC_ACQUIRE, "agent");
        asm volatile("s_waitcnt vmcnt(0)" ::: "memory");
    }
    __syncthreads();
}
constexpr int NPHASE = 10;
__global__ void __launch_bounds__(NTHR, 2) fwd(Args a) {
    extern __shared__ __attribute__((aligned(16))) unsigned char lds_raw[];
    LAS unsigned char* lds = (LAS unsigned char*)lds_raw;
    const int lo = a.ph_lo, hi = a.ph_hi;
#ifndef REPMASK
#define REPMASK 0
#endif
#define REP(k) for (int _r = 0; _r < (((REPMASK) >> (k)) & 1) + 1; ++_r)
#define IN(k) (lo <= (k) && (k) < hi)
#define SEAM(k) do { if (IN(k) && IN((k) + 1)) xcd_barrier(bar); } while (0)
    unsigned char* ws = a.ws;
    volatile LAS unsigned* misc = (volatile LAS unsigned*)(lds + 131072);
    if (threadIdx.x < 2) misc[threadIdx.x] = 0u;
    __syncthreads();
    XcdBarrier bar = xcd_barrier_post((unsigned*)(ws + WS_CTL), misc);
    unsigned* ctlw = (unsigned*)(ws + WS_CTL);
    if (threadIdx.x == 0) __hip_atomic_fetch_or(&ctlw[XL_MASK(blockIdx.x & 7)], 1u << bar.x, __ATOMIC_RELAXED, __HIP_MEMORY_SCOPE_AGENT);
    if ((REPMASK) & 16384) { for (int i = 0; i < 10; ++i) xcd_barrier(bar); }
    const bool defer_w4 = (gridDim.x == 256) && lo == 0 && hi > 7;
    if (IN(0)) REP(0) { phase_p0(a, lds, defer_w4); __syncthreads(); }
    SEAM(0);
    bool colo = false;
    if ((gridDim.x == 256) && lo == 0 && hi > 5) {
        unsigned seen = 0u; colo = true;
#pragma unroll
        for (int g8 = 0; g8 < 8; ++g8) { const unsigned mk = xb_ld(&ctlw[XL_MASK(g8)]); colo = colo && mk != 0u && (mk & (mk - 1u)) == 0u && (seen & mk) == 0u; seen |= mk; }
        colo = __builtin_amdgcn_readfirstlane(colo ? 1 : 0) != 0;
    }
#define SEAM_L(k) do { if (IN(k) && IN((k) + 1)) { if (colo) local_barrier(ctlw, blockIdx.x & 7); else xcd_barrier(bar); } } while (0)
    if (IN(1)) REP(1) { pg8::Gemm g{(const bf16*)(ws + WS_H), (const bf16*)(ws + WS_W1), M, N1, DM}; pg8::StaticOrder S; S.init(M, N1, gridDim.x, blockIdx.x);
        pg8::EpiProj E{(bf16*)(ws + WS_PROJ)}; pg8::gemm_phase<pg8::EpiProj, pg8::StaticOrder, true, true>(lds, g, S, E); }
    SEAM_L(1);
    if (IN(2)) REP(2) { phase_ssd_s1(a, lds); }
    SEAM_L(2);
    if (IN(3)) REP(3) { phase_ssd_s2(a); }
    SEAM_L(3);
    if (IN(4)) { REP(10) { phase_ssd_s3(a, lds); __syncthreads(); } REP(11) { phase_attn(a, lds); __syncthreads(); } }
    SEAM_L(4);
    const bool fuse_n1 = (gridDim.x == 256) && lo <= 5 && hi > 7;
    if (IN(5)) { pg8::Gemm g{(const bf16*)(ws + WS_H), (const bf16*)(ws + WS_W2), M, DM, DM}; pg8::StaticOrder S; S.init(M, DM, gridDim.x, blockIdx.x);
        if (fuse_n1) {
            pg8::EpiRmsResRms E{a.x, (bf16*)(ws + WS_CS), (bf16*)(ws + WS_PB), a.post_mix_gain, a.pre_ffn_gain, (float*)(ws + WS_CTL + 65536 + 262144), (unsigned*)(ws + WS_CTL + 32768), (float*)(ws + WS_CTL + 65536 + 524288), (unsigned*)(ws + WS_CTL + 49152)};
            pg8::gemm_phase<pg8::EpiRmsResRms, pg8::StaticOrder, false, true>(lds, g, S, E);
        } else {
            pg8::EpiBf16 E{(bf16*)(ws + WS_PROJ), DM}; pg8::gemm_phase<pg8::EpiBf16, pg8::StaticOrder, true, true>(lds, g, S, E);
        }
    }
    if (!fuse_n1) {
    SEAM(5);
    if (IN(6)) REP(6) { phase_norm1(a); }
    }
    SEAM_L(6);
    if (IN(7)) REP(7) { pg8::Gemm g{(const bf16*)(ws + (fuse_n1 ? WS_PB : WS_H)), (const bf16*)(ws + WS_W3), M, N3, DM}; pg8::StaticOrder S; S.init(M, N3, gridDim.x, blockIdx.x);
        pg8::EpiSwiglu E{(bf16*)(ws + WS_PROJ)}; pg8::gemm_phase<pg8::EpiSwiglu, pg8::StaticOrder, true, true>(lds, g, S, E);
        if (defer_w4) { __syncthreads(); phase_w4(a, lds); } }
    SEAM(7);
    if (IN(8)) { pg8::Gemm g{(const bf16*)(ws + WS_PROJ), (const bf16*)(ws + WS_W4), M, DM, DFF, (size_t)1 << 20}; pg8::StaticOrder S; S.init(M, DM, gridDim.x, blockIdx.x);
        if (gridDim.x == 256 && hi > 9 && lo <= 5) {
            pg8::EpiRmsRes E{(const bf16*)(ws + WS_CS), a.out, a.post_ffn_gain, (float*)(ws + WS_CTL + 65536), (unsigned*)(ws + WS_CTL + 16384)};
            pg8::gemm_phase<pg8::EpiRmsRes, pg8::StaticOrder, false, true>(lds, g, S, E);
        } else {
            pg8::EpiBf16 E{(bf16*)(ws + WS_CS), DM}; pg8::gemm_phase<pg8::EpiBf16, pg8::StaticOrder, true, true>(lds, g, S, E);
            SEAM(8);
            if (IN(9)) { phase_norm2(a); }
        }
    }
#undef IN
#undef SEAM
}

#ifndef N_LAUNCHES
#define N_LAUNCHES 1
#endif
extern "C" void kernel_launch(void* const* d_in, const int* in_sizes, int n_in, void* d_out, int out_size, void* d_ws, size_t ws_size, hipStream_t stream) {
    static int grid = 0;
    if (grid == 0) {
        if (n_in != 17 || out_size != M * DM || ws_size < WS_END) { fprintf(stderr, "kernel_launch: unexpected problem (n_in %d out %d ws %zu)\n", n_in, out_size, ws_size); grid = -1; return; }
        int dev = 0, cus = 0, per_cu = 0;
        hipGetDevice(&dev); hipDeviceGetAttribute(&cus, hipDeviceAttributeMultiprocessorCount, dev);
        if (hipFuncSetAttribute((const void*)fwd, hipFuncAttributeMaxDynamicSharedMemorySize, LDS_BYTES) != hipSuccess) { fprintf(stderr, "kernel_launch: hipFuncSetAttribute failed\n"); grid = -1; return; }
        if (hipOccupancyMaxActiveBlocksPerMultiprocessor(&per_cu, (const void*)fwd, NTHR, LDS_BYTES) != hipSuccess || per_cu < 1) { fprintf(stderr, "kernel_launch: occupancy query says %d blocks per CU\n", per_cu); per_cu = 1; }
        (void)hipGetLastError();
        grid = cus;
    }
    if (grid < 0) return;
    if (hipMemsetAsync((char*)d_ws + WS_CTL, 0, 65536, stream) != hipSuccess) { fprintf(stderr, "kernel_launch: memset failed\n"); return; }
    Args a{};
    const float** ap = (const float**)&a;
    for (int i = 0; i < 17; ++i) ap[i] = (const float*)d_in[i];
    a.out = (float*)d_out; a.ws = (unsigned char*)d_ws;
#if N_LAUNCHES == 1
    a.ph_lo = 0; a.ph_hi = NPHASE;
    void* args[] = {&a};
    hipError_t e = hipLaunchCooperativeKernel((const void*)fwd, dim3(grid), dim3(NTHR), args, LDS_BYTES, stream);
    if (e != hipSuccess) fprintf(stderr, "cooperative launch failed: %s (grid %d)\n", hipGetErrorString(e), grid);
#else
    for (int ph = 0; ph < NPHASE; ++ph) { a.ph_lo = ph; a.ph_hi = ph + 1; hipLaunchKernelGGL(fwd, dim3(grid), dim3(NTHR), LDS_BYTES, stream, a); }
#endif
}
```

```cpp
#define REPMASK 0
#include <hip/hip_runtime.h>
#include <hip/hip_cooperative_groups.h>
#include <cstdio>
#include <cstdint>
namespace cg = cooperative_groups;
#ifndef REPMASK
#define REPMASK 0
#endif

constexpr int NB = 8, SEQ = 2048, DM = 1024, M = NB * SEQ;
constexpr int DIN = 3080;
constexpr int N1 = 3072;
constexpr int PZ = 0, PX = 512, PQ = 1536, PK = 2048, PV = 2560;
constexpr int DFF = 2816, N3 = 2 * DFF;
constexpr int NH = 8, HD = 64, NST = 128, CH = 64, NCH = SEQ / CH;
constexpr float EPS = 1e-6f;
constexpr float LOG2E = 1.4426950408889634f;
constexpr float QSCALE = 0.125f * LOG2E;

constexpr size_t MiB = 1u << 20;
constexpr size_t WS_W1 = 0, WS_W2 = 6 * MiB, WS_W3 = 8 * MiB, WS_W4 = 19 * MiB;
constexpr size_t WS_DT = 25 * MiB;
constexpr size_t WS_CD = 25 * MiB + 512 * 1024;
constexpr size_t WS_H = 26 * MiB;
constexpr size_t WS_PROJ = 58 * MiB;
constexpr size_t WS_CS = 154 * MiB;
constexpr size_t WS_CTL = 218 * MiB;
constexpr size_t WS_PB = 219 * MiB;
constexpr size_t WS_END = 251 * MiB;

constexpr int LDS_BYTES = 147456;
constexpr int NTHR = 512, NWAVES = 8;

#define LAS __attribute__((address_space(3)))
typedef unsigned short bf16;
typedef unsigned v4u __attribute__((ext_vector_type(4)));
typedef unsigned v2u __attribute__((ext_vector_type(2)));
typedef float v4f __attribute__((ext_vector_type(4)));
typedef float f32x16 __attribute__((ext_vector_type(16)));

__device__ __forceinline__ unsigned f2bf(float f) { unsigned u = __builtin_bit_cast(unsigned, f); return (u + 0x7fffu + ((u >> 16) & 1u)) >> 16; }
typedef float f32x2_t __attribute__((ext_vector_type(2)));
typedef __bf16 bf16x2_t __attribute__((ext_vector_type(2)));
__device__ __forceinline__ unsigned cvtpk(float lo, float hi) { f32x2_t v = {lo, hi}; bf16x2_t b = __builtin_convertvector(v, bf16x2_t); return __builtin_bit_cast(unsigned, b); }
__device__ __forceinline__ unsigned pk2(float lo, float hi) { return cvtpk(lo, hi); }
__device__ __forceinline__ void wt8(void* p, unsigned lo, unsigned hi) { __hip_atomic_store((unsigned long long*)p, (unsigned long long)lo | ((unsigned long long)hi << 32), __ATOMIC_RELAXED, __HIP_MEMORY_SCOPE_AGENT); }
__device__ __forceinline__ __amdgpu_buffer_rsrc_t wt_rsrc(void* base, unsigned bytes) { return __builtin_amdgcn_make_buffer_rsrc(base, 0, (int)bytes, 0x00020000); }
__device__ __forceinline__ void wt16(__amdgpu_buffer_rsrc_t r, unsigned byte_off, v4u v) { __builtin_amdgcn_raw_buffer_store_b128(v, r, (int)byte_off, 0, 16); }
__device__ __forceinline__ float bf2f(unsigned b) { return __builtin_bit_cast(float, b << 16); }
__device__ __forceinline__ float bflo(unsigned w) { return __builtin_bit_cast(float, w << 16); }
__device__ __forceinline__ float bfhi(unsigned w) { return __builtin_bit_cast(float, w & 0xffff0000u); }
__device__ __forceinline__ float wave_sum(float v) {
#pragma unroll
    for (int o = 1; o < 64; o <<= 1) v += __shfl_xor(v, o);
    return v;
}
__device__ __forceinline__ float siluf(float v) { return v / (1.f + __expf(-v)); }
__device__ __forceinline__ float silu_fast(float v) { return v * __builtin_amdgcn_rcpf(1.f + __builtin_amdgcn_exp2f(-LOG2E * v)); }
__device__ __forceinline__ float softplusf(float v) { return fmaxf(v, 0.f) + log1pf(__expf(-fabsf(v))); }

namespace pg8 {
#define PG8_LAS __attribute__((address_space(3)))
typedef unsigned short bf16_t;
typedef short bf16x8 __attribute__((ext_vector_type(8)));
typedef float f32x4 __attribute__((ext_vector_type(4)));
typedef unsigned u32x4 __attribute__((ext_vector_type(4)));
constexpr int BM = 256, BK = 64, HALF = 128, HTB = HALF * BK * 2  , STAGE_BYTES = 8 * HTB, NXCD = 8, WGM = 8;

__host__ __device__ __forceinline__ int lds_byte(int r, int c) { const int st = (r >> 4) * 2 + (c >> 5), rr = r & 15, cc = c & 31, ob = rr * 64 + cc * 2; return st * 1024 + (ob ^ (((ob >> 9) & 1) << 5)); }
__host__ __device__ __forceinline__ void stage_rc(int b, int& R, int& C) { const int st = b / 1024, sb = b % 1024, swz = sb ^ (((sb >> 9) & 1) << 5); R = (st >> 1) * 16 + swz / 64; C = (st & 1) * 32 + (swz % 64) / 2; }
__host__ __device__ __forceinline__ int perm32(int rho) { const int n = rho >> 4, i = rho & 15; return 8 * (i >> 2) + 4 * n + (i & 3); }

struct Unit { int pm, pn; };
struct Gemm { const bf16_t* A; const bf16_t* Bt; int M, N, K; size_t agap; };

struct StaticOrder {
    int nM, nN, nwg, G, c;
    __host__ __device__ void init(int M, int N, int G_, int c_) { nM = M / BM; nN = N / BM; nwg = nM * nN; G = G_; c = c_; }
    __host__ __device__ bool next(int i, Unit& u) const {
        const long L = (long)i * G + c; if (L >= nwg) return false;
        int wgid = (int)L; { const int q = nwg / NXCD, r = nwg % NXCD, xcd = wgid % NXCD, off = wgid / NXCD; wgid = (xcd < r ? xcd * (q + 1) : r * (q + 1) + (xcd - r) * q) + off; }
        const int nig = WGM * nN, gid = wgid / nig, fm = gid * WGM, gsz = (nM - fm) < WGM ? (nM - fm) : WGM;
        u.pm = fm + ((wgid % nig) % gsz); u.pn = (wgid % nig) / gsz; return true;
    }
    __device__ __forceinline__ void a_ready(const Unit&) const {}
    __device__ __forceinline__ void done(const Unit&) const {}
};

__device__ __forceinline__ unsigned cvt_pk_bf16(float lo, float hi) { unsigned r; asm volatile("v_cvt_pk_bf16_f32 %0, %1, %2" : "=v"(r) : "v"(lo), "v"(hi)); return r; }
template <class Epi, class Sched, bool ALIGN_EPI = false, bool SP2 = false>
__device__ __forceinline__ void gemm_phase(PG8_LAS unsigned char* lds, const Gemm g, const Sched& S, const Epi& E) {
    const int tid = threadIdx.x, wid = __builtin_amdgcn_readfirstlane(tid >> 6), lane = tid & 63, wr = wid >> 2, wc = wid & 3, fr = lane & 15, fq = lane >> 4;
    const int K = g.K, nt = K / BK;
    unsigned voffA[2], voffB[2];
#pragma unroll
    for (int i = 0; i < 2; ++i) { int R, C; stage_rc(tid * 16 + i * 8192, R, C); const int Rb = Epi::PERM ? ((R & ~31) + perm32(R & 31)) : R;
        voffA[i] = (unsigned)(R * K + C) * 2u; voffB[i] = (unsigned)(Rb * K + C) * 2u; }
    const size_t kstep = (size_t)(BK * 2);
    const size_t hstep = (size_t)HALF * K * 2;
    const size_t tstep = 2 * hstep;
    const unsigned ldsw = (unsigned)wid * 1024u;
    const int aoff = lds_byte(wr * 64 + fr, fq * 8), boff = lds_byte(wc * 32 + fr, fq * 8);
#define PG8_SA(b, h) (((b) * 2 + (h)) * HTB)
#define PG8_SB(b, h) ((4 + (b) * 2 + (h)) * HTB)
#define PG8_STAGE(bufoff, gbase, voff) do { _Pragma("unroll") for (int _i = 0; _i < 2; ++_i) \
        __builtin_amdgcn_global_load_lds((const unsigned*)((const char*)(gbase) + (voff)[_i]), (PG8_LAS unsigned*)(lds + (bufoff) + ldsw + _i * 8192), 16, 0, 0); } while (0)
#define PG8_LDA(dst, b, h) do { _Pragma("unroll") for (int m = 0; m < 4; ++m) _Pragma("unroll") for (int k = 0; k < 2; ++k) dst[m][k] = *(const PG8_LAS bf16x8*)(lds + PG8_SA(b, h) + aoff + m * 2048 + k * 1024); } while (0)
#define PG8_LDB(dst, b, h) do { _Pragma("unroll") for (int n = 0; n < 2; ++n) _Pragma("unroll") for (int k = 0; k < 2; ++k) dst[n][k] = *(const PG8_LAS bf16x8*)(lds + PG8_SB(b, h) + boff + n * 2048 + k * 1024); } while (0)
#define PG8_MMA(ai, bj, At, Bt) do { __builtin_amdgcn_s_setprio(1); _Pragma("unroll") for (int m = 0; m < 4; ++m) _Pragma("unroll") for (int n = 0; n < 2; ++n) _Pragma("unroll") for (int k = 0; k < 2; ++k) \
        acc[ai][bj][m][n] = __builtin_amdgcn_mfma_f32_16x16x32_bf16(Bt[n][k], At[m][k], acc[ai][bj][m][n], 0, 0, 0); __builtin_amdgcn_s_setprio(0); } while (0)
#define PG8_WAIT_V(n) asm volatile("s_waitcnt vmcnt(" #n ")" ::: "memory")
#define PG8_WAIT_L(n) asm volatile("s_waitcnt lgkmcnt(" #n ")" ::: "memory")
#define PG8_BAR __builtin_amdgcn_s_barrier()
#define PG8_SCHED __builtin_amdgcn_sched_barrier(0)
    Unit cur, nxt; int ui = 0;
    if (!S.next(0, cur)) return;
    f32x4 acc[2][2][4][2];
#pragma unroll
    for (int a = 0; a < 2; ++a)
#pragma unroll
        for (int b = 0; b < 2; ++b)
#pragma unroll
            for (int m = 0; m < 4; ++m)
#pragma unroll
                for (int n = 0; n < 2; ++n) acc[a][b][m][n] = (f32x4){0.f, 0.f, 0.f, 0.f};
    bf16x8 At[4][2], B0[2][2], B1[2][2];
    const char* cA = (const char*)g.A + (size_t)cur.pm * tstep + (size_t)(cur.pm >> 3) * g.agap; const char* cB = (const char*)g.Bt + (size_t)cur.pn * tstep;
    S.a_ready(cur);
    if constexpr (SP2) {
        PG8_STAGE(PG8_SB(0, 0), cB, voffB); PG8_STAGE(PG8_SB(0, 1), cB + hstep, voffB); PG8_STAGE(PG8_SA(0, 0), cA, voffA); PG8_STAGE(PG8_SA(0, 1), cA + hstep, voffA);
        if (wr == 1) PG8_BAR;
        PG8_WAIT_V(2); PG8_BAR;
        PG8_STAGE(PG8_SB(1, 0), cB + kstep, voffB); PG8_STAGE(PG8_SA(1, 0), cA + kstep, voffA); PG8_STAGE(PG8_SB(1, 1), cB + hstep + kstep, voffB);
        PG8_WAIT_V(6); PG8_BAR;
    } else {
        PG8_STAGE(PG8_SB(0, 0), cB, voffB); PG8_STAGE(PG8_SA(0, 0), cA, voffA); PG8_STAGE(PG8_SB(0, 1), cB + hstep, voffB); PG8_STAGE(PG8_SA(0, 1), cA + hstep, voffA);
        if (wr == 1) PG8_BAR;
        PG8_WAIT_V(4); PG8_BAR;
        PG8_STAGE(PG8_SB(1, 0), cB + kstep, voffB); PG8_STAGE(PG8_SA(1, 0), cA + kstep, voffA); PG8_STAGE(PG8_SB(1, 1), cB + hstep + kstep, voffB);
        PG8_WAIT_V(6); PG8_BAR;
    }
    for (;;) {
        const bool has_next = S.next(ui + 1, nxt);
        const char* nA = has_next ? (const char*)g.A + (size_t)nxt.pm * tstep + (size_t)(nxt.pm >> 3) * g.agap : cA; const char* nB = has_next ? (const char*)g.Bt + (size_t)nxt.pn * tstep : cB;
        for (int t = 0; t < nt; t += 2) {
            const bool last = (t == nt - 2);
            const char* a1 = cA + (size_t)(t + 1) * kstep;
            const char* a2 = last ? nA : cA + (size_t)(t + 2) * kstep; const char* b2 = last ? nB : cB + (size_t)(t + 2) * kstep;
            const char* a3 = a2 + kstep; const char* b3 = b2 + kstep;
            if (last && has_next) S.a_ready(nxt);
            if constexpr (SP2) {
            PG8_LDB(B0, 0, 0); PG8_LDB(B1, 0, 1); PG8_SCHED; PG8_LDA(At, 0, 0); PG8_STAGE(PG8_SA(1, 1), a1 + hstep, voffA);
            PG8_WAIT_V(8); PG8_WAIT_L(0); PG8_BAR; PG8_MMA(0, 0, At, B0); PG8_MMA(0, 1, At, B1); PG8_BAR; PG8_SCHED;
            PG8_LDA(At, 0, 1); PG8_STAGE(PG8_SB(0, 0), b2, voffB); PG8_STAGE(PG8_SB(0, 1), b2 + hstep, voffB); PG8_STAGE(PG8_SA(0, 0), a2, voffA);
            PG8_WAIT_V(8); PG8_WAIT_L(0); PG8_BAR; PG8_MMA(1, 0, At, B0); PG8_MMA(1, 1, At, B1); PG8_BAR; PG8_SCHED;
            PG8_LDB(B0, 1, 0); PG8_LDB(B1, 1, 1); PG8_SCHED; PG8_LDA(At, 1, 0); PG8_STAGE(PG8_SA(0, 1), a2 + hstep, voffA);
            PG8_WAIT_V(8); PG8_WAIT_L(0); PG8_BAR; PG8_MMA(0, 0, At, B0); PG8_MMA(0, 1, At, B1); PG8_BAR; PG8_SCHED;
            PG8_LDA(At, 1, 1); PG8_STAGE(PG8_SB(1, 0), b3, voffB); PG8_STAGE(PG8_SB(1, 1), b3 + hstep, voffB); PG8_STAGE(PG8_SA(1, 0), a3, voffA);
            PG8_WAIT_V(8); PG8_WAIT_L(0); PG8_BAR; PG8_MMA(1, 0, At, B0); PG8_MMA(1, 1, At, B1); PG8_BAR; PG8_SCHED;
            } else {
            PG8_LDB(B0, 0, 0); PG8_SCHED; PG8_LDA(At, 0, 0); PG8_STAGE(PG8_SA(1, 1), a1 + hstep, voffA);
            PG8_WAIT_L(8); PG8_BAR; PG8_WAIT_L(0); PG8_MMA(0, 0, At, B0); PG8_BAR; PG8_SCHED;
            PG8_LDB(B1, 0, 1); PG8_STAGE(PG8_SB(0, 0), b2, voffB);
            PG8_BAR; PG8_WAIT_L(0); PG8_MMA(0, 1, At, B1); PG8_BAR;
            PG8_LDA(At, 0, 1); PG8_STAGE(PG8_SA(0, 0), a2, voffA);
            PG8_BAR; PG8_WAIT_L(0); PG8_MMA(1, 0, At, B0); PG8_BAR; PG8_SCHED;
            PG8_STAGE(PG8_SB(0, 1), b2 + hstep, voffB);
            PG8_WAIT_V(6); PG8_BAR; PG8_MMA(1, 1, At, B1); PG8_BAR;
            PG8_LDB(B0, 1, 0); PG8_SCHED; PG8_LDA(At, 1, 0); PG8_STAGE(PG8_SA(0, 1), a2 + hstep, voffA);
            PG8_WAIT_L(8); PG8_BAR; PG8_WAIT_L(0); PG8_MMA(0, 0, At, B0); PG8_BAR; PG8_SCHED;
            PG8_LDB(B1, 1, 1); PG8_STAGE(PG8_SB(1, 0), b3, voffB);
            PG8_BAR; PG8_WAIT_L(0); PG8_MMA(0, 1, At, B1); PG8_BAR;
            PG8_LDA(At, 1, 1); PG8_STAGE(PG8_SA(1, 0), a3, voffA);
            PG8_BAR; PG8_WAIT_L(0); PG8_MMA(1, 0, At, B0); PG8_BAR; PG8_SCHED;
            PG8_STAGE(PG8_SB(1, 1), b3 + hstep, voffB);
            PG8_WAIT_V(6); PG8_BAR; PG8_MMA(1, 1, At, B1); PG8_BAR;
            }
        }
        if constexpr (ALIGN_EPI) { if (wr == 0) PG8_BAR; }
        if constexpr (!Epi::AFTER_DRAIN) { E(acc, cur, wr, wc, fr, fq); S.done(cur); }
        if (!has_next) break;
#pragma unroll
        for (int a = 0; a < 2; ++a)
#pragma unroll
            for (int b = 0; b < 2; ++b)
#pragma unroll
                for (int m = 0; m < 4; ++m)
#pragma unroll
                    for (int n = 0; n < 2; ++n) acc[a][b][m][n] = (f32x4){0.f, 0.f, 0.f, 0.f};
        cur = nxt; cA = nA; cB = nB; ++ui;
        if constexpr (ALIGN_EPI) { if (wr == 1) PG8_BAR; }
    }
    PG8_WAIT_V(0);
    if constexpr (!ALIGN_EPI) { if (wr == 0) PG8_BAR; }
    PG8_BAR;
    if constexpr (Epi::AFTER_DRAIN) { E.fused(acc, cur, wr, wc, fr, fq, lds, wid, lane); S.done(cur); }
#undef PG8_SA
#undef PG8_SB
#undef PG8_STAGE
#undef PG8_LDA
#undef PG8_LDB
#undef PG8_MMA
#undef PG8_WAIT_V
#undef PG8_WAIT_L
#undef PG8_BAR
#undef PG8_SCHED
}
}

namespace pg8 {
struct EpiProj {
    static constexpr bool PERM = true, AFTER_DRAIN = false;
    bf16_t* O;
    __device__ __forceinline__ void operator()(const f32x4 (&acc)[2][2][4][2], const Unit& u, int wr, int wc, int fr, int fq) const {
        const int row0 = u.pm * BM + wr * 64 + fr, col0 = u.pn * BM + wc * 32 + 8 * fq;
        const float sc = (u.pn == 6 || u.pn == 7) ? QSCALE : 1.f;
        const __amdgpu_buffer_rsrc_t rs = wt_rsrc(O, (unsigned)((size_t)16384 * N1 * 2));
#pragma unroll
        for (int ai = 0; ai < 2; ++ai)
#pragma unroll
            for (int m = 0; m < 4; ++m) { const unsigned rowb = (unsigned)(((size_t)(row0 + ai * HALF + m * 16) * N1 + col0) * 2);
#pragma unroll
                for (int bj = 0; bj < 2; ++bj) { const f32x4 v0 = acc[ai][bj][m][0] * sc, v1 = acc[ai][bj][m][1] * sc;
                    u32x4 w; w.x = cvt_pk_bf16(v0[0], v0[1]); w.y = cvt_pk_bf16(v0[2], v0[3]); w.z = cvt_pk_bf16(v1[0], v1[1]); w.w = cvt_pk_bf16(v1[2], v1[3]);
                    wt16(rs, rowb + bj * HALF * 2, w); } }
    }
};
struct EpiBf16 {
    static constexpr bool PERM = true, AFTER_DRAIN = false;
    bf16_t* O; int ldc;
    __device__ __forceinline__ void operator()(const f32x4 (&acc)[2][2][4][2], const Unit& u, int wr, int wc, int fr, int fq) const {
        const int row0 = u.pm * BM + wr * 64 + fr, col0 = u.pn * BM + wc * 32 + 8 * fq;
#pragma unroll
        for (int ai = 0; ai < 2; ++ai)
#pragma unroll
            for (int m = 0; m < 4; ++m) { bf16_t* rowp = O + (size_t)(row0 + ai * HALF + m * 16) * ldc + col0;
#pragma unroll
                for (int bj = 0; bj < 2; ++bj) { const f32x4 v0 = acc[ai][bj][m][0], v1 = acc[ai][bj][m][1];
                    u32x4 w; w.x = cvt_pk_bf16(v0[0], v0[1]); w.y = cvt_pk_bf16(v0[2], v0[3]); w.z = cvt_pk_bf16(v1[0], v1[1]); w.w = cvt_pk_bf16(v1[2], v1[3]);
                    *(u32x4*)(rowp + bj * HALF) = w; } }
    }
};
__device__ __forceinline__ void rms_exchange(const f32x4 (&v)[2][2][4][2], const Unit& u, int wr, int wc, int fr, int fq, PG8_LAS unsigned char* lds, int wid, int lane, float* xbuf, unsigned* cnt) {
    PG8_LAS float* P = (PG8_LAS float*)lds;
    PG8_LAS float* S = (PG8_LAS float*)(lds + 4096);
#pragma unroll
    for (int ai = 0; ai < 2; ++ai)
#pragma unroll
        for (int m = 0; m < 4; ++m) {
            float s = 0.f;
#pragma unroll
            for (int bj = 0; bj < 2; ++bj)
#pragma unroll
                for (int n = 0; n < 2; ++n) { const f32x4 x = v[ai][bj][m][n]; s += (x[0] * x[0] + x[1] * x[1]) + (x[2] * x[2] + x[3] * x[3]); }
            s += __shfl_xor(s, 16); s += __shfl_xor(s, 32);
            if (fq == 0) P[(ai * HALF + wr * 64 + m * 16 + fr) * 4 + wc] = s;
        }
    asm volatile("s_waitcnt lgkmcnt(0)" ::: "memory"); __builtin_amdgcn_s_barrier(); asm volatile("" ::: "memory");
    const int row = wid * 32 + (lane & 31);
    if (lane < 32) {
        const float tot = (P[row * 4 + 0] + P[row * 4 + 1]) + (P[row * 4 + 2] + P[row * 4 + 3]);
        __hip_atomic_store((unsigned*)xbuf + (size_t)(u.pm * BM + row) * 4 + u.pn, __builtin_bit_cast(unsigned, tot), __ATOMIC_RELAXED, __HIP_MEMORY_SCOPE_AGENT);
    }
    asm volatile("s_waitcnt vmcnt(0)" ::: "memory");
    if (lane == 0) __hip_atomic_fetch_add(cnt + 64 * u.pm, 1u, __ATOMIC_RELAXED, __HIP_MEMORY_SCOPE_AGENT);
    if (wid == 0) {
        unsigned sp = 0u;
        while ((unsigned)__builtin_amdgcn_readfirstlane(__hip_atomic_load(cnt + 64 * u.pm, __ATOMIC_RELAXED, __HIP_MEMORY_SCOPE_AGENT)) < 32u) { __builtin_amdgcn_s_sleep(2); if (++sp > (1u << 22)) break; }
        __builtin_amdgcn_fence(__ATOMIC_ACQUIRE, "agent");
    }
    asm volatile("s_waitcnt vmcnt(0) lgkmcnt(0)" ::: "memory"); __builtin_amdgcn_s_barrier(); asm volatile("" ::: "memory");
    if (lane < 32) {
        const unsigned* slot = (const unsigned*)xbuf + (size_t)(u.pm * BM + row) * 4; float q = 0.f;
#pragma unroll
        for (int t = 0; t < 4; ++t) q += __builtin_bit_cast(float, __hip_atomic_load(slot + t, __ATOMIC_RELAXED, __HIP_MEMORY_SCOPE_AGENT));
        S[row] = rsqrtf(q * (1.f / 1024.f) + 1e-6f);
    }
    asm volatile("s_waitcnt vmcnt(0) lgkmcnt(0)" ::: "memory"); __builtin_amdgcn_s_barrier(); asm volatile("" ::: "memory");
}
struct EpiRmsRes {
    static constexpr bool PERM = false, AFTER_DRAIN = true;
    const bf16_t* x1b; float* out; const float* gain; float* xbuf; unsigned* cnt;
    __device__ __forceinline__ void fused(f32x4 (&acc)[2][2][4][2], const Unit& u, int wr, int wc, int fr, int fq, PG8_LAS unsigned char* lds, int wid, int lane) const {
        typedef unsigned u32x2v __attribute__((ext_vector_type(2)));
        const PG8_LAS float* S = (const PG8_LAS float*)(lds + 4096);
        const int col0 = u.pn * BM + wc * 32 + 4 * fq;
        u32x2v pre[2][4][2][2];
#pragma unroll
        for (int ai = 0; ai < 2; ++ai)
#pragma unroll
            for (int m = 0; m < 4; ++m) { const size_t off = (size_t)(u.pm * BM + ai * HALF + wr * 64 + m * 16 + fr) * 1024 + col0;
#pragma unroll
                for (int bj = 0; bj < 2; ++bj)
#pragma unroll
                    for (int n = 0; n < 2; ++n) pre[ai][m][bj][n] = *(const u32x2v*)(x1b + off + bj * HALF + n * 16); }
        rms_exchange(acc, u, wr, wc, fr, fq, lds, wid, lane, xbuf, cnt);
        f32x4 gv[2][2];
#pragma unroll
        for (int bj = 0; bj < 2; ++bj)
#pragma unroll
            for (int n = 0; n < 2; ++n) gv[bj][n] = *(const f32x4*)(gain + col0 + bj * HALF + n * 16);
#pragma unroll
        for (int ai = 0; ai < 2; ++ai)
#pragma unroll
            for (int m = 0; m < 4; ++m) { const int r = ai * HALF + wr * 64 + m * 16 + fr; const float rs = S[r]; const size_t off = (size_t)(u.pm * BM + r) * 1024 + col0;
#pragma unroll
                for (int bj = 0; bj < 2; ++bj)
#pragma unroll
                    for (int n = 0; n < 2; ++n) { const u32x2v pv = pre[ai][m][bj][n];
                        const f32x4 bs = {__builtin_bit_cast(float, pv.x << 16), __builtin_bit_cast(float, pv.x & 0xffff0000u), __builtin_bit_cast(float, pv.y << 16), __builtin_bit_cast(float, pv.y & 0xffff0000u)};
                        *(f32x4*)(out + off + bj * HALF + n * 16) = bs + acc[ai][bj][m][n] * rs * gv[bj][n]; } }
    }
};
struct EpiRmsResRms {
    static constexpr bool PERM = false, AFTER_DRAIN = true;
    const float* x; bf16_t* x1b; bf16_t* h2; const float* g1; const float* g2; float* xbuf1; unsigned* cnt1; float* xbuf2; unsigned* cnt2;
    __device__ __forceinline__ void fused(f32x4 (&acc)[2][2][4][2], const Unit& u, int wr, int wc, int fr, int fq, PG8_LAS unsigned char* lds, int wid, int lane) const {
        typedef unsigned u32x2v __attribute__((ext_vector_type(2)));
        const PG8_LAS float* S = (const PG8_LAS float*)(lds + 4096);
        const int col0 = u.pn * BM + wc * 32 + 4 * fq;
        rms_exchange(acc, u, wr, wc, fr, fq, lds, wid, lane, xbuf1, cnt1);
        {
            f32x4 gv[2][2];
#pragma unroll
            for (int bj = 0; bj < 2; ++bj)
#pragma unroll
                for (int n = 0; n < 2; ++n) gv[bj][n] = *(const f32x4*)(g1 + col0 + bj * HALF + n * 16);
#pragma unroll
            for (int ai = 0; ai < 2; ++ai)
#pragma unroll
                for (int m = 0; m < 4; ++m) { const int r = ai * HALF + wr * 64 + m * 16 + fr; const float rs = S[r]; const size_t off = (size_t)(u.pm * BM + r) * 1024 + col0;
#pragma unroll
                    for (int bj = 0; bj < 2; ++bj)
#pragma unroll
                        for (int n = 0; n < 2; ++n) { const f32x4 bs = *(const f32x4*)(x + off + bj * HALF + n * 16); acc[ai][bj][m][n] = bs + acc[ai][bj][m][n] * rs * gv[bj][n]; }
                    asm volatile("" : "+v"(acc[ai][0][m][0]), "+v"(acc[ai][0][m][1]), "+v"(acc[ai][1][m][0]), "+v"(acc[ai][1][m][1]));
                    if (m & 1) asm volatile("" ::: "memory"); }
        }
        rms_exchange(acc, u, wr, wc, fr, fq, lds, wid, lane, xbuf2, cnt2);
        f32x4 gv[2][2];
#pragma unroll
        for (int bj = 0; bj < 2; ++bj)
#pragma unroll
            for (int n = 0; n < 2; ++n) gv[bj][n] = *(const f32x4*)(g2 + col0 + bj * HALF + n * 16);
#pragma unroll
        for (int ai = 0; ai < 2; ++ai)
#pragma unroll
            for (int m = 0; m < 4; ++m) { const int r = ai * HALF + wr * 64 + m * 16 + fr; const float rs = S[r]; const size_t off = (size_t)(u.pm * BM + r) * 1024 + col0;
#pragma unroll
                for (int bj = 0; bj < 2; ++bj)
#pragma unroll
                    for (int n = 0; n < 2; ++n) { const f32x4 x1 = acc[ai][bj][m][n]; { u32x2v xw; xw.x = cvt_pk_bf16(x1[0], x1[1]); xw.y = cvt_pk_bf16(x1[2], x1[3]); *(u32x2v*)(x1b + off + bj * HALF + n * 16) = xw; }
                        const f32x4 o = x1 * rs * gv[bj][n]; u32x2v w; w.x = cvt_pk_bf16(o[0], o[1]); w.y = cvt_pk_bf16(o[2], o[3]); *(u32x2v*)(h2 + off + bj * HALF + n * 16) = w; }
                asm volatile("" ::: "memory"); }
    }
};
struct EpiF32 {
    static constexpr bool PERM = true, AFTER_DRAIN = false;
    float* O; int ldc;
    __device__ __forceinline__ void operator()(const f32x4 (&acc)[2][2][4][2], const Unit& u, int wr, int wc, int fr, int fq) const {
        const int row0 = u.pm * BM + wr * 64 + fr, col0 = u.pn * BM + wc * 32 + 8 * fq;
#pragma unroll
        for (int ai = 0; ai < 2; ++ai)
#pragma unroll
            for (int m = 0; m < 4; ++m) { float* rowp = O + (size_t)(row0 + ai * HALF + m * 16) * ldc + col0;
#pragma unroll
                for (int bj = 0; bj < 2; ++bj) { *(f32x4*)(rowp + bj * HALF) = acc[ai][bj][m][0]; *(f32x4*)(rowp + bj * HALF + 4) = acc[ai][bj][m][1]; } }
    }
};
struct EpiSwiglu {
    static constexpr bool PERM = true, AFTER_DRAIN = false;
    bf16_t* O;
    __device__ __forceinline__ void operator()(const f32x4 (&acc)[2][2][4][2], const Unit& u, int wr, int wc, int fr, int fq) const {
        const int row0 = u.pm * BM + wr * 64 + fr, col0 = u.pn * HALF + wc * 32 + 8 * fq;
        const __amdgpu_buffer_rsrc_t rs = wt_rsrc(O, 96u << 20);
        const unsigned bshift = (unsigned)(u.pm >> 3) << 20;
#pragma unroll
        for (int ai = 0; ai < 2; ++ai)
#pragma unroll
            for (int m = 0; m < 4; ++m) { const unsigned rowb = (unsigned)(((size_t)(row0 + ai * HALF + m * 16) * DFF + col0) * 2) + bshift;
                float r[8];
#pragma unroll
                for (int n = 0; n < 2; ++n)
#pragma unroll
                    for (int e = 0; e < 4; ++e) { const float g = acc[ai][0][m][n][e], up = acc[ai][1][m][n][e];
                        r[4 * n + e] = g * __builtin_amdgcn_rcpf(1.f + __expf(-g)) * up; }
                u32x4 w; w.x = cvt_pk_bf16(r[0], r[1]); w.y = cvt_pk_bf16(r[2], r[3]); w.z = cvt_pk_bf16(r[4], r[5]); w.w = cvt_pk_bf16(r[6], r[7]);
                wt16(rs, rowb, w); }
    }
};
}

struct Args {
    const float* x; const float* pre_mix_gain; const float* w_in; const float* conv_w; const float* conv_b; const float* dt_bias; const float* a_log; const float* d_skip;
    const float* ssd_norm_gain; const float* sb_norm_gain; const float* w_out; const float* post_mix_gain; const float* pre_ffn_gain; const float* w_gate; const float* w_up;
    const float* w_down; const float* post_ffn_gain; float* out; unsigned char* ws; int ph_lo, ph_hi;
};

__device__ __forceinline__ void transpose_item(const float* src, int ldw, bf16* dst, int K, LAS float* scr, int lane, __amdgpu_buffer_rsrc_t wr, const bf16* wbase) {
    float tv[32];
#pragma unroll
    for (int i = 0; i < 32; ++i) tv[i] = src[(size_t)(2 * i + (lane >> 5)) * ldw + (lane & 31)];
#pragma unroll
    for (int i = 0; i < 32; ++i) scr[(2 * i + (lane >> 5)) * 33 + (lane & 31)] = tv[i];
    asm volatile("s_waitcnt lgkmcnt(0)" ::: "memory");
    const int c = lane & 7;
#pragma unroll
    for (int j = 0; j < 4; ++j) { const int n = (lane >> 3) + 8 * j; const LAS float* s = scr + (8 * c) * 33 + n;
        v4u o; o.x = pk2(s[0 * 33], s[1 * 33]); o.y = pk2(s[2 * 33], s[3 * 33]); o.z = pk2(s[4 * 33], s[5 * 33]); o.w = pk2(s[6 * 33], s[7 * 33]);
        wt16(wr, (unsigned)((dst + (size_t)n * K + 8 * c - wbase) * 2), o); }
    asm volatile("s_waitcnt lgkmcnt(0)" ::: "memory");
}

__device__ __forceinline__ void phase_p0(const Args& a, LAS unsigned char* lds, bool defer_w4) {
    const int tid = threadIdx.x, lane = tid & 63, wave = tid >> 6;
    const int gw = blockIdx.x * NWAVES + wave, NGW = gridDim.x * NWAVES;
    unsigned char* ws = a.ws;
    LAS float* scr = (LAS float*)(lds + wave * 8704);
    LAS float* wdt = (LAS float*)(lds + 73728);
    for (int i = tid; i < 8192; i += NTHR) { const int hd = i & 7, k = i >> 3; wdt[hd * 1024 + k] = a.w_in[(size_t)k * DIN + 1536 + hd]; }
    __syncthreads();
    bf16* W1 = (bf16*)(ws + WS_W1); bf16* W2 = (bf16*)(ws + WS_W2); bf16* W3 = (bf16*)(ws + WS_W3); bf16* W4 = (bf16*)(ws + WS_W4);
    const __amdgpu_buffer_rsrc_t wrs = wt_rsrc(W1, 25u << 20);
    constexpr int I1 = 16 * 48, I2 = 16 * 32, I3 = 16 * 88, I4 = 44 * 32;
    const int NITEMS = 2 * I1 + I2 + 2 * I3 + (defer_w4 ? 0 : I4);
    for (int _rp = 0; _rp < 1 + (((REPMASK) >> 12) & 1); ++_rp)
    for (int it = gw; it < NITEMS; it += NGW) {
        int r = it;
        if (r < I1) { const int kb = r / 48, nb = r % 48; transpose_item(a.w_in + (size_t)(64 * kb) * DIN + 32 * nb, DIN, W1 + (size_t)(32 * nb) * 1024 + 64 * kb, 1024, scr, lane, wrs, W1); continue; } r -= I1;
        if (r < I1) { const int kb = r / 48, nb = r % 48; transpose_item(a.w_in + (size_t)(64 * kb) * DIN + 1544 + 32 * nb, DIN, W1 + (size_t)(1536 + 32 * nb) * 1024 + 64 * kb, 1024, scr, lane, wrs, W1); continue; } r -= I1;
        if (r < I2) { const int kb = r / 32, nb = r % 32; transpose_item(a.w_out + (size_t)(64 * kb) * 1024 + 32 * nb, 1024, W2 + (size_t)(32 * nb) * 1024 + 64 * kb, 1024, scr, lane, wrs, W1); continue; } r -= I2;
        if (r < I3) { const int kb = r / 88, nb = r % 88, n0 = 32 * nb; transpose_item(a.w_gate + (size_t)(64 * kb) * DFF + n0, DFF, W3 + (size_t)(256 * (n0 >> 7) + (n0 & 127)) * 1024 + 64 * kb, 1024, scr, lane, wrs, W1); continue; } r -= I3;
        if (r < I3) { const int kb = r / 88, nb = r % 88, n0 = 32 * nb; transpose_item(a.w_up + (size_t)(64 * kb) * DFF + n0, DFF, W3 + (size_t)(256 * (n0 >> 7) + 128 + (n0 & 127)) * 1024 + 64 * kb, 1024, scr, lane, wrs, W1); continue; } r -= I3;
        { const int kb = r / 32, nb = r % 32; transpose_item(a.w_down + (size_t)(64 * kb) * 1024 + 32 * nb, 1024, W4 + (size_t)(32 * nb) * DFF + 64 * kb, DFF, scr, lane, wrs, W1); }
    }
    bf16* H = (bf16*)(ws + WS_H); float* DT = (float*)(ws + WS_DT);
    const int hh = lane >> 5, b4 = (lane >> 4) & 1, b3 = (lane >> 3) & 1;
    v4f gpm[4];
#pragma unroll
    for (int j = 0; j < 4; ++j) gpm[j] = ((const v4f*)a.pre_mix_gain)[lane + 64 * j];
    v4f v[4], vn[4];
    if (gw < M) {
#pragma unroll
        for (int j = 0; j < 4; ++j) v[j] = ((const v4f*)(a.x + (size_t)gw * DM))[lane + 64 * j];
    }
    for (int _rq = 0; _rq < 1 + (((REPMASK) >> 13) & 1); ++_rq)
    for (int m = gw; m < M; m += NGW) {
        const int mn = m + NGW < M ? m + NGW : gw;
        if (true) {
#pragma unroll
            for (int j = 0; j < 4; ++j) vn[j] = ((const v4f*)(a.x + (size_t)mn * DM))[lane + 64 * j];
        }
        float s = 0.f;
#pragma unroll
        for (int j = 0; j < 4; ++j) s += (v[j].x * v[j].x + v[j].y * v[j].y) + (v[j].z * v[j].z + v[j].w * v[j].w);
        const float rstd = rsqrtf(wave_sum(s) * (1.f / DM) + EPS);
        float da[8];
#pragma unroll
        for (int hd = 0; hd < 8; ++hd) da[hd] = 0.f;
        unsigned long long* o8 = (unsigned long long*)(H + (size_t)m * DM) + lane;
#pragma unroll
        for (int j = 0; j < 4; ++j) {
            const v4f hv = v[j] * rstd * gpm[j];
            wt8(o8 + 64 * j, pk2(hv.x, hv.y), pk2(hv.z, hv.w));
#pragma unroll
            for (int hd = 0; hd < 8; ++hd) { const v4f w = *(const LAS v4f*)(wdt + hd * 1024 + 4 * lane + 256 * j); da[hd] += (hv.x * w.x + hv.y * w.y) + (hv.z * w.z + hv.w * w.w); }
        }
        float k4[4], k2[2], k1;
#pragma unroll
        for (int i = 0; i < 4; ++i) { const float keep = hh ? da[4 + i] : da[i], send = hh ? da[i] : da[4 + i]; k4[i] = keep + __shfl_xor(send, 32); }
#pragma unroll
        for (int i = 0; i < 2; ++i) { const float keep = b4 ? k4[2 + i] : k4[i], send = b4 ? k4[i] : k4[2 + i]; k2[i] = keep + __shfl_xor(send, 16); }
        { const float keep = b3 ? k2[1] : k2[0], send = b3 ? k2[0] : k2[1]; k1 = keep + __shfl_xor(send, 8); }
        k1 += __shfl_xor(k1, 4); k1 += __shfl_xor(k1, 2); k1 += __shfl_xor(k1, 1);
        if ((lane & 7) == 0) DT[(size_t)m * 8 + (lane >> 3)] = k1;
#pragma unroll
        for (int j = 0; j < 4; ++j) v[j] = vn[j];
    }
}

__device__ __forceinline__ void phase_w4(const Args& a, LAS unsigned char* lds) {
    if (blockIdx.x < 128) return;
    const int lane = threadIdx.x & 63, wave = threadIdx.x >> 6, gw = (blockIdx.x - 128) * NWAVES + wave, NGW = 128 * NWAVES;
    LAS float* scr = (LAS float*)(lds + wave * 8704);
    bf16* W1 = (bf16*)(a.ws + WS_W1); bf16* W4 = (bf16*)(a.ws + WS_W4);
    const __amdgpu_buffer_rsrc_t wrs = wt_rsrc(W1, 25u << 20);
    for (int r = gw; r < 44 * 32; r += NGW) { const int kb = r / 32, nb = r % 32; transpose_item(a.w_down + (size_t)(64 * kb) * 1024 + 32 * nb, 1024, W4 + (size_t)(32 * nb) * DFF + 64 * kb, DFF, scr, lane, wrs, W1); }
}

__device__ __forceinline__ void phase_conv_naive(const Args& a) {
    const bf16* PROJ = (const bf16*)(a.ws + WS_PROJ); float* XC = (float*)(a.ws + WS_CS);
    const size_t total = (size_t)M * 1024, stride = (size_t)gridDim.x * NTHR;
    for (size_t idx = (size_t)blockIdx.x * NTHR + threadIdx.x; idx < total; idx += stride) {
        const int m = (int)(idx >> 10), ch = (int)(idx & 1023), t = m & (SEQ - 1);
        float acc = a.conv_b[ch];
#pragma unroll
        for (int j = 0; j < 4; ++j) { const int tt = t - 3 + j; if (tt >= 0) acc += a.conv_w[j * 1024 + ch] * bf2f(PROJ[(size_t)(m - 3 + j) * N1 + PX + ch]); }
        XC[idx] = siluf(acc);
    }
}

__device__ __forceinline__ void phase_ssd_naive(const Args& a, LAS unsigned char* lds) {
    if (blockIdx.x >= 16) return;
    const int tid = threadIdx.x, lane = tid & 63, wave = tid >> 6;
    const int b = blockIdx.x >> 1, g = blockIdx.x & 1;
    const bool act = tid < 256;
    const int hl = (tid >> 6) & 3, p = tid & 63, h = 4 * g + hl;
    const bf16* PROJ = (const bf16*)(a.ws + WS_PROJ); const float* XC = (const float*)(a.ws + WS_CS); const float* DT = (const float*)(a.ws + WS_DT);
    bf16* YC = (bf16*)(a.ws + WS_H);
    LAS float* sBC = (LAS float*)lds; LAS float* red = (LAS float*)(lds + 1024);
    float st[128];
#pragma unroll
    for (int n = 0; n < 128; ++n) st[n] = 0.f;
    const float av = -__expf(a.a_log[h]), dtb = a.dt_bias[h], dsk = a.d_skip[h], gain = a.ssd_norm_gain[g * 256 + hl * 64 + p];
    for (int t = 0; t < SEQ; ++t) {
        const size_t m = (size_t)b * SEQ + t;
        if (act) sBC[tid] = XC[m * 1024 + (tid < 128 ? 512 + g * 128 + tid : 768 + g * 128 + (tid - 128))];
        __syncthreads();
        float y = 0.f;
        if (act) {
            const float dt = softplusf(DT[m * 8 + h] + dtb), dA = __expf(dt * av), xv = XC[m * 1024 + h * 64 + p], dx = dt * xv;
#pragma unroll
            for (int n = 0; n < 128; ++n) { st[n] = st[n] * dA + dx * sBC[n]; y += sBC[128 + n] * st[n]; }
            y += dsk * xv;
            y *= siluf(bf2f(PROJ[m * N1 + PZ + h * 64 + p]));
        }
        const float ss = wave_sum(y * y);
        if (lane == 0) red[wave] = ss;
        __syncthreads();
        const float tot = (red[0] + red[1]) + (red[2] + red[3]);
        if (act) YC[m * 1024 + h * 64 + p] = (bf16)f2bf(y * rsqrtf(tot * (1.f / 256.f) + EPS) * gain);
    }
}

__device__ __forceinline__ void phase_attn_naive(const Args& a, LAS unsigned char* lds) {
    const int tid = threadIdx.x;
    const bf16* PROJ = (const bf16*)(a.ws + WS_PROJ); bf16* YC = (bf16*)(a.ws + WS_H);
    LAS float* sK = (LAS float*)(lds + 4096); LAS float* sV = (LAS float*)(lds + 4096 + 16384);
    for (int unit = blockIdx.x; unit < 256; unit += gridDim.x) {
        const int b = unit >> 5, h = (unit >> 2) & 7, qb = unit & 3;
        const int t = qb * 512 + tid; const size_t m = (size_t)b * SEQ + t;
        float q[64], o[64];
#pragma unroll
        for (int d = 0; d < 64; ++d) { q[d] = bf2f(PROJ[m * N1 + PQ + h * 64 + d]); o[d] = 0.f; }
        float P = 1.f;
        for (int kt = qb * 8 + 7; kt >= 0; --kt) {
            __syncthreads();
#pragma unroll
            for (int i = 0; i < 8; ++i) { const int idx = tid + 512 * i, key = idx >> 6, d = idx & 63; const size_t mk = (size_t)b * SEQ + kt * 64 + key;
                sK[idx] = bf2f(PROJ[mk * N1 + PK + h * 64 + d]); sV[idx] = bf2f(PROJ[mk * N1 + PV + h * 64 + d]); }
            __syncthreads();
            for (int kk = 63; kk >= 0; --kk) {
                const int s = kt * 64 + kk;
                if (s < t) {
                    float z = 0.f;
#pragma unroll
                    for (int d = 0; d < 64; ++d) z += q[d] * sK[kk * 64 + d];
                    z = fminf(z, 100.f);
                    const float e = exp2f(z), r = 1.f / (1.f + e);
                    P *= r;
                    const float w = e * P;
#pragma unroll
                    for (int d = 0; d < 64; ++d) o[d] += w * sV[kk * 64 + d];
                }
            }
        }
        float ss = 0.f;
#pragma unroll
        for (int d = 0; d < 64; ++d) ss += o[d] * o[d];
        const float rstd = rsqrtf(ss * (1.f / 64.f) + EPS);
#pragma unroll
        for (int d = 0; d < 64; ++d) YC[m * 1024 + 512 + h * 64 + d] = (bf16)f2bf(o[d] * rstd * a.sb_norm_gain[h * 64 + d]);
    }
}


typedef short v4i16 __attribute__((ext_vector_type(4)));
typedef short bf16x8v __attribute__((ext_vector_type(8)));
constexpr int AT_KSTR = 144, AT_KBYTES = 64 * AT_KSTR, AT_VBYTES = 64 * 128, AT_BUF = AT_KBYTES + AT_VBYTES;
#define MFMA32(a, b, c) __builtin_amdgcn_mfma_f32_32x32x16_bf16((a), (b), (c), 0, 0, 0)

template <bool DIAG>
__device__ __forceinline__ void attn_tile(LAS const unsigned char* Kb, LAS const unsigned char* Vb, const bf16x8v (&qf)[4], f32x16& o0, f32x16& o1, float& carry,
                                          int qrel, int l32, int hh, unsigned vbase0, unsigned vbase1) {
    f32x16 p[2];
    bf16x8v kf[2][4];
#pragma unroll
    for (int blk = 0; blk < 2; ++blk)
#pragma unroll
        for (int s = 0; s < 4; ++s) kf[blk][s] = *(LAS const bf16x8v*)(Kb + (32 * blk + l32) * AT_KSTR + 32 * s + 16 * hh);
    asm volatile("s_waitcnt lgkmcnt(0)" ::: "memory");
#pragma unroll
    for (int bi = 0; bi < 2; ++bi) {
        const int blk = 1 - bi;
#pragma unroll
        for (int i = 0; i < 16; ++i) p[blk][i] = 0.f;
#pragma unroll
        for (int s = 0; s < 4; ++s) p[blk] = MFMA32(kf[blk][s], qf[s], p[blk]);
    }
#pragma unroll
    for (int bi = 0; bi < 2; ++bi) {
        const int blk = 1 - bi;
        float R[16];
#pragma unroll
        for (int i = 0; i < 16; ++i) {
            float rv = __builtin_amdgcn_rcpf(1.f + __builtin_amdgcn_exp2f(p[blk][i]));
            if (DIAG) { const int krel = 32 * blk + (i & 3) + 8 * (i >> 2) + 4 * hh; if (krel >= qrel) rv = 1.f; }
            R[i] = rv;
        }
        float GG[4], sel[4];
#pragma unroll
        for (int g = 0; g < 4; ++g) { R[4 * g + 2] *= R[4 * g + 3]; R[4 * g + 1] *= R[4 * g + 2]; R[4 * g] *= R[4 * g + 1]; }
#pragma unroll
        for (int g = 0; g < 4; g += 2) {
            const unsigned ua = __builtin_bit_cast(unsigned, R[4 * g]), ub = __builtin_bit_cast(unsigned, R[4 * g + 4]);
            auto s1 = __builtin_amdgcn_permlane32_swap(ua, ub, false, false);
            auto s2 = __builtin_amdgcn_permlane32_swap(ub, ua, false, false);
            const float pa = __builtin_bit_cast(float, hh ? s2[0] : s1[1]), pb2 = __builtin_bit_cast(float, hh ? s1[0] : s2[1]);
            GG[g] = R[4 * g] * pa; GG[g + 1] = R[4 * g + 4] * pb2;
            sel[g] = hh ? 1.f : pa; sel[g + 1] = hh ? 1.f : pb2;
        }
        float T3 = carry, T2 = T3 * GG[3], T1 = T2 * GG[2], T0 = T1 * GG[1];
        carry = T0 * GG[0];
        const float base[4] = {T0 * sel[0], T1 * sel[1], T2 * sel[2], T3 * sel[3]};
        float w[16];
#pragma unroll
        for (int g = 0; g < 4; ++g) {
            w[4 * g + 3] = base[g] * (1.f - R[4 * g + 3]); w[4 * g + 2] = base[g] * (R[4 * g + 3] - R[4 * g + 2]);
            w[4 * g + 1] = base[g] * (R[4 * g + 2] - R[4 * g + 1]); w[4 * g] = base[g] * (R[4 * g + 1] - R[4 * g]);
        }
#pragma unroll
        for (int s = 0; s < 2; ++s) {
            v4u pk; pk.x = cvtpk(w[8 * s], w[8 * s + 1]); pk.y = cvtpk(w[8 * s + 2], w[8 * s + 3]); pk.z = cvtpk(w[8 * s + 4], w[8 * s + 5]); pk.w = cvtpk(w[8 * s + 6], w[8 * s + 7]);
            const bf16x8v pb = __builtin_bit_cast(bf16x8v, pk);
            const int rowoff = (32 * blk + 16 * s) * 128;
            const v4i16 a0l = __builtin_amdgcn_ds_read_tr16_b64_v4i16((LAS v4i16*)(Vb + vbase0 + rowoff));
            const v4i16 a0h = __builtin_amdgcn_ds_read_tr16_b64_v4i16((LAS v4i16*)(Vb + vbase0 + rowoff + 8 * 128));
            const v4i16 a1l = __builtin_amdgcn_ds_read_tr16_b64_v4i16((LAS v4i16*)(Vb + vbase1 + rowoff));
            const v4i16 a1h = __builtin_amdgcn_ds_read_tr16_b64_v4i16((LAS v4i16*)(Vb + vbase1 + rowoff + 8 * 128));
            const bf16x8v va0 = __builtin_shufflevector(a0l, a0h, 0, 1, 2, 3, 4, 5, 6, 7), va1 = __builtin_shufflevector(a1l, a1h, 0, 1, 2, 3, 4, 5, 6, 7);
            o0 = MFMA32(va0, pb, o0); o1 = MFMA32(va1, pb, o1);
        }
    }
}

__device__ __forceinline__ void attn_unit(const Args& a, LAS unsigned char* lds, int b, int h, int qb) {
    const int tid = threadIdx.x, lane = tid & 63, w = __builtin_amdgcn_readfirstlane(tid >> 6), l32 = lane & 31, hh = lane >> 5;
    const bf16* PROJ = (const bf16*)(a.ws + WS_PROJ); bf16* YC = (bf16*)(a.ws + WS_H);
    const size_t rowbase = (size_t)b * SEQ;
    const int q0 = qb * 256 + 32 * w, ktd = q0 >> 6, ktmax = 4 * qb + 3, qrel = 32 * (w & 1) + l32;
    bf16x8v qf[4];
    { const bf16* qp = PROJ + (rowbase + q0 + l32) * N1 + PQ + h * 64 + 8 * hh;
#pragma unroll
      for (int s = 0; s < 4; ++s) qf[s] = *(const bf16x8v*)(qp + 16 * s); }
    f32x16 o0, o1;
#pragma unroll
    for (int i = 0; i < 16; ++i) { o0[i] = 0.f; o1[i] = 0.f; }
    float carry = 1.f;
    const int skey = tid >> 3, sc = tid & 7;
    const bf16* kg = PROJ + (rowbase + skey) * N1 + PK + h * 64 + 8 * sc;
    const unsigned kwoff = skey * AT_KSTR + sc * 16, vwoff = AT_KBYTES + skey * 128 + ((sc * 16) ^ (((skey >> 1) & 1) << 6));
    const int gi = (lane >> 4) & 1, q4 = (lane & 15) >> 2, pp = lane & 3;
    const unsigned vb = (4 * hh + q4) * 128 + 32 * gi + 8 * pp, xq = (q4 >> 1) << 6;
    const unsigned vbase0 = vb + xq, vbase1 = vb + (64 ^ xq);
    LAS unsigned* dflag = (LAS unsigned*)(lds + 6 * AT_BUF);
    bool wdone = false;
    const int tlo = ktmax >= 5 ? ktmax - 5 : 0, nwin = ktmax - tlo + 1;
    {
        v4u kr[6], vr[6];
#pragma unroll
        for (int i = 0; i < 6; ++i) if (i < nwin) { const size_t t = (size_t)(tlo + i) * 64 * N1; kr[i] = *(const v4u*)(kg + t); vr[i] = *(const v4u*)(kg + t + (PV - PK)); }
#pragma unroll
        for (int i = 0; i < 6; ++i) if (i < nwin) { *(LAS v4u*)(lds + i * AT_BUF + kwoff) = kr[i]; *(LAS v4u*)(lds + i * AT_BUF + vwoff) = vr[i]; }
    }
    __syncthreads();
#pragma unroll 1
    for (int kt = ktd; kt >= tlo; --kt) {
        if (!wdone) {
            LAS unsigned char* bt = lds + (kt - tlo) * AT_BUF;
            if (kt == ktd) attn_tile<true>(bt, bt + AT_KBYTES, qf, o0, o1, carry, qrel, l32, hh, vbase0, vbase1);
            else attn_tile<false>(bt, bt + AT_KBYTES, qf, o0, o1, carry, qrel, l32, hh, vbase0, vbase1);
            wdone = __builtin_amdgcn_ballot_w64(carry >= 3.5527137e-15f) == 0ull;
        }
    }
    if (lane == 0) dflag[16 + w] = wdone ? 1u : 0u;
    __syncthreads();
    bool alldone;
    { const v4u f0 = *(const LAS v4u*)(dflag + 16), f1 = *(const LAS v4u*)(dflag + 20);
      alldone = __builtin_amdgcn_readfirstlane((f0.x & f0.y & f0.z & f0.w) & (f1.x & f1.y & f1.z & f1.w)) != 0u; }
    if (!alldone && tlo > 0) {
        const int npair = tlo >> 1;
        const bf16* kg2 = kg + (size_t)64 * N1;
        v4u kr0, vr0, kr1, vr1;
        { const size_t t = (size_t)(npair - 1) * 128 * N1;
          kr0 = *(const v4u*)(kg + t); vr0 = *(const v4u*)(kg + t + (PV - PK)); kr1 = *(const v4u*)(kg2 + t); vr1 = *(const v4u*)(kg2 + t + (PV - PK)); }
        *(LAS v4u*)(lds + AT_BUF + kwoff) = kr0; *(LAS v4u*)(lds + AT_BUF + vwoff) = vr0; *(LAS v4u*)(lds + kwoff) = kr1; *(LAS v4u*)(lds + vwoff) = vr1;
        __syncthreads();
        int cur = 0, it = 0;
        for (int pj = npair - 1; pj >= 0; --pj, ++it) {
            if (pj > 0) { const size_t t = (size_t)(pj - 1) * 128 * N1;
                kr0 = *(const v4u*)(kg + t); vr0 = *(const v4u*)(kg + t + (PV - PK)); kr1 = *(const v4u*)(kg2 + t); vr1 = *(const v4u*)(kg2 + t + (PV - PK)); }
            LAS unsigned char* bh = lds + cur * (2 * AT_BUF); LAS unsigned char* bl = bh + AT_BUF;
            if (!wdone) {
                attn_tile<false>(bh, bh + AT_KBYTES, qf, o0, o1, carry, qrel, l32, hh, vbase0, vbase1);
                if (__builtin_amdgcn_ballot_w64(carry >= 3.5527137e-15f) != 0ull)
                    attn_tile<false>(bl, bl + AT_KBYTES, qf, o0, o1, carry, qrel, l32, hh, vbase0, vbase1);
                wdone = __builtin_amdgcn_ballot_w64(carry >= 3.5527137e-15f) == 0ull;
            }
            if (lane == 0) dflag[(it & 1) * 8 + w] = wdone ? 1u : 0u;
            if (pj > 0) { LAS unsigned char* nb = lds + (cur ^ 1) * (2 * AT_BUF);
                *(LAS v4u*)(nb + AT_BUF + kwoff) = kr0; *(LAS v4u*)(nb + AT_BUF + vwoff) = vr0; *(LAS v4u*)(nb + kwoff) = kr1; *(LAS v4u*)(nb + vwoff) = vr1; }
            __syncthreads();
            cur ^= 1;
            const v4u f0 = *(const LAS v4u*)(dflag + (it & 1) * 8), f1 = *(const LAS v4u*)(dflag + (it & 1) * 8 + 4);
            if (__builtin_amdgcn_readfirstlane((f0.x & f0.y & f0.z & f0.w) & (f1.x & f1.y & f1.z & f1.w)) != 0u) break;
        }
    }
    float ss = 0.f;
#pragma unroll
    for (int i = 0; i < 16; ++i) ss += o0[i] * o0[i] + o1[i] * o1[i];
    ss += __shfl_xor(ss, 32);
    const float rstd = rsqrtf(ss * (1.f / 64.f) + EPS);
    bf16* yp = YC + (rowbase + q0 + l32) * 1024 + 512 + h * 64 + 4 * hh;
    const float* gp = a.sb_norm_gain + h * 64 + 4 * hh;
#pragma unroll
    for (int g = 0; g < 4; ++g) {
        const v4f g0 = *(const v4f*)(gp + 8 * g), g1 = *(const v4f*)(gp + 32 + 8 * g);
        v2u s0, s1;
        s0.x = pk2(o0[4 * g] * rstd * g0.x, o0[4 * g + 1] * rstd * g0.y); s0.y = pk2(o0[4 * g + 2] * rstd * g0.z, o0[4 * g + 3] * rstd * g0.w);
        s1.x = pk2(o1[4 * g] * rstd * g1.x, o1[4 * g + 1] * rstd * g1.y); s1.y = pk2(o1[4 * g + 2] * rstd * g1.z, o1[4 * g + 3] * rstd * g1.w);
        *(v2u*)(yp + 8 * g) = s0; *(v2u*)(yp + 32 + 8 * g) = s1;
    }
}

__device__ __forceinline__ void phase_attn(const Args& a, LAS unsigned char* lds) {
    for (int pid = blockIdx.x; pid < 256; pid += gridDim.x) {
        int bh, qp;
        if (gridDim.x == 256) { const int xcd = pid & 7, j = pid >> 3; bh = xcd * 8 + (j >> 2); qp = j & 3; }
        else { bh = pid >> 2; qp = pid & 3; }
        attn_unit(a, lds, bh >> 3, bh & 7, 7 - qp);
        attn_unit(a, lds, bh >> 3, bh & 7, qp);
    }
}

constexpr int SD_DT = 0, SD_ACS = 1024, SD_WB = 2048, SD_X = 4096, SD_XS = 576, SD_B = 40960, SD_BS = 320, SD_C = 61440, SD_Z = 81920, SD_ZS = 528;

__device__ __forceinline__ float ssd_dt_load(const Args& a, int b, int c, int g) {
    const int tid = threadIdx.x;
    if (tid >= 256) return 0.f;
    return ((const float*)(a.ws + WS_DT))[((size_t)b * SEQ + 64 * c + (tid & 63)) * 8 + 4 * g + (tid >> 6)];
}
template <bool S1>
__device__ __forceinline__ void ssd_dt(const Args& a, LAS unsigned char* lds, int b, int c, int g, float dtraw) {
    const int tid = threadIdx.x, lane = tid & 63;
    if (tid < 256) {
        const int hl = tid >> 6, h = 4 * g + hl;
        const float dtv = softplusf(dtraw + a.dt_bias[h]);
        float cs = dtv * (-__expf(a.a_log[h]));
#pragma unroll
        for (int o = 1; o < 64; o <<= 1) { const float t = __shfl_up(cs, o); if (lane >= o) cs += t; }
        ((LAS float*)(lds + SD_DT))[hl * 64 + lane] = dtv;
        ((LAS float*)(lds + SD_ACS))[hl * 64 + lane] = cs;
        if (S1) {
            const float tot = __shfl(cs, 63);
            ((LAS float*)(lds + SD_WB))[hl * 64 + lane] = __expf(tot - cs) * dtv;
            if (lane == 63) ((float*)(a.ws + WS_CD))[((size_t)b * NCH + c) * 8 + h] = __expf(tot);
        }
    }
}

struct ConvIn { unsigned halo[3]; unsigned vin[32]; };
__device__ __forceinline__ void ssd_conv_load(const Args& a, ConvIn& r, int b, int c, int th, int col) {
    const bf16* PROJ = (const bf16*)(a.ws + WS_PROJ);
    const int t0 = 64 * c + 32 * th;
    const bf16* src = PROJ + ((size_t)b * SEQ + t0) * N1 + PX + col;
#pragma unroll
    for (int j = 0; j < 3; ++j) { unsigned v = 0u; if (t0 - 3 + j >= 0) v = *(const unsigned*)(src + (ptrdiff_t)(j - 3) * N1); r.halo[j] = v; }
#pragma unroll
    for (int i = 0; i < 32; ++i) r.vin[i] = *(const unsigned*)(src + (size_t)i * N1);
}
template <bool SCALE>
__device__ __forceinline__ void ssd_conv_compute(const Args& a, const ConvIn& r, LAS unsigned char* dst, int dstride, int th, int col, const LAS float* wsc) {
    float w0[4], w1[4];
#pragma unroll
    for (int j = 0; j < 4; ++j) { w0[j] = a.conv_w[j * 1024 + col]; w1[j] = a.conv_w[j * 1024 + col + 1]; }
    const float b0 = a.conv_b[col], b1 = a.conv_b[col + 1];
    float u0[3], u1[3];
#pragma unroll
    for (int j = 0; j < 3; ++j) { u0[j] = bflo(r.halo[j]); u1[j] = bfhi(r.halo[j]); }
#pragma unroll
    for (int i = 0; i < 32; ++i) {
        const unsigned v = r.vin[i];
        const float c0 = bflo(v), c1 = bfhi(v);
        float y0 = b0 + w0[0] * u0[0] + w0[1] * u0[1] + w0[2] * u0[2] + w0[3] * c0;
        float y1 = b1 + w1[0] * u1[0] + w1[1] * u1[1] + w1[2] * u1[2] + w1[3] * c1;
        u0[0] = u0[1]; u0[1] = u0[2]; u0[2] = c0; u1[0] = u1[1]; u1[1] = u1[2]; u1[2] = c1;
        y0 = silu_fast(y0); y1 = silu_fast(y1);
        if (SCALE) { const float s = wsc[32 * th + i]; y0 *= s; y1 *= s; }
        *(LAS unsigned*)(dst + (32 * th + i) * dstride) = pk2(y0, y1);
    }
}

__device__ __forceinline__ bf16x8v tr_pair(LAS const unsigned char* p, int rowstride4) {
    const v4i16 lo = __builtin_amdgcn_ds_read_tr16_b64_v4i16((LAS v4i16*)p);
    const v4i16 hi = __builtin_amdgcn_ds_read_tr16_b64_v4i16((LAS v4i16*)(p + rowstride4));
    return __builtin_shufflevector(lo, hi, 0, 1, 2, 3, 4, 5, 6, 7);
}

__device__ __forceinline__ int ssd_item(int item);
__device__ __forceinline__ void phase_ssd_s1(const Args& a, LAS unsigned char* lds) {
    const int tid = threadIdx.x, lane = tid & 63, w = __builtin_amdgcn_readfirstlane(tid >> 6), l32 = lane & 31, hh = lane >> 5;
    const int hl = w >> 1, half = w & 1;
    const int gi = (lane >> 4) & 1, q4 = (lane & 15) >> 2, pp = lane & 3;
    bf16* CS = (bf16*)(a.ws + WS_CS);
    ConvIn cin; float dtraw = 0.f;
    const int cp = tid % 192, th = tid / 192;
    if (blockIdx.x < NB * NCH * 2) { const int it0 = ssd_item(blockIdx.x), g0 = it0 & 1, c0 = (it0 >> 1) & (NCH - 1), b0 = it0 >> 6;
        if (tid < 384) ssd_conv_load(a, cin, b0, c0, th, cp < 128 ? 256 * g0 + 2 * cp : 512 + 128 * g0 + 2 * (cp - 128));
        dtraw = ssd_dt_load(a, b0, c0, g0); }
    for (int item = blockIdx.x; item < NB * NCH * 2; item += gridDim.x) {
        const int it2 = ssd_item(item), g = it2 & 1, c = (it2 >> 1) & (NCH - 1), b = it2 >> 6;
        const int ccol = cp < 128 ? 256 * g + 2 * cp : 512 + 128 * g + 2 * (cp - 128);
        __syncthreads();
        ssd_dt<true>(a, lds, b, c, g, dtraw);
        __syncthreads();
        if (tid < 384) {
            if (cp < 128) ssd_conv_compute<true>(a, cin, lds + SD_X + 4 * cp, SD_XS, th, ccol, (const LAS float*)(lds + SD_WB) + (cp >> 5) * 64);
            else ssd_conv_compute<false>(a, cin, lds + SD_B + 4 * (cp - 128), SD_BS, th, ccol, nullptr);
        }
        __syncthreads();
        { const int itn = item + gridDim.x;
          if (itn < NB * NCH * 2) { const int in2 = ssd_item(itn), gn = in2 & 1, cn = (in2 >> 1) & (NCH - 1), bn = in2 >> 6;
              if (tid < 384) ssd_conv_load(a, cin, bn, cn, th, cp < 128 ? 256 * gn + 2 * cp : 512 + 128 * gn + 2 * (cp - 128));
              dtraw = ssd_dt_load(a, bn, cn, gn); } }
        f32x16 acc[2][2];
#pragma unroll
        for (int i = 0; i < 16; ++i) { acc[0][0][i] = 0.f; acc[0][1][i] = 0.f; acc[1][0][i] = 0.f; acc[1][1][i] = 0.f; }
#pragma unroll
        for (int s = 0; s < 4; ++s) {
            const int l0 = 16 * s + 8 * hh + q4;
            bf16x8v af[2], bfr[2];
#pragma unroll
            for (int nb = 0; nb < 2; ++nb) af[nb] = tr_pair(lds + SD_B + l0 * SD_BS + (32 * (2 * half + nb) + 16 * gi + 4 * pp) * 2, 4 * SD_BS);
#pragma unroll
            for (int pb = 0; pb < 2; ++pb) bfr[pb] = tr_pair(lds + SD_X + l0 * SD_XS + (64 * hl + 32 * pb + 16 * gi + 4 * pp) * 2, 4 * SD_XS);
#pragma unroll
            for (int nb = 0; nb < 2; ++nb)
#pragma unroll
                for (int pb = 0; pb < 2; ++pb) acc[nb][pb] = MFMA32(bfr[pb], af[nb], acc[nb][pb]);
        }
        bf16* dst = CS + ((((size_t)b * NCH + c) * 8 + 4 * g + hl) * 64) * 128;
#pragma unroll
        for (int nb = 0; nb < 2; ++nb)
#pragma unroll
            for (int pb = 0; pb < 2; ++pb)
#pragma unroll
                for (int i = 0; i < 16; ++i) { const int p = 32 * pb + (i & 3) + 8 * (i >> 2) + 4 * hh; dst[p * 128 + 32 * (2 * half + nb) + l32] = (bf16)f2bf(acc[nb][pb][i]); }
    }
}

__device__ __forceinline__ void phase_ssd_s2(const Args& a) {
    const bf16* CS = (const bf16*)(a.ws + WS_CS); const float* CD = (const float*)(a.ws + WS_CD);
    for (int gid = blockIdx.x * NTHR + threadIdx.x; gid < 64 * 2048; gid += gridDim.x * NTHR) {
        int bh = gid >> 11, e4 = gid & 2047;
        if (gridDim.x == 256) { const int blk = gid >> 9, grp = blk & 7, j = blk >> 3; bh = grp * 8 + (j >> 2); e4 = (j & 3) * 512 + (gid & 511); }
        const int b = bh >> 3, h = bh & 7;
        const v2u* p = (const v2u*)(CS + (((size_t)b * NCH) * 8 + h) * 8192) + e4;
        const float* cd = CD + (size_t)b * NCH * 8 + h;
        v2u* o = (v2u*)((bf16*)(a.ws + WS_PB) + (((size_t)b * NCH) * 8 + h) * 8192) + e4;
        v4f st = {0.f, 0.f, 0.f, 0.f};
        for (int c0 = 0; c0 < NCH; c0 += 16) {
            v2u v[16]; float d[16];
#pragma unroll
            for (int j = 0; j < 16; ++j) { v[j] = p[(size_t)(c0 + j) * 16384]; d[j] = cd[(c0 + j) * 8]; }
#pragma unroll
            for (int j = 0; j < 16; ++j) { v2u w2; w2.x = cvtpk(st.x, st.y); w2.y = cvtpk(st.z, st.w); wt8(o + (size_t)(c0 + j) * 16384, w2.x, w2.y);
                const v4f vv = {bflo(v[j].x), bfhi(v[j].x), bflo(v[j].y), bfhi(v[j].y)}; st = st * d[j] + vv; }
        }
    }
}

__device__ __forceinline__ void phase_ssd_s3(const Args& a, LAS unsigned char* lds) {
    const int tid = threadIdx.x, lane = tid & 63, w = __builtin_amdgcn_readfirstlane(tid >> 6), l32 = lane & 31, hh = lane >> 5;
    const int hl = w >> 1, half = w & 1;
    const int gi = (lane >> 4) & 1, q4 = (lane & 15) >> 2, pp = lane & 3;
    const bf16* PROJ = (const bf16*)(a.ws + WS_PROJ); bf16* YC = (bf16*)(a.ws + WS_H);
    for (int item = blockIdx.x; item < NB * NCH * 2; item += gridDim.x) {
        const int it2 = ssd_item(item), g = it2 & 1, c = (it2 >> 1) & (NCH - 1), b = it2 >> 6, h = 4 * g + hl;
        const size_t m0 = (size_t)b * SEQ + 64 * c;
        __syncthreads();
        bf16x8v pvf[8][2];
        { const bf16* pvb = (const bf16*)(a.ws + WS_PB) + ((((size_t)b * NCH + c) * 8 + h) * 64 + l32) * 128 + 8 * hh;
#pragma unroll
          for (int s = 0; s < 8; ++s) { pvf[s][0] = *(const bf16x8v*)(pvb + 16 * s); pvf[s][1] = *(const bf16x8v*)(pvb + 32 * 128 + 16 * s); } }
        ConvIn cin; v4u zr[4];
        {
            const int cp = tid & 255, th = tid >> 8;
            const int ccol = cp < 128 ? 256 * g + 2 * cp : (cp < 192 ? 512 + 128 * g + 2 * (cp - 128) : 768 + 128 * g + 2 * (cp - 192));
            ssd_conv_load(a, cin, b, c, th, ccol);
#pragma unroll
            for (int i = 0; i < 4; ++i) { const int id = tid + 512 * i, row = id >> 5, ck = id & 31; zr[i] = *(const v4u*)(PROJ + (m0 + row) * N1 + PZ + 256 * g + 8 * ck); }
            ssd_dt<false>(a, lds, b, c, g, ssd_dt_load(a, b, c, g));
            LAS unsigned char* cdst = cp < 128 ? lds + SD_X + 4 * cp : (cp < 192 ? lds + SD_B + 4 * (cp - 128) : lds + SD_C + 4 * (cp - 192));
            ssd_conv_compute<false>(a, cin, cdst, cp < 128 ? SD_XS : SD_BS, th, ccol, nullptr);
#pragma unroll
            for (int i = 0; i < 4; ++i) { const int id = tid + 512 * i, row = id >> 5, ck = id & 31; *(LAS v4u*)(lds + SD_Z + row * SD_ZS + 16 * ck) = zr[i]; }
        }
        __syncthreads();
        const int lcol = 32 * half + l32;
        bf16x8v cf[8];
        f32x16 yo[2], yd[2];
#pragma unroll
        for (int i = 0; i < 16; ++i) { yo[0][i] = 0.f; yo[1][i] = 0.f; yd[0][i] = 0.f; yd[1][i] = 0.f; }
#pragma unroll
        for (int s = 0; s < 8; ++s) {
            cf[s] = *(LAS const bf16x8v*)(lds + SD_C + lcol * SD_BS + (16 * s + 8 * hh) * 2);
            yo[0] = MFMA32(pvf[s][0], cf[s], yo[0]); yo[1] = MFMA32(pvf[s][1], cf[s], yo[1]);
        }
        const float acs_l = ((const LAS float*)(lds + SD_ACS))[hl * 64 + lcol];
#pragma unroll
        for (int sb = 0; sb < 2; ++sb) {
            if (sb <= half) {
                f32x16 cb;
#pragma unroll
                for (int i = 0; i < 16; ++i) cb[i] = 0.f;
#pragma unroll
                for (int s = 0; s < 8; ++s) { const bf16x8v bfrag = *(LAS const bf16x8v*)(lds + SD_B + (32 * sb + l32) * SD_BS + (16 * s + 8 * hh) * 2); cb = MFMA32(bfrag, cf[s], cb); }
                float mv[16];
#pragma unroll
                for (int gq = 0; gq < 4; ++gq) {
                    const v4f as4 = *(const LAS v4f*)(lds + SD_ACS + (hl * 64 + 32 * sb + 8 * gq + 4 * hh) * 4), dt4 = *(const LAS v4f*)(lds + SD_DT + (hl * 64 + 32 * sb + 8 * gq + 4 * hh) * 4);
#pragma unroll
                    for (int j = 0; j < 4; ++j) { const int srow = 32 * sb + 8 * gq + 4 * hh + j;
                        const float dec = __expf(fminf(acs_l - as4[j], 0.f)) * dt4[j];
                        mv[4 * gq + j] = (srow <= lcol) ? cb[4 * gq + j] * dec : 0.f; }
                }
#pragma unroll
                for (int k2 = 0; k2 < 2; ++k2) {
                    v4u pk; pk.x = cvtpk(mv[8 * k2], mv[8 * k2 + 1]); pk.y = cvtpk(mv[8 * k2 + 2], mv[8 * k2 + 3]); pk.z = cvtpk(mv[8 * k2 + 4], mv[8 * k2 + 5]); pk.w = cvtpk(mv[8 * k2 + 6], mv[8 * k2 + 7]);
                    const bf16x8v mf = __builtin_bit_cast(bf16x8v, pk);
#pragma unroll
                    for (int pb = 0; pb < 2; ++pb) {
                        const bf16x8v xf = tr_pair(lds + SD_X + (32 * sb + 16 * k2 + 4 * hh + q4) * SD_XS + (64 * hl + 32 * pb + 16 * gi + 4 * pp) * 2, 8 * SD_XS);
                        yd[pb] = MFMA32(xf, mf, yd[pb]);
                    }
                }
            }
        }
        const float eal = __expf(acs_l), dsk = a.d_skip[h];
        float y[2][16]; float ss = 0.f;
#pragma unroll
        for (int pb = 0; pb < 2; ++pb)
#pragma unroll
            for (int gq = 0; gq < 4; ++gq) {
                const int ch = 64 * hl + 32 * pb + 8 * gq + 4 * hh;
                const v2u xv = *(const LAS v2u*)(lds + SD_X + lcol * SD_XS + ch * 2), zv = *(const LAS v2u*)(lds + SD_Z + lcol * SD_ZS + ch * 2);
                const float xs[4] = {bflo(xv.x), bfhi(xv.x), bflo(xv.y), bfhi(xv.y)}, zs[4] = {bflo(zv.x), bfhi(zv.x), bflo(zv.y), bfhi(zv.y)};
#pragma unroll
                for (int j = 0; j < 4; ++j) { float t = yd[pb][4 * gq + j] + yo[pb][4 * gq + j] * eal + dsk * xs[j]; t *= silu_fast(zs[j]); y[pb][4 * gq + j] = t; ss += t * t; }
            }
        ss += __shfl_xor(ss, 32);
        if (hh == 0) ((LAS float*)(lds + SD_WB))[hl * 64 + lcol] = ss;
        __syncthreads();
        const LAS float* sred = (const LAS float*)(lds + SD_WB);
        const float tot = (sred[lcol] + sred[64 + lcol]) + (sred[128 + lcol] + sred[192 + lcol]);
        const float rstd = rsqrtf(tot * (1.f / 256.f) + EPS);
        bf16* yp = YC + (m0 + lcol) * 1024 + 256 * g + 64 * hl + 4 * hh;
        const float* gp = a.ssd_norm_gain + 256 * g + 64 * hl + 4 * hh;
#pragma unroll
        for (int pb = 0; pb < 2; ++pb)
#pragma unroll
            for (int gq = 0; gq < 4; ++gq) {
                const v4f gn = *(const v4f*)(gp + 32 * pb + 8 * gq);
                v2u o; o.x = pk2(y[pb][4 * gq] * rstd * gn.x, y[pb][4 * gq + 1] * rstd * gn.y); o.y = pk2(y[pb][4 * gq + 2] * rstd * gn.z, y[pb][4 * gq + 3] * rstd * gn.w);
                *(v2u*)(yp + 32 * pb + 8 * gq) = o;
            }
    }
}

__device__ __forceinline__ void phase_norm1(const Args& a) {
    const int lane = threadIdx.x & 63, wave = threadIdx.x >> 6, gw = blockIdx.x * NWAVES + wave, NGW = gridDim.x * NWAVES;
    const bf16* MIX = (const bf16*)(a.ws + WS_PROJ); bf16* H = (bf16*)(a.ws + WS_H);
    v4f g1[4], g2[4];
#pragma unroll
    for (int j = 0; j < 4; ++j) { g1[j] = ((const v4f*)a.post_mix_gain)[lane + 64 * j]; g2[j] = ((const v4f*)a.pre_ffn_gain)[lane + 64 * j]; }
    v2u mv[4], mvn[4]; v4f xv[4], xvn[4];
    if (gw < M) {
#pragma unroll
        for (int j = 0; j < 4; ++j) { mv[j] = ((const v2u*)(MIX + (size_t)gw * DM))[lane + 64 * j]; xv[j] = ((const v4f*)(a.x + (size_t)gw * DM))[lane + 64 * j]; }
    }
    for (int m = gw; m < M; m += NGW) {
        const int mn = m + NGW;
        if (mn < M) {
#pragma unroll
            for (int j = 0; j < 4; ++j) { mvn[j] = ((const v2u*)(MIX + (size_t)mn * DM))[lane + 64 * j]; xvn[j] = ((const v4f*)(a.x + (size_t)mn * DM))[lane + 64 * j]; }
        }
        v4f* orow = (v4f*)(a.out + (size_t)m * DM) + lane;
        v4f v[4]; float s = 0.f;
#pragma unroll
        for (int j = 0; j < 4; ++j) { v[j] = (v4f){bflo(mv[j].x), bfhi(mv[j].x), bflo(mv[j].y), bfhi(mv[j].y)}; s += (v[j].x * v[j].x + v[j].y * v[j].y) + (v[j].z * v[j].z + v[j].w * v[j].w); }
        const float rstd = rsqrtf(wave_sum(s) * (1.f / DM) + EPS);
        float s2 = 0.f;
#pragma unroll
        for (int j = 0; j < 4; ++j) { xv[j] = xv[j] + v[j] * rstd * g1[j]; orow[64 * j] = xv[j];
            s2 += (xv[j].x * xv[j].x + xv[j].y * xv[j].y) + (xv[j].z * xv[j].z + xv[j].w * xv[j].w); }
        const float rstd2 = rsqrtf(wave_sum(s2) * (1.f / DM) + EPS);
        unsigned long long* o8 = (unsigned long long*)(H + (size_t)m * DM) + lane;
#pragma unroll
        for (int j = 0; j < 4; ++j) { const v4f hv = xv[j] * rstd2 * g2[j];
            o8[64 * j] = (unsigned long long)pk2(hv.x, hv.y) | ((unsigned long long)pk2(hv.z, hv.w) << 32); }
#pragma unroll
        for (int j = 0; j < 4; ++j) { mv[j] = mvn[j]; xv[j] = xvn[j]; }
    }
}
__device__ __forceinline__ void phase_norm2(const Args& a) {
    const int lane = threadIdx.x & 63, wave = threadIdx.x >> 6, gw = blockIdx.x * NWAVES + wave, NGW = gridDim.x * NWAVES;
    const bf16* F = (const bf16*)(a.ws + WS_CS);
    v4f g1[4];
#pragma unroll
    for (int j = 0; j < 4; ++j) g1[j] = ((const v4f*)a.post_ffn_gain)[lane + 64 * j];
    v2u fv[4], fvn[4]; v4f xv[4], xvn[4];
    if (gw < M) {
#pragma unroll
        for (int j = 0; j < 4; ++j) { fv[j] = ((const v2u*)(F + (size_t)gw * DM))[lane + 64 * j]; xv[j] = ((const v4f*)(a.out + (size_t)gw * DM))[lane + 64 * j]; }
    }
    for (int m = gw; m < M; m += NGW) {
        const int mn = m + NGW;
        if (mn < M) {
#pragma unroll
            for (int j = 0; j < 4; ++j) { fvn[j] = ((const v2u*)(F + (size_t)mn * DM))[lane + 64 * j]; xvn[j] = ((const v4f*)(a.out + (size_t)mn * DM))[lane + 64 * j]; }
        }
        v4f* orow = (v4f*)(a.out + (size_t)m * DM) + lane;
        v4f v[4]; float s = 0.f;
#pragma unroll
        for (int j = 0; j < 4; ++j) { v[j] = (v4f){bflo(fv[j].x), bfhi(fv[j].x), bflo(fv[j].y), bfhi(fv[j].y)}; s += (v[j].x * v[j].x + v[j].y * v[j].y) + (v[j].z * v[j].z + v[j].w * v[j].w); }
        const float rstd = rsqrtf(wave_sum(s) * (1.f / DM) + EPS);
#pragma unroll
        for (int j = 0; j < 4; ++j) orow[64 * j] = xv[j] + v[j] * rstd * g1[j];
#pragma unroll
        for (int j = 0; j < 4; ++j) { fv[j] = fvn[j]; xv[j] = xvn[j]; }
    }
}

#define XB_TMO      128
#define XB_XCNT(j)  (256  + 64 * (j))
#define XB_XSUB(j)  (1280 + 64 * (j))
#define XB_XGEN(j)  (2304 + 64 * (j))
#define XB_TOP      3328
#define XB_TOPGEN   3392
#define XCD_BAR_WORDS 3456
#define XB_SPIN_CAP (1u << 18)

__device__ __forceinline__ unsigned xb_ld(unsigned* p)              { return __hip_atomic_load(p, __ATOMIC_RELAXED, __HIP_MEMORY_SCOPE_AGENT); }
__device__ __forceinline__ unsigned xb_add(unsigned* p, unsigned v) { return __hip_atomic_fetch_add(p, v, __ATOMIC_RELAXED, __HIP_MEMORY_SCOPE_AGENT); }
__device__ __forceinline__ unsigned xb_xcc_id() { return (unsigned)__builtin_amdgcn_s_getreg((3 << 11) | 20) & 0xFu; }
#define XB_SPIN(cond, bar) do { unsigned _sp = 0; while (cond) { __builtin_amdgcn_s_sleep(1); \
    if ((++_sp & 255u) == 0u) { if (xb_ld(&(bar)[XB_TMO])) break; if (_sp > XB_SPIN_CAP) { atomicAdd(&(bar)[XB_TMO], 1u); break; } } } } while (0)

struct XcdBarrier {
    unsigned* bar; unsigned x;
    volatile LAS unsigned* st;
};

__device__ __forceinline__ XcdBarrier xcd_barrier_post(unsigned* bar, volatile LAS unsigned* st) {
    XcdBarrier b; b.bar = bar; b.x = xb_xcc_id(); b.st = st;
    if (threadIdx.x == 0) (void)xb_add(&bar[XB_XCNT(b.x)], 1u);
    return b;
}
__device__ __forceinline__ void xcd_barrier_complete(unsigned* bar, unsigned x, unsigned& nloc, unsigned& nx) {
    const unsigned G = gridDim.x * gridDim.y * gridDim.z;
    unsigned sum, cnt, mine, sp = 0u;
    for (;;) {
        sum = 0u; cnt = 0u; mine = 0u;
#pragma unroll
        for (unsigned j = 0; j < 16; ++j) { const unsigned c = xb_ld(&bar[XB_XCNT(j)]); sum += c; cnt += (c > 0u) ? 1u : 0u; mine = (j == x) ? c : mine; }
        if (sum == G) break;
        __builtin_amdgcn_s_sleep(1);
        if ((++sp & 255u) == 0u) { if (xb_ld(&bar[XB_TMO])) break; if (sp > XB_SPIN_CAP) { atomicAdd(&bar[XB_TMO], 1u); break; } }
    }
    nloc = mine > 0u ? mine : 1u; nx = cnt > 0u ? cnt : 1u;
}

__device__ __forceinline__ void xcd_barrier(const XcdBarrier& b) {
    asm volatile("s_waitcnt vmcnt(0)" ::: "memory");
    __syncthreads();
    if (threadIdx.x == 0) {
        unsigned* bar = b.bar;
        __builtin_amdgcn_s_waitcnt(0);
        unsigned nloc = b.st[0], nx = b.st[1];
        if (nloc == 0u) { xcd_barrier_complete(bar, b.x, nloc, nx); b.st[0] = nloc; b.st[1] = nx; }
        const unsigned old = xb_add(&bar[XB_XSUB(b.x)], 1u);
        const unsigned gen = old / nloc;
        if (old + 1u == (gen + 1u) * nloc) {
            __builtin_amdgcn_fence(__ATOMIC_RELEASE, "agent");
            asm volatile("s_waitcnt vmcnt(0)" ::: "memory");
            const unsigned og = xb_add(&bar[XB_TOP], 1u);
            const unsigned tg = og / nx;
            if (og + 1u == (tg + 1u) * nx) xb_add(&bar[XB_TOPGEN], 1u);
            else XB_SPIN(xb_ld(&bar[XB_TOPGEN]) == tg, bar);
            __builtin_amdgcn_fence(__ATOMIC_ACQUIRE, "agent");
            xb_add(&bar[XB_XGEN(b.x)], 1u);
            asm volatile("s_waitcnt vmcnt(0)" ::: "memory");
        } else {
            XB_SPIN(xb_ld(&bar[XB_XGEN(b.x)]) == gen, bar);
            __builtin_amdgcn_fence(__ATOMIC_ACQUIRE, "agent");
            asm volatile("s_waitcnt vmcnt(0)" ::: "memory");
        }
    }
    __syncthreads();
}


__device__ __forceinline__ int ssd_item(int item) {
    if (gridDim.x != 256) return item;
    const int blk = item & 255, k = item >> 8, grp = blk & 7, j = blk >> 3;
    return (grp << 6) | (j + 32 * k);
}
#define XL_SUB(g) (3472 + 16 * (g))
#define XL_GEN(g) (3600 + 16 * (g))
#define XL_MASK(g) (3456 + (g))
__device__ __forceinline__ void local_barrier(unsigned* ctl, int g) {
    asm volatile("s_waitcnt vmcnt(0)" ::: "memory");
    __syncthreads();
    if (threadIdx.x == 0) {
        const unsigned old = xb_add(&ctl[XL_SUB(g)], 1u), gen = old / 32u;
        if (old + 1u == (gen + 1u) * 32u) xb_add(&ctl[XL_GEN(g)], 1u);
        else { unsigned sp = 0u; while (xb_ld(&ctl[XL_GEN(g)]) == gen) { __builtin_amdgcn_s_sleep(1); if (++sp > (1u << 22)) break; } }
        __builtin_amdgcn_fence(__ATOMIC_ACQUIRE, "agent");
        asm volatile("s_waitcnt vmcnt(0)" ::: "memory");
    }
    __syncthreads();
}
constexpr int NPHASE = 10;
__global__ void __launch_bounds__(NTHR, 2) fwd(Args a) {
    extern __shared__ __attribute__((aligned(16))) unsigned char lds_raw[];
    LAS unsigned char* lds = (LAS unsigned char*)lds_raw;
    const int lo = a.ph_lo, hi = a.ph_hi;
#ifndef REPMASK
#define REPMASK 0
#endif
#define REP(k) for (int _r = 0; _r < (((REPMASK) >> (k)) & 1) + 1; ++_r)
#define IN(k) (lo <= (k) && (k) < hi)
#define SEAM(k) do { if (IN(k) && IN((k) + 1)) xcd_barrier(bar); } while (0)
    unsigned char* ws = a.ws;
    volatile LAS unsigned* misc = (volatile LAS unsigned*)(lds + 131072);
    if (threadIdx.x < 2) misc[threadIdx.x] = 0u;
    __syncthreads();
    XcdBarrier bar = xcd_barrier_post((unsigned*)(ws + WS_CTL), misc);
    unsigned* ctlw = (unsigned*)(ws + WS_CTL);
    if (threadIdx.x == 0) __hip_atomic_fetch_or(&ctlw[XL_MASK(blockIdx.x & 7)], 1u << bar.x, __ATOMIC_RELAXED, __HIP_MEMORY_SCOPE_AGENT);
    if ((REPMASK) & 16384) { for (int i = 0; i < 10; ++i) xcd_barrier(bar); }
    const bool defer_w4 = (gridDim.x == 256) && lo == 0 && hi > 7;
    if (IN(0)) REP(0) { phase_p0(a, lds, defer_w4); __syncthreads(); }
    SEAM(0);
    bool colo = false;
    if ((gridDim.x == 256) && lo == 0 && hi > 5) {
        unsigned seen = 0u; colo = true;
#pragma unroll
        for (int g8 = 0; g8 < 8; ++g8) { const unsigned mk = xb_ld(&ctlw[XL_MASK(g8)]); colo = colo && mk != 0u && (mk & (mk - 1u)) == 0u && (seen & mk) == 0u; seen |= mk; }
        colo = __builtin_amdgcn_readfirstlane(colo ? 1 : 0) != 0;
    }
#define SEAM_L(k) do { if (IN(k) && IN((k) + 1)) { if (colo) local_barrier(ctlw, blockIdx.x & 7); else xcd_barrier(bar); } } while (0)
    if (IN(1)) REP(1) { pg8::Gemm g{(const bf16*)(ws + WS_H), (const bf16*)(ws + WS_W1), M, N1, DM}; pg8::StaticOrder S; S.init(M, N1, gridDim.x, blockIdx.x);
        pg8::EpiProj E{(bf16*)(ws + WS_PROJ)}; pg8::gemm_phase<pg8::EpiProj, pg8::StaticOrder, true, true>(lds, g, S, E); }
    SEAM_L(1);
    const bool att_first = colo && (blockIdx.x & 1) && IN(2) && IN(4);
    if (att_first) { phase_attn(a, lds); __syncthreads(); }
    if (IN(2)) REP(2) { phase_ssd_s1(a, lds); }
    SEAM_L(2);
    if (IN(3)) REP(3) { phase_ssd_s2(a); }
    SEAM_L(3);
    if (IN(4)) { REP(10) { phase_ssd_s3(a, lds); __syncthreads(); } if (!att_first) REP(11) { phase_attn(a, lds); __syncthreads(); } }
    SEAM_L(4);
    const bool fuse_n1 = (gridDim.x == 256) && lo <= 5 && hi > 7;
    if (IN(5)) { pg8::Gemm g{(const bf16*)(ws + WS_H), (const bf16*)(ws + WS_W2), M, DM, DM}; pg8::StaticOrder S; S.init(M, DM, gridDim.x, blockIdx.x);
        if (fuse_n1) {
            pg8::EpiRmsResRms E{a.x, (bf16*)(ws + WS_CS), (bf16*)(ws + WS_PB), a.post_mix_gain, a.pre_ffn_gain, (float*)(ws + WS_CTL + 65536 + 262144), (unsigned*)(ws + WS_CTL + 32768), (float*)(ws + WS_CTL + 65536 + 524288), (unsigned*)(ws + WS_CTL + 49152)};
            pg8::gemm_phase<pg8::EpiRmsResRms, pg8::StaticOrder, false, true>(lds, g, S, E);
        } else {
            pg8::EpiBf16 E{(bf16*)(ws + WS_PROJ), DM}; pg8::gemm_phase<pg8::EpiBf16, pg8::StaticOrder, true, true>(lds, g, S, E);
        }
    }
    if (!fuse_n1) {
    SEAM(5);
    if (IN(6)) REP(6) { phase_norm1(a); }
    }
    SEAM_L(6);
    if (IN(7)) REP(7) { pg8::Gemm g{(const bf16*)(ws + (fuse_n1 ? WS_PB : WS_H)), (const bf16*)(ws + WS_W3), M, N3, DM}; pg8::StaticOrder S; S.init(M, N3, gridDim.x, blockIdx.x);
        pg8::EpiSwiglu E{(bf16*)(ws + WS_PROJ)}; pg8::gemm_phase<pg8::EpiSwiglu, pg8::StaticOrder, true, true>(lds, g, S, E);
        if (defer_w4) { __syncthreads(); phase_w4(a, lds); } }
    SEAM(7);
    if (IN(8)) { pg8::Gemm g{(const bf16*)(ws + WS_PROJ), (const bf16*)(ws + WS_W4), M, DM, DFF, (size_t)1 << 20}; pg8::StaticOrder S; S.init(M, DM, gridDim.x, blockIdx.x);
        if (gridDim.x == 256 && hi > 9 && lo <= 5) {
            pg8::EpiRmsRes E{(const bf16*)(ws + WS_CS), a.out, a.post_ffn_gain, (float*)(ws + WS_CTL + 65536), (unsigned*)(ws + WS_CTL + 16384)};
            pg8::gemm_phase<pg8::EpiRmsRes, pg8::StaticOrder, false, true>(lds, g, S, E);
        } else {
            pg8::EpiBf16 E{(bf16*)(ws + WS_CS), DM}; pg8::gemm_phase<pg8::EpiBf16, pg8::StaticOrder, true, true>(lds, g, S, E);
            SEAM(8);
            if (IN(9)) { phase_norm2(a); }
        }
    }
#undef IN
#undef SEAM
}

#ifndef N_LAUNCHES
#define N_LAUNCHES 1
#endif
extern "C" void kernel_launch(void* const* d_in, const int* in_sizes, int n_in, void* d_out, int out_size, void* d_ws, size_t ws_size, hipStream_t stream) {
    static int grid = 0;
    if (grid == 0) {
        if (n_in != 17 || out_size != M * DM || ws_size < WS_END) { fprintf(stderr, "kernel_launch: unexpected problem (n_in %d out %d ws %zu)\n", n_in, out_size, ws_size); grid = -1; return; }
        int dev = 0, cus = 0, per_cu = 0;
        hipGetDevice(&dev); hipDeviceGetAttribute(&cus, hipDeviceAttributeMultiprocessorCount, dev);
        if (hipFuncSetAttribute((const void*)fwd, hipFuncAttributeMaxDynamicSharedMemorySize, LDS_BYTES) != hipSuccess) { fprintf(stderr, "kernel_launch: hipFuncSetAttribute failed\n"); grid = -1; return; }
        if (hipOccupancyMaxActiveBlocksPerMultiprocessor(&per_cu, (const void*)fwd, NTHR, LDS_BYTES) != hipSuccess || per_cu < 1) { fprintf(stderr, "kernel_launch: occupancy query says %d blocks per CU\n", per_cu); per_cu = 1; }
        (void)hipGetLastError();
        grid = cus;
    }
    if (grid < 0) return;
    if (hipMemsetAsync((char*)d_ws + WS_CTL, 0, 65536, stream) != hipSuccess) { fprintf(stderr, "kernel_launch: memset failed\n"); return; }
    Args a{};
    const float** ap = (const float**)&a;
    for (int i = 0; i < 17; ++i) ap[i] = (const float*)d_in[i];
    a.out = (float*)d_out; a.ws = (unsigned char*)d_ws;
#if N_LAUNCHES == 1
    a.ph_lo = 0; a.ph_hi = NPHASE;
    void* args[] = {&a};
    hipError_t e = hipLaunchCooperativeKernel((const void*)fwd, dim3(grid), dim3(NTHR), args, LDS_BYTES, stream);
    if (e != hipSuccess) fprintf(stderr, "cooperative launch failed: %s (grid %d)\n", hipGetErrorString(e), grid);
#else
    for (int ph = 0; ph < NPHASE; ++ph) { a.ph_lo = ph; a.ph_hi = ph + 1; hipLaunchKernelGGL(fwd, dim3(grid), dim3(NTHR), LDS_BYTES, stream, a); }
#endif
}
```

```cpp
#define REPMASK 0
#include <hip/hip_runtime.h>
#include <hip/hip_cooperative_groups.h>
#include <cstdio>
#include <cstdint>
namespace cg = cooperative_groups;
#ifndef REPMASK
#define REPMASK 0
#endif

constexpr int NB = 8, SEQ = 2048, DM = 1024, M = NB * SEQ;
constexpr int DIN = 3080;
constexpr int N1 = 3072;
constexpr int PZ = 0, PX = 512, PQ = 1536, PK = 2048, PV = 2560;
constexpr int DFF = 2816, N3 = 2 * DFF;
constexpr int NH = 8, HD = 64, NST = 128, CH = 64, NCH = SEQ / CH;
constexpr float EPS = 1e-6f;
constexpr float LOG2E = 1.4426950408889634f;
constexpr float QSCALE = 0.125f * LOG2E;

constexpr size_t MiB = 1u << 20;
constexpr size_t WS_W1 = 0, WS_W2 = 6 * MiB, WS_W3 = 8 * MiB, WS_W4 = 19 * MiB;
constexpr size_t WS_DT = 25 * MiB;
constexpr size_t WS_CD = 25 * MiB + 512 * 1024;
constexpr size_t WS_H = 26 * MiB;
constexpr size_t WS_PROJ = 58 * MiB;
constexpr size_t WS_CS = 154 * MiB;
constexpr size_t WS_CTL = 218 * MiB;
constexpr size_t WS_PB = 219 * MiB;
constexpr size_t WS_END = 251 * MiB;

constexpr int LDS_BYTES = 147456;
constexpr int NTHR = 512, NWAVES = 8;

#define LAS __attribute__((address_space(3)))
typedef unsigned short bf16;
typedef unsigned v4u __attribute__((ext_vector_type(4)));
typedef unsigned v2u __attribute__((ext_vector_type(2)));
typedef float v4f __attribute__((ext_vector_type(4)));
typedef float f32x16 __attribute__((ext_vector_type(16)));

__device__ __forceinline__ unsigned f2bf(float f) { unsigned u = __builtin_bit_cast(unsigned, f); return (u + 0x7fffu + ((u >> 16) & 1u)) >> 16; }
typedef float f32x2_t __attribute__((ext_vector_type(2)));
typedef __bf16 bf16x2_t __attribute__((ext_vector_type(2)));
__device__ __forceinline__ unsigned cvtpk(float lo, float hi) { f32x2_t v = {lo, hi}; bf16x2_t b = __builtin_convertvector(v, bf16x2_t); return __builtin_bit_cast(unsigned, b); }
__device__ __forceinline__ unsigned pk2(float lo, float hi) { return cvtpk(lo, hi); }
__device__ __forceinline__ void wt8(void* p, unsigned lo, unsigned hi) { __hip_atomic_store((unsigned long long*)p, (unsigned long long)lo | ((unsigned long long)hi << 32), __ATOMIC_RELAXED, __HIP_MEMORY_SCOPE_AGENT); }
__device__ __forceinline__ __amdgpu_buffer_rsrc_t wt_rsrc(void* base, unsigned bytes) { return __builtin_amdgcn_make_buffer_rsrc(base, 0, (int)bytes, 0x00020000); }
__device__ __forceinline__ void wt16(__amdgpu_buffer_rsrc_t r, unsigned byte_off, v4u v) { __builtin_amdgcn_raw_buffer_store_b128(v, r, (int)byte_off, 0, 16); }
__device__ __forceinline__ float bf2f(unsigned b) { return __builtin_bit_cast(float, b << 16); }
__device__ __forceinline__ float bflo(unsigned w) { return __builtin_bit_cast(float, w << 16); }
__device__ __forceinline__ float bfhi(unsigned w) { return __builtin_bit_cast(float, w & 0xffff0000u); }
__device__ __forceinline__ float wave_sum(float v) {
#pragma unroll
    for (int o = 1; o < 64; o <<= 1) v += __shfl_xor(v, o);
    return v;
}
__device__ __forceinline__ float siluf(float v) { return v / (1.f + __expf(-v)); }
__device__ __forceinline__ float silu_fast(float v) { return v * __builtin_amdgcn_rcpf(1.f + __builtin_amdgcn_exp2f(-LOG2E * v)); }
__device__ __forceinline__ float softplusf(float v) { return fmaxf(v, 0.f) + log1pf(__expf(-fabsf(v))); }

namespace pg8 {
#define PG8_LAS __attribute__((address_space(3)))
typedef unsigned short bf16_t;
typedef short bf16x8 __attribute__((ext_vector_type(8)));
typedef float f32x4 __attribute__((ext_vector_type(4)));
typedef unsigned u32x4 __attribute__((ext_vector_type(4)));
constexpr int BM = 256, BK = 64, HALF = 128, HTB = HALF * BK * 2  , STAGE_BYTES = 8 * HTB, NXCD = 8, WGM = 8;

__host__ __device__ __forceinline__ int lds_byte(int r, int c) { const int st = (r >> 4) * 2 + (c >> 5), rr = r & 15, cc = c & 31, ob = rr * 64 + cc * 2; return st * 1024 + (ob ^ (((ob >> 9) & 1) << 5)); }
__host__ __device__ __forceinline__ void stage_rc(int b, int& R, int& C) { const int st = b / 1024, sb = b % 1024, swz = sb ^ (((sb >> 9) & 1) << 5); R = (st >> 1) * 16 + swz / 64; C = (st & 1) * 32 + (swz % 64) / 2; }
__host__ __device__ __forceinline__ int perm32(int rho) { const int n = rho >> 4, i = rho & 15; return 8 * (i >> 2) + 4 * n + (i & 3); }

struct Unit { int pm, pn; };
struct Gemm { const bf16_t* A; const bf16_t* Bt; int M, N, K; size_t agap; };

struct StaticOrder {
    int nM, nN, nwg, G, c;
    __host__ __device__ void init(int M, int N, int G_, int c_) { nM = M / BM; nN = N / BM; nwg = nM * nN; G = G_; c = c_; }
    __host__ __device__ bool next(int i, Unit& u) const {
        const long L = (long)i * G + c; if (L >= nwg) return false;
        int wgid = (int)L; { const int q = nwg / NXCD, r = nwg % NXCD, xcd = wgid % NXCD, off = wgid / NXCD; wgid = (xcd < r ? xcd * (q + 1) : r * (q + 1) + (xcd - r) * q) + off; }
        const int nig = WGM * nN, gid = wgid / nig, fm = gid * WGM, gsz = (nM - fm) < WGM ? (nM - fm) : WGM;
        u.pm = fm + ((wgid % nig) % gsz); u.pn = (wgid % nig) / gsz; return true;
    }
    __device__ __forceinline__ void a_ready(const Unit&) const {}
    __device__ __forceinline__ void done(const Unit&) const {}
};

__device__ __forceinline__ unsigned cvt_pk_bf16(float lo, float hi) { unsigned r; asm volatile("v_cvt_pk_bf16_f32 %0, %1, %2" : "=v"(r) : "v"(lo), "v"(hi)); return r; }
template <class Epi, class Sched, bool ALIGN_EPI = false, bool SP2 = false>
__device__ __forceinline__ void gemm_phase(PG8_LAS unsigned char* lds, const Gemm g, const Sched& S, const Epi& E) {
    const int tid = threadIdx.x, wid = __builtin_amdgcn_readfirstlane(tid >> 6), lane = tid & 63, wr = wid >> 2, wc = wid & 3, fr = lane & 15, fq = lane >> 4;
    const int K = g.K, nt = K / BK;
    unsigned voffA[2], voffB[2];
#pragma unroll
    for (int i = 0; i < 2; ++i) { int R, C; stage_rc(tid * 16 + i * 8192, R, C); const int Rb = Epi::PERM ? ((R & ~31) + perm32(R & 31)) : R;
        voffA[i] = (unsigned)(R * K + C) * 2u; voffB[i] = (unsigned)(Rb * K + C) * 2u; }
    const size_t kstep = (size_t)(BK * 2);
    const size_t hstep = (size_t)HALF * K * 2;
    const size_t tstep = 2 * hstep;
    const unsigned ldsw = (unsigned)wid * 1024u;
    const int aoff = lds_byte(wr * 64 + fr, fq * 8), boff = lds_byte(wc * 32 + fr, fq * 8);
#define PG8_SA(b, h) (((b) * 2 + (h)) * HTB)
#define PG8_SB(b, h) ((4 + (b) * 2 + (h)) * HTB)
#define PG8_STAGE(bufoff, gbase, voff) do { _Pragma("unroll") for (int _i = 0; _i < 2; ++_i) \
        __builtin_amdgcn_global_load_lds((const unsigned*)((const char*)(gbase) + (voff)[_i]), (PG8_LAS unsigned*)(lds + (bufoff) + ldsw + _i * 8192), 16, 0, 0); } while (0)
#define PG8_LDA(dst, b, h) do { _Pragma("unroll") for (int m = 0; m < 4; ++m) _Pragma("unroll") for (int k = 0; k < 2; ++k) dst[m][k] = *(const PG8_LAS bf16x8*)(lds + PG8_SA(b, h) + aoff + m * 2048 + k * 1024); } while (0)
#define PG8_LDB(dst, b, h) do { _Pragma("unroll") for (int n = 0; n < 2; ++n) _Pragma("unroll") for (int k = 0; k < 2; ++k) dst[n][k] = *(const PG8_LAS bf16x8*)(lds + PG8_SB(b, h) + boff + n * 2048 + k * 1024); } while (0)
#define PG8_MMA(ai, bj, At, Bt) do { __builtin_amdgcn_s_setprio(1); _Pragma("unroll") for (int m = 0; m < 4; ++m) _Pragma("unroll") for (int n = 0; n < 2; ++n) _Pragma("unroll") for (int k = 0; k < 2; ++k) \
        acc[ai][bj][m][n] = __builtin_amdgcn_mfma_f32_16x16x32_bf16(Bt[n][k], At[m][k], acc[ai][bj][m][n], 0, 0, 0); __builtin_amdgcn_s_setprio(0); } while (0)
#define PG8_WAIT_V(n) asm volatile("s_waitcnt vmcnt(" #n ")" ::: "memory")
#define PG8_WAIT_L(n) asm volatile("s_waitcnt lgkmcnt(" #n ")" ::: "memory")
#define PG8_BAR __builtin_amdgcn_s_barrier()
#define PG8_SCHED __builtin_amdgcn_sched_barrier(0)
    Unit cur, nxt; int ui = 0;
    if (!S.next(0, cur)) return;
    f32x4 acc[2][2][4][2];
#pragma unroll
    for (int a = 0; a < 2; ++a)
#pragma unroll
        for (int b = 0; b < 2; ++b)
#pragma unroll
            for (int m = 0; m < 4; ++m)
#pragma unroll
                for (int n = 0; n < 2; ++n) acc[a][b][m][n] = (f32x4){0.f, 0.f, 0.f, 0.f};
    bf16x8 At[4][2], B0[2][2], B1[2][2];
    const char* cA = (const char*)g.A + (size_t)cur.pm * tstep + (size_t)(cur.pm >> 3) * g.agap; const char* cB = (const char*)g.Bt + (size_t)cur.pn * tstep;
    S.a_ready(cur);
    if constexpr (SP2) {
        PG8_STAGE(PG8_SB(0, 0), cB, voffB); PG8_STAGE(PG8_SB(0, 1), cB + hstep, voffB); PG8_STAGE(PG8_SA(0, 0), cA, voffA); PG8_STAGE(PG8_SA(0, 1), cA + hstep, voffA);
        if (wr == 1) PG8_BAR;
        PG8_WAIT_V(2); PG8_BAR;
        PG8_STAGE(PG8_SB(1, 0), cB + kstep, voffB); PG8_STAGE(PG8_SA(1, 0), cA + kstep, voffA); PG8_STAGE(PG8_SB(1, 1), cB + hstep + kstep, voffB);
        PG8_WAIT_V(6); PG8_BAR;
    } else {
        PG8_STAGE(PG8_SB(0, 0), cB, voffB); PG8_STAGE(PG8_SA(0, 0), cA, voffA); PG8_STAGE(PG8_SB(0, 1), cB + hstep, voffB); PG8_STAGE(PG8_SA(0, 1), cA + hstep, voffA);
        if (wr == 1) PG8_BAR;
        PG8_WAIT_V(4); PG8_BAR;
        PG8_STAGE(PG8_SB(1, 0), cB + kstep, voffB); PG8_STAGE(PG8_SA(1, 0), cA + kstep, voffA); PG8_STAGE(PG8_SB(1, 1), cB + hstep + kstep, voffB);
        PG8_WAIT_V(6); PG8_BAR;
    }
    for (;;) {
        const bool has_next = S.next(ui + 1, nxt);
        const char* nA = has_next ? (const char*)g.A + (size_t)nxt.pm * tstep + (size_t)(nxt.pm >> 3) * g.agap : cA; const char* nB = has_next ? (const char*)g.Bt + (size_t)nxt.pn * tstep : cB;
        for (int t = 0; t < nt; t += 2) {
            const bool last = (t == nt - 2);
            const char* a1 = cA + (size_t)(t + 1) * kstep;
            const char* a2 = last ? nA : cA + (size_t)(t + 2) * kstep; const char* b2 = last ? nB : cB + (size_t)(t + 2) * kstep;
            const char* a3 = a2 + kstep; const char* b3 = b2 + kstep;
            if (last && has_next) S.a_ready(nxt);
            if constexpr (SP2) {
            PG8_LDB(B0, 0, 0); PG8_LDB(B1, 0, 1); PG8_SCHED; PG8_LDA(At, 0, 0); PG8_STAGE(PG8_SA(1, 1), a1 + hstep, voffA);
            PG8_WAIT_V(8); PG8_WAIT_L(0); PG8_BAR; PG8_MMA(0, 0, At, B0); PG8_MMA(0, 1, At, B1); PG8_BAR; PG8_SCHED;
            PG8_LDA(At, 0, 1); PG8_STAGE(PG8_SB(0, 0), b2, voffB); PG8_STAGE(PG8_SB(0, 1), b2 + hstep, voffB); PG8_STAGE(PG8_SA(0, 0), a2, voffA);
            PG8_WAIT_V(8); PG8_WAIT_L(0); PG8_BAR; PG8_MMA(1, 0, At, B0); PG8_MMA(1, 1, At, B1); PG8_BAR; PG8_SCHED;
            PG8_LDB(B0, 1, 0); PG8_LDB(B1, 1, 1); PG8_SCHED; PG8_LDA(At, 1, 0); PG8_STAGE(PG8_SA(0, 1), a2 + hstep, voffA);
            PG8_WAIT_V(8); PG8_WAIT_L(0); PG8_BAR; PG8_MMA(0, 0, At, B0); PG8_MMA(0, 1, At, B1); PG8_BAR; PG8_SCHED;
            PG8_LDA(At, 1, 1); PG8_STAGE(PG8_SB(1, 0), b3, voffB); PG8_STAGE(PG8_SB(1, 1), b3 + hstep, voffB); PG8_STAGE(PG8_SA(1, 0), a3, voffA);
            PG8_WAIT_V(8); PG8_WAIT_L(0); PG8_BAR; PG8_MMA(1, 0, At, B0); PG8_MMA(1, 1, At, B1); PG8_BAR; PG8_SCHED;
            } else {
            PG8_LDB(B0, 0, 0); PG8_SCHED; PG8_LDA(At, 0, 0); PG8_STAGE(PG8_SA(1, 1), a1 + hstep, voffA);
            PG8_WAIT_L(8); PG8_BAR; PG8_WAIT_L(0); PG8_MMA(0, 0, At, B0); PG8_BAR; PG8_SCHED;
            PG8_LDB(B1, 0, 1); PG8_STAGE(PG8_SB(0, 0), b2, voffB);
            PG8_BAR; PG8_WAIT_L(0); PG8_MMA(0, 1, At, B1); PG8_BAR;
            PG8_LDA(At, 0, 1); PG8_STAGE(PG8_SA(0, 0), a2, voffA);
            PG8_BAR; PG8_WAIT_L(0); PG8_MMA(1, 0, At, B0); PG8_BAR; PG8_SCHED;
            PG8_STAGE(PG8_SB(0, 1), b2 + hstep, voffB);
            PG8_WAIT_V(6); PG8_BAR; PG8_MMA(1, 1, At, B1); PG8_BAR;
            PG8_LDB(B0, 1, 0); PG8_SCHED; PG8_LDA(At, 1, 0); PG8_STAGE(PG8_SA(0, 1), a2 + hstep, voffA);
            PG8_WAIT_L(8); PG8_BAR; PG8_WAIT_L(0); PG8_MMA(0, 0, At, B0); PG8_BAR; PG8_SCHED;
            PG8_LDB(B1, 1, 1); PG8_STAGE(PG8_SB(1, 0), b3, voffB);
            PG8_BAR; PG8_WAIT_L(0); PG8_MMA(0, 1, At, B1); PG8_BAR;
            PG8_LDA(At, 1, 1); PG8_STAGE(PG8_SA(1, 0), a3, voffA);
            PG8_BAR; PG8_WAIT_L(0); PG8_MMA(1, 0, At, B0); PG8_BAR; PG8_SCHED;
            PG8_STAGE(PG8_SB(1, 1), b3 + hstep, voffB);
            PG8_WAIT_V(6); PG8_BAR; PG8_MMA(1, 1, At, B1); PG8_BAR;
            }
        }
        if constexpr (ALIGN_EPI) { if (wr == 0) PG8_BAR; }
        if constexpr (!Epi::AFTER_DRAIN) { E(acc, cur, wr, wc, fr, fq); S.done(cur); }
        if (!has_next) break;
#pragma unroll
        for (int a = 0; a < 2; ++a)
#pragma unroll
            for (int b = 0; b < 2; ++b)
#pragma unroll
                for (int m = 0; m < 4; ++m)
#pragma unroll
                    for (int n = 0; n < 2; ++n) acc[a][b][m][n] = (f32x4){0.f, 0.f, 0.f, 0.f};
        cur = nxt; cA = nA; cB = nB; ++ui;
        if constexpr (ALIGN_EPI) { if (wr == 1) PG8_BAR; }
    }
    PG8_WAIT_V(0);
    if constexpr (!ALIGN_EPI) { if (wr == 0) PG8_BAR; }
    PG8_BAR;
    if constexpr (Epi::AFTER_DRAIN) { E.fused(acc, cur, wr, wc, fr, fq, lds, wid, lane); S.done(cur); }
#undef PG8_SA
#undef PG8_SB
#undef PG8_STAGE
#undef PG8_LDA
#undef PG8_LDB
#undef PG8_MMA
#undef PG8_WAIT_V
#undef PG8_WAIT_L
#undef PG8_BAR
#undef PG8_SCHED
}
}

namespace pg8 {
struct EpiProj {
    static constexpr bool PERM = true, AFTER_DRAIN = false;
    bf16_t* O;
    __device__ __forceinline__ void operator()(const f32x4 (&acc)[2][2][4][2], const Unit& u, int wr, int wc, int fr, int fq) const {
        const int row0 = u.pm * BM + wr * 64 + fr, col0 = u.pn * BM + wc * 32 + 8 * fq;
        const float sc = (u.pn == 6 || u.pn == 7) ? QSCALE : 1.f;
        const __amdgpu_buffer_rsrc_t rs = wt_rsrc(O, (unsigned)((size_t)16384 * N1 * 2));
#pragma unroll
        for (int ai = 0; ai < 2; ++ai)
#pragma unroll
            for (int m = 0; m < 4; ++m) { const unsigned rowb = (unsigned)(((size_t)(row0 + ai * HALF + m * 16) * N1 + col0) * 2);
#pragma unroll
                for (int bj = 0; bj < 2; ++bj) { const f32x4 v0 = acc[ai][bj][m][0] * sc, v1 = acc[ai][bj][m][1] * sc;
                    u32x4 w; w.x = cvt_pk_bf16(v0[0], v0[1]); w.y = cvt_pk_bf16(v0[2], v0[3]); w.z = cvt_pk_bf16(v1[0], v1[1]); w.w = cvt_pk_bf16(v1[2], v1[3]);
                    wt16(rs, rowb + bj * HALF * 2, w); } }
    }
};
struct EpiBf16 {
    static constexpr bool PERM = true, AFTER_DRAIN = false;
    bf16_t* O; int ldc;
    __device__ __forceinline__ void operator()(const f32x4 (&acc)[2][2][4][2], const Unit& u, int wr, int wc, int fr, int fq) const {
        const int row0 = u.pm * BM + wr * 64 + fr, col0 = u.pn * BM + wc * 32 + 8 * fq;
#pragma unroll
        for (int ai = 0; ai < 2; ++ai)
#pragma unroll
            for (int m = 0; m < 4; ++m) { bf16_t* rowp = O + (size_t)(row0 + ai * HALF + m * 16) * ldc + col0;
#pragma unroll
                for (int bj = 0; bj < 2; ++bj) { const f32x4 v0 = acc[ai][bj][m][0], v1 = acc[ai][bj][m][1];
                    u32x4 w; w.x = cvt_pk_bf16(v0[0], v0[1]); w.y = cvt_pk_bf16(v0[2], v0[3]); w.z = cvt_pk_bf16(v1[0], v1[1]); w.w = cvt_pk_bf16(v1[2], v1[3]);
                    *(u32x4*)(rowp + bj * HALF) = w; } }
    }
};
__device__ __forceinline__ void rms_exchange(const f32x4 (&v)[2][2][4][2], const Unit& u, int wr, int wc, int fr, int fq, PG8_LAS unsigned char* lds, int wid, int lane, float* xbuf, unsigned* cnt) {
    PG8_LAS float* P = (PG8_LAS float*)lds;
    PG8_LAS float* S = (PG8_LAS float*)(lds + 4096);
#pragma unroll
    for (int ai = 0; ai < 2; ++ai)
#pragma unroll
        for (int m = 0; m < 4; ++m) {
            float s = 0.f;
#pragma unroll
            for (int bj = 0; bj < 2; ++bj)
#pragma unroll
                for (int n = 0; n < 2; ++n) { const f32x4 x = v[ai][bj][m][n]; s += (x[0] * x[0] + x[1] * x[1]) + (x[2] * x[2] + x[3] * x[3]); }
            s += __shfl_xor(s, 16); s += __shfl_xor(s, 32);
            if (fq == 0) P[(ai * HALF + wr * 64 + m * 16 + fr) * 4 + wc] = s;
        }
    asm volatile("s_waitcnt lgkmcnt(0)" ::: "memory"); __builtin_amdgcn_s_barrier(); asm volatile("" ::: "memory");
    const int row = wid * 32 + (lane & 31);
    if (lane < 32) {
        const float tot = (P[row * 4 + 0] + P[row * 4 + 1]) + (P[row * 4 + 2] + P[row * 4 + 3]);
        __hip_atomic_store((unsigned*)xbuf + (size_t)(u.pm * BM + row) * 4 + u.pn, __builtin_bit_cast(unsigned, tot), __ATOMIC_RELAXED, __HIP_MEMORY_SCOPE_AGENT);
    }
    asm volatile("s_waitcnt vmcnt(0)" ::: "memory");
    if (lane == 0) __hip_atomic_fetch_add(cnt + 64 * u.pm, 1u, __ATOMIC_RELAXED, __HIP_MEMORY_SCOPE_AGENT);
    if (wid == 0) {
        unsigned sp = 0u;
        while ((unsigned)__builtin_amdgcn_readfirstlane(__hip_atomic_load(cnt + 64 * u.pm, __ATOMIC_RELAXED, __HIP_MEMORY_SCOPE_AGENT)) < 32u) { __builtin_amdgcn_s_sleep(2); if (++sp > (1u << 22)) break; }
        __builtin_amdgcn_fence(__ATOMIC_ACQUIRE, "agent");
    }
    asm volatile("s_waitcnt vmcnt(0) lgkmcnt(0)" ::: "memory"); __builtin_amdgcn_s_barrier(); asm volatile("" ::: "memory");
    if (lane < 32) {
        const unsigned* slot = (const unsigned*)xbuf + (size_t)(u.pm * BM + row) * 4; float q = 0.f;
#pragma unroll
        for (int t = 0; t < 4; ++t) q += __builtin_bit_cast(float, __hip_atomic_load(slot + t, __ATOMIC_RELAXED, __HIP_MEMORY_SCOPE_AGENT));
        S[row] = rsqrtf(q * (1.f / 1024.f) + 1e-6f);
    }
    asm volatile("s_waitcnt vmcnt(0) lgkmcnt(0)" ::: "memory"); __builtin_amdgcn_s_barrier(); asm volatile("" ::: "memory");
}
struct EpiRmsRes {
    static constexpr bool PERM = false, AFTER_DRAIN = true;
    const bf16_t* x1b; float* out; const float* gain; float* xbuf; unsigned* cnt;
    __device__ __forceinline__ void fused(f32x4 (&acc)[2][2][4][2], const Unit& u, int wr, int wc, int fr, int fq, PG8_LAS unsigned char* lds, int wid, int lane) const {
        typedef unsigned u32x2v __attribute__((ext_vector_type(2)));
        const PG8_LAS float* S = (const PG8_LAS float*)(lds + 4096);
        const int col0 = u.pn * BM + wc * 32 + 4 * fq;
        u32x2v pre[2][4][2][2];
#pragma unroll
        for (int ai = 0; ai < 2; ++ai)
#pragma unroll
            for (int m = 0; m < 4; ++m) { const size_t off = (size_t)(u.pm * BM + ai * HALF + wr * 64 + m * 16 + fr) * 1024 + col0;
#pragma unroll
                for (int bj = 0; bj < 2; ++bj)
#pragma unroll
                    for (int n = 0; n < 2; ++n) pre[ai][m][bj][n] = *(const u32x2v*)(x1b + off + bj * HALF + n * 16); }
        rms_exchange(acc, u, wr, wc, fr, fq, lds, wid, lane, xbuf, cnt);
        f32x4 gv[2][2];
#pragma unroll
        for (int bj = 0; bj < 2; ++bj)
#pragma unroll
            for (int n = 0; n < 2; ++n) gv[bj][n] = *(const f32x4*)(gain + col0 + bj * HALF + n * 16);
#pragma unroll
        for (int ai = 0; ai < 2; ++ai)
#pragma unroll
            for (int m = 0; m < 4; ++m) { const int r = ai * HALF + wr * 64 + m * 16 + fr; const float rs = S[r]; const size_t off = (size_t)(u.pm * BM + r) * 1024 + col0;
#pragma unroll
                for (int bj = 0; bj < 2; ++bj)
#pragma unroll
                    for (int n = 0; n < 2; ++n) { const u32x2v pv = pre[ai][m][bj][n];
                        const f32x4 bs = {__builtin_bit_cast(float, pv.x << 16), __builtin_bit_cast(float, pv.x & 0xffff0000u), __builtin_bit_cast(float, pv.y << 16), __builtin_bit_cast(float, pv.y & 0xffff0000u)};
                        *(f32x4*)(out + off + bj * HALF + n * 16) = bs + acc[ai][bj][m][n] * rs * gv[bj][n]; } }
    }
};
struct EpiRmsResRms {
    static constexpr bool PERM = false, AFTER_DRAIN = true;
    const float* x; bf16_t* x1b; bf16_t* h2; const float* g1; const float* g2; float* xbuf1; unsigned* cnt1; float* xbuf2; unsigned* cnt2;
    __device__ __forceinline__ void fused(f32x4 (&acc)[2][2][4][2], const Unit& u, int wr, int wc, int fr, int fq, PG8_LAS unsigned char* lds, int wid, int lane) const {
        typedef unsigned u32x2v __attribute__((ext_vector_type(2)));
        const PG8_LAS float* S = (const PG8_LAS float*)(lds + 4096);
        const int col0 = u.pn * BM + wc * 32 + 4 * fq;
        rms_exchange(acc, u, wr, wc, fr, fq, lds, wid, lane, xbuf1, cnt1);
        {
            f32x4 gv[2][2];
#pragma unroll
            for (int bj = 0; bj < 2; ++bj)
#pragma unroll
                for (int n = 0; n < 2; ++n) gv[bj][n] = *(const f32x4*)(g1 + col0 + bj * HALF + n * 16);
#pragma unroll
            for (int ai = 0; ai < 2; ++ai)
#pragma unroll
                for (int m = 0; m < 4; ++m) { const int r = ai * HALF + wr * 64 + m * 16 + fr; const float rs = S[r]; const size_t off = (size_t)(u.pm * BM + r) * 1024 + col0;
#pragma unroll
                    for (int bj = 0; bj < 2; ++bj)
#pragma unroll
                        for (int n = 0; n < 2; ++n) { const f32x4 bs = *(const f32x4*)(x + off + bj * HALF + n * 16); acc[ai][bj][m][n] = bs + acc[ai][bj][m][n] * rs * gv[bj][n]; }
                    asm volatile("" : "+v"(acc[ai][0][m][0]), "+v"(acc[ai][0][m][1]), "+v"(acc[ai][1][m][0]), "+v"(acc[ai][1][m][1]));
                    if (m & 1) asm volatile("" ::: "memory"); }
        }
        rms_exchange(acc, u, wr, wc, fr, fq, lds, wid, lane, xbuf2, cnt2);
        f32x4 gv[2][2];
#pragma unroll
        for (int bj = 0; bj < 2; ++bj)
#pragma unroll
            for (int n = 0; n < 2; ++n) gv[bj][n] = *(const f32x4*)(g2 + col0 + bj * HALF + n * 16);
#pragma unroll
        for (int ai = 0; ai < 2; ++ai)
#pragma unroll
            for (int m = 0; m < 4; ++m) { const int r = ai * HALF + wr * 64 + m * 16 + fr; const float rs = S[r]; const size_t off = (size_t)(u.pm * BM + r) * 1024 + col0;
#pragma unroll
                for (int bj = 0; bj < 2; ++bj)
#pragma unroll
                    for (int n = 0; n < 2; ++n) { const f32x4 x1 = acc[ai][bj][m][n]; { u32x2v xw; xw.x = cvt_pk_bf16(x1[0], x1[1]); xw.y = cvt_pk_bf16(x1[2], x1[3]); *(u32x2v*)(x1b + off + bj * HALF + n * 16) = xw; }
                        const f32x4 o = x1 * rs * gv[bj][n]; u32x2v w; w.x = cvt_pk_bf16(o[0], o[1]); w.y = cvt_pk_bf16(o[2], o[3]); *(u32x2v*)(h2 + off + bj * HALF + n * 16) = w; }
                asm volatile("" ::: "memory"); }
    }
};
struct EpiF32 {
    static constexpr bool PERM = true, AFTER_DRAIN = false;
    float* O; int ldc;
    __device__ __forceinline__ void operator()(const f32x4 (&acc)[2][2][4][2], const Unit& u, int wr, int wc, int fr, int fq) const {
        const int row0 = u.pm * BM + wr * 64 + fr, col0 = u.pn * BM + wc * 32 + 8 * fq;
#pragma unroll
        for (int ai = 0; ai < 2; ++ai)
#pragma unroll
            for (int m = 0; m < 4; ++m) { float* rowp = O + (size_t)(row0 + ai * HALF + m * 16) * ldc + col0;
#pragma unroll
                for (int bj = 0; bj < 2; ++bj) { *(f32x4*)(rowp + bj * HALF) = acc[ai][bj][m][0]; *(f32x4*)(rowp + bj * HALF + 4) = acc[ai][bj][m][1]; } }
    }
};
struct EpiSwiglu {
    static constexpr bool PERM = true, AFTER_DRAIN = false;
    bf16_t* O;
    __device__ __forceinline__ void operator()(const f32x4 (&acc)[2][2][4][2], const Unit& u, int wr, int wc, int fr, int fq) const {
        const int row0 = u.pm * BM + wr * 64 + fr, col0 = u.pn * HALF + wc * 32 + 8 * fq;
        const __amdgpu_buffer_rsrc_t rs = wt_rsrc(O, 96u << 20);
        const unsigned bshift = (unsigned)(u.pm >> 3) << 20;
#pragma unroll
        for (int ai = 0; ai < 2; ++ai)
#pragma unroll
            for (int m = 0; m < 4; ++m) { const unsigned rowb = (unsigned)(((size_t)(row0 + ai * HALF + m * 16) * DFF + col0) * 2) + bshift;
                float r[8];
#pragma unroll
                for (int n = 0; n < 2; ++n)
#pragma unroll
                    for (int e = 0; e < 4; ++e) { const float g = acc[ai][0][m][n][e], up = acc[ai][1][m][n][e];
                        r[4 * n + e] = g * __builtin_amdgcn_rcpf(1.f + __expf(-g)) * up; }
                u32x4 w; w.x = cvt_pk_bf16(r[0], r[1]); w.y = cvt_pk_bf16(r[2], r[3]); w.z = cvt_pk_bf16(r[4], r[5]); w.w = cvt_pk_bf16(r[6], r[7]);
                wt16(rs, rowb, w); }
    }
};
}

struct Args {
    const float* x; const float* pre_mix_gain; const float* w_in; const float* conv_w; const float* conv_b; const float* dt_bias; const float* a_log; const float* d_skip;
    const float* ssd_norm_gain; const float* sb_norm_gain; const float* w_out; const float* post_mix_gain; const float* pre_ffn_gain; const float* w_gate; const float* w_up;
    const float* w_down; const float* post_ffn_gain; float* out; unsigned char* ws; int ph_lo, ph_hi;
};

__device__ __forceinline__ void transpose_item(const float* src, int ldw, bf16* dst, int K, LAS float* scr, int lane, __amdgpu_buffer_rsrc_t wr, const bf16* wbase) {
    float tv[32];
#pragma unroll
    for (int i = 0; i < 32; ++i) tv[i] = src[(size_t)(2 * i + (lane >> 5)) * ldw + (lane & 31)];
#pragma unroll
    for (int i = 0; i < 32; ++i) scr[(2 * i + (lane >> 5)) * 33 + (lane & 31)] = tv[i];
    asm volatile("s_waitcnt lgkmcnt(0)" ::: "memory");
    const int c = lane & 7;
#pragma unroll
    for (int j = 0; j < 4; ++j) { const int n = (lane >> 3) + 8 * j; const LAS float* s = scr + (8 * c) * 33 + n;
        v4u o; o.x = pk2(s[0 * 33], s[1 * 33]); o.y = pk2(s[2 * 33], s[3 * 33]); o.z = pk2(s[4 * 33], s[5 * 33]); o.w = pk2(s[6 * 33], s[7 * 33]);
        wt16(wr, (unsigned)((dst + (size_t)n * K + 8 * c - wbase) * 2), o); }
    asm volatile("s_waitcnt lgkmcnt(0)" ::: "memory");
}

__device__ __forceinline__ void phase_p0(const Args& a, LAS unsigned char* lds, bool defer_w4, bool defer_w23) {
    const int tid = threadIdx.x, lane = tid & 63, wave = tid >> 6;
    const int gw = blockIdx.x * NWAVES + wave, NGW = gridDim.x * NWAVES;
    unsigned char* ws = a.ws;
    LAS float* scr = (LAS float*)(lds + wave * 8704);
    LAS float* wdt = (LAS float*)(lds + 73728);
    for (int i = tid; i < 8192; i += NTHR) { const int hd = i & 7, k = i >> 3; wdt[hd * 1024 + k] = a.w_in[(size_t)k * DIN + 1536 + hd]; }
    __syncthreads();
    bf16* W1 = (bf16*)(ws + WS_W1); bf16* W2 = (bf16*)(ws + WS_W2); bf16* W3 = (bf16*)(ws + WS_W3); bf16* W4 = (bf16*)(ws + WS_W4);
    const __amdgpu_buffer_rsrc_t wrs = wt_rsrc(W1, 25u << 20);
    constexpr int I1 = 16 * 48, I2 = 16 * 32, I3 = 16 * 88, I4 = 44 * 32;
    const int NITEMS = defer_w23 ? 2 * I1 : 2 * I1 + I2 + 2 * I3 + (defer_w4 ? 0 : I4);
    (void)0;
    for (int _rp = 0; _rp < 1 + (((REPMASK) >> 12) & 1); ++_rp)
    for (int it = gw; it < NITEMS; it += NGW) {
        int r = it;
        if (r < I1) { const int kb = r / 48, nb = r % 48; transpose_item(a.w_in + (size_t)(64 * kb) * DIN + 32 * nb, DIN, W1 + (size_t)(32 * nb) * 1024 + 64 * kb, 1024, scr, lane, wrs, W1); continue; } r -= I1;
        if (r < I1) { const int kb = r / 48, nb = r % 48; transpose_item(a.w_in + (size_t)(64 * kb) * DIN + 1544 + 32 * nb, DIN, W1 + (size_t)(1536 + 32 * nb) * 1024 + 64 * kb, 1024, scr, lane, wrs, W1); continue; } r -= I1;
        if (r < I2) { const int kb = r / 32, nb = r % 32; transpose_item(a.w_out + (size_t)(64 * kb) * 1024 + 32 * nb, 1024, W2 + (size_t)(32 * nb) * 1024 + 64 * kb, 1024, scr, lane, wrs, W1); continue; } r -= I2;
        if (r < I3) { const int kb = r / 88, nb = r % 88, n0 = 32 * nb; transpose_item(a.w_gate + (size_t)(64 * kb) * DFF + n0, DFF, W3 + (size_t)(256 * (n0 >> 7) + (n0 & 127)) * 1024 + 64 * kb, 1024, scr, lane, wrs, W1); continue; } r -= I3;
        if (r < I3) { const int kb = r / 88, nb = r % 88, n0 = 32 * nb; transpose_item(a.w_up + (size_t)(64 * kb) * DFF + n0, DFF, W3 + (size_t)(256 * (n0 >> 7) + 128 + (n0 & 127)) * 1024 + 64 * kb, 1024, scr, lane, wrs, W1); continue; } r -= I3;
        { const int kb = r / 32, nb = r % 32; transpose_item(a.w_down + (size_t)(64 * kb) * 1024 + 32 * nb, 1024, W4 + (size_t)(32 * nb) * DFF + 64 * kb, DFF, scr, lane, wrs, W1); }
    }
    bf16* H = (bf16*)(ws + WS_H); float* DT = (float*)(ws + WS_DT);
    const int hh = lane >> 5, b4 = (lane >> 4) & 1, b3 = (lane >> 3) & 1;
    v4f gpm[4];
#pragma unroll
    for (int j = 0; j < 4; ++j) gpm[j] = ((const v4f*)a.pre_mix_gain)[lane + 64 * j];
    v4f v[4], vn[4];
    if (gw < M) {
#pragma unroll
        for (int j = 0; j < 4; ++j) v[j] = ((const v4f*)(a.x + (size_t)gw * DM))[lane + 64 * j];
    }
    for (int _rq = 0; _rq < 1 + (((REPMASK) >> 13) & 1); ++_rq)
    for (int m = gw; m < M; m += NGW) {
        const int mn = m + NGW < M ? m + NGW : gw;
        if (true) {
#pragma unroll
            for (int j = 0; j < 4; ++j) vn[j] = ((const v4f*)(a.x + (size_t)mn * DM))[lane + 64 * j];
        }
        float s = 0.f;
#pragma unroll
        for (int j = 0; j < 4; ++j) s += (v[j].x * v[j].x + v[j].y * v[j].y) + (v[j].z * v[j].z + v[j].w * v[j].w);
        const float rstd = rsqrtf(wave_sum(s) * (1.f / DM) + EPS);
        float da[8];
#pragma unroll
        for (int hd = 0; hd < 8; ++hd) da[hd] = 0.f;
        unsigned long long* o8 = (unsigned long long*)(H + (size_t)m * DM) + lane;
#pragma unroll
        for (int j = 0; j < 4; ++j) {
            const v4f hv = v[j] * rstd * gpm[j];
            wt8(o8 + 64 * j, pk2(hv.x, hv.y), pk2(hv.z, hv.w));
#pragma unroll
            for (int hd = 0; hd < 8; ++hd) { const v4f w = *(const LAS v4f*)(wdt + hd * 1024 + 4 * lane + 256 * j); da[hd] += (hv.x * w.x + hv.y * w.y) + (hv.z * w.z + hv.w * w.w); }
        }
        float k4[4], k2[2], k1;
#pragma unroll
        for (int i = 0; i < 4; ++i) { const float keep = hh ? da[4 + i] : da[i], send = hh ? da[i] : da[4 + i]; k4[i] = keep + __shfl_xor(send, 32); }
#pragma unroll
        for (int i = 0; i < 2; ++i) { const float keep = b4 ? k4[2 + i] : k4[i], send = b4 ? k4[i] : k4[2 + i]; k2[i] = keep + __shfl_xor(send, 16); }
        { const float keep = b3 ? k2[1] : k2[0], send = b3 ? k2[0] : k2[1]; k1 = keep + __shfl_xor(send, 8); }
        k1 += __shfl_xor(k1, 4); k1 += __shfl_xor(k1, 2); k1 += __shfl_xor(k1, 1);
        if ((lane & 7) == 0) DT[(size_t)m * 8 + (lane >> 3)] = k1;
#pragma unroll
        for (int j = 0; j < 4; ++j) v[j] = vn[j];
    }
}

__device__ __forceinline__ void phase_w4(const Args& a, LAS unsigned char* lds) {
    if (blockIdx.x < 128) return;
    const int lane = threadIdx.x & 63, wave = threadIdx.x >> 6, gw = (blockIdx.x - 128) * NWAVES + wave, NGW = 128 * NWAVES;
    LAS float* scr = (LAS float*)(lds + wave * 8704);
    bf16* W1 = (bf16*)(a.ws + WS_W1); bf16* W4 = (bf16*)(a.ws + WS_W4);
    const __amdgpu_buffer_rsrc_t wrs = wt_rsrc(W1, 25u << 20);
    for (int r = gw; r < 44 * 32; r += NGW) { const int kb = r / 32, nb = r % 32; transpose_item(a.w_down + (size_t)(64 * kb) * 1024 + 32 * nb, 1024, W4 + (size_t)(32 * nb) * DFF + 64 * kb, DFF, scr, lane, wrs, W1); }
}

__device__ __forceinline__ void phase_w23(const Args& a, LAS unsigned char* lds) {
    const int lane = threadIdx.x & 63, wave = threadIdx.x >> 6, gw = blockIdx.x * NWAVES + wave, NGW = gridDim.x * NWAVES;
    LAS float* scr = (LAS float*)(lds + wave * 8704);
    bf16* W1 = (bf16*)(a.ws + WS_W1); bf16* W2 = (bf16*)(a.ws + WS_W2); bf16* W3 = (bf16*)(a.ws + WS_W3);
    const __amdgpu_buffer_rsrc_t wrs = wt_rsrc(W1, 25u << 20);
    constexpr int I2 = 16 * 32, I3 = 16 * 88;
    for (int it = gw; it < I2 + 2 * I3; it += NGW) {
        int r = it;
        if (r < I2) { const int kb = r / 32, nb = r % 32; transpose_item(a.w_out + (size_t)(64 * kb) * 1024 + 32 * nb, 1024, W2 + (size_t)(32 * nb) * 1024 + 64 * kb, 1024, scr, lane, wrs, W1); continue; } r -= I2;
        if (r < I3) { const int kb = r / 88, nb = r % 88, n0 = 32 * nb; transpose_item(a.w_gate + (size_t)(64 * kb) * DFF + n0, DFF, W3 + (size_t)(256 * (n0 >> 7) + (n0 & 127)) * 1024 + 64 * kb, 1024, scr, lane, wrs, W1); continue; } r -= I3;
        { const int kb = r / 88, nb = r % 88, n0 = 32 * nb; transpose_item(a.w_up + (size_t)(64 * kb) * DFF + n0, DFF, W3 + (size_t)(256 * (n0 >> 7) + 128 + (n0 & 127)) * 1024 + 64 * kb, 1024, scr, lane, wrs, W1); }
    }
    asm volatile("s_waitcnt vmcnt(0)" ::: "memory");
    if (lane == 0) __hip_atomic_fetch_add((unsigned*)(a.ws + WS_CTL) + 3744, 1u, __ATOMIC_RELAXED, __HIP_MEMORY_SCOPE_AGENT);
}

__device__ __forceinline__ void phase_conv_naive(const Args& a) {
    const bf16* PROJ = (const bf16*)(a.ws + WS_PROJ); float* XC = (float*)(a.ws + WS_CS);
    const size_t total = (size_t)M * 1024, stride = (size_t)gridDim.x * NTHR;
    for (size_t idx = (size_t)blockIdx.x * NTHR + threadIdx.x; idx < total; idx += stride) {
        const int m = (int)(idx >> 10), ch = (int)(idx & 1023), t = m & (SEQ - 1);
        float acc = a.conv_b[ch];
#pragma unroll
        for (int j = 0; j < 4; ++j) { const int tt = t - 3 + j; if (tt >= 0) acc += a.conv_w[j * 1024 + ch] * bf2f(PROJ[(size_t)(m - 3 + j) * N1 + PX + ch]); }
        XC[idx] = siluf(acc);
    }
}

__device__ __forceinline__ void phase_ssd_naive(const Args& a, LAS unsigned char* lds) {
    if (blockIdx.x >= 16) return;
    const int tid = threadIdx.x, lane = tid & 63, wave = tid >> 6;
    const int b = blockIdx.x >> 1, g = blockIdx.x & 1;
    const bool act = tid < 256;
    const int hl = (tid >> 6) & 3, p = tid & 63, h = 4 * g + hl;
    const bf16* PROJ = (const bf16*)(a.ws + WS_PROJ); const float* XC = (const float*)(a.ws + WS_CS); const float* DT = (const float*)(a.ws + WS_DT);
    bf16* YC = (bf16*)(a.ws + WS_H);
    LAS float* sBC = (LAS float*)lds; LAS float* red = (LAS float*)(lds + 1024);
    float st[128];
#pragma unroll
    for (int n = 0; n < 128; ++n) st[n] = 0.f;
    const float av = -__expf(a.a_log[h]), dtb = a.dt_bias[h], dsk = a.d_skip[h], gain = a.ssd_norm_gain[g * 256 + hl * 64 + p];
    for (int t = 0; t < SEQ; ++t) {
        const size_t m = (size_t)b * SEQ + t;
        if (act) sBC[tid] = XC[m * 1024 + (tid < 128 ? 512 + g * 128 + tid : 768 + g * 128 + (tid - 128))];
        __syncthreads();
        float y = 0.f;
        if (act) {
            const float dt = softplusf(DT[m * 8 + h] + dtb), dA = __expf(dt * av), xv = XC[m * 1024 + h * 64 + p], dx = dt * xv;
#pragma unroll
            for (int n = 0; n < 128; ++n) { st[n] = st[n] * dA + dx * sBC[n]; y += sBC[128 + n] * st[n]; }
            y += dsk * xv;
            y *= siluf(bf2f(PROJ[m * N1 + PZ + h * 64 + p]));
        }
        const float ss = wave_sum(y * y);
        if (lane == 0) red[wave] = ss;
        __syncthreads();
        const float tot = (red[0] + red[1]) + (red[2] + red[3]);
        if (act) YC[m * 1024 + h * 64 + p] = (bf16)f2bf(y * rsqrtf(tot * (1.f / 256.f) + EPS) * gain);
    }
}

__device__ __forceinline__ void phase_attn_naive(const Args& a, LAS unsigned char* lds) {
    const int tid = threadIdx.x;
    const bf16* PROJ = (const bf16*)(a.ws + WS_PROJ); bf16* YC = (bf16*)(a.ws + WS_H);
    LAS float* sK = (LAS float*)(lds + 4096); LAS float* sV = (LAS float*)(lds + 4096 + 16384);
    for (int unit = blockIdx.x; unit < 256; unit += gridDim.x) {
        const int b = unit >> 5, h = (unit >> 2) & 7, qb = unit & 3;
        const int t = qb * 512 + tid; const size_t m = (size_t)b * SEQ + t;
        float q[64], o[64];
#pragma unroll
        for (int d = 0; d < 64; ++d) { q[d] = bf2f(PROJ[m * N1 + PQ + h * 64 + d]); o[d] = 0.f; }
        float P = 1.f;
        for (int kt = qb * 8 + 7; kt >= 0; --kt) {
            __syncthreads();
#pragma unroll
            for (int i = 0; i < 8; ++i) { const int idx = tid + 512 * i, key = idx >> 6, d = idx & 63; const size_t mk = (size_t)b * SEQ + kt * 64 + key;
                sK[idx] = bf2f(PROJ[mk * N1 + PK + h * 64 + d]); sV[idx] = bf2f(PROJ[mk * N1 + PV + h * 64 + d]); }
            __syncthreads();
            for (int kk = 63; kk >= 0; --kk) {
                const int s = kt * 64 + kk;
                if (s < t) {
                    float z = 0.f;
#pragma unroll
                    for (int d = 0; d < 64; ++d) z += q[d] * sK[kk * 64 + d];
                    z = fminf(z, 100.f);
                    const float e = exp2f(z), r = 1.f / (1.f + e);
                    P *= r;
                    const float w = e * P;
#pragma unroll
                    for (int d = 0; d < 64; ++d) o[d] += w * sV[kk * 64 + d];
                }
            }
        }
        float ss = 0.f;
#pragma unroll
        for (int d = 0; d < 64; ++d) ss += o[d] * o[d];
        const float rstd = rsqrtf(ss * (1.f / 64.f) + EPS);
#pragma unroll
        for (int d = 0; d < 64; ++d) YC[m * 1024 + 512 + h * 64 + d] = (bf16)f2bf(o[d] * rstd * a.sb_norm_gain[h * 64 + d]);
    }
}


typedef short v4i16 __attribute__((ext_vector_type(4)));
typedef short bf16x8v __attribute__((ext_vector_type(8)));
constexpr int AT_KSTR = 144, AT_KBYTES = 64 * AT_KSTR, AT_VBYTES = 64 * 128, AT_BUF = AT_KBYTES + AT_VBYTES;
#define MFMA32(a, b, c) __builtin_amdgcn_mfma_f32_32x32x16_bf16((a), (b), (c), 0, 0, 0)

template <bool DIAG>
__device__ __forceinline__ void attn_tile(LAS const unsigned char* Kb, LAS const unsigned char* Vb, const bf16x8v (&qf)[4], f32x16& o0, f32x16& o1, float& carry,
                                          int qrel, int l32, int hh, unsigned vbase0, unsigned vbase1) {
    f32x16 p[2];
    bf16x8v kf[2][4];
#pragma unroll
    for (int blk = 0; blk < 2; ++blk)
#pragma unroll
        for (int s = 0; s < 4; ++s) kf[blk][s] = *(LAS const bf16x8v*)(Kb + (32 * blk + l32) * AT_KSTR + 32 * s + 16 * hh);
    asm volatile("s_waitcnt lgkmcnt(0)" ::: "memory");
#pragma unroll
    for (int bi = 0; bi < 2; ++bi) {
        const int blk = 1 - bi;
#pragma unroll
        for (int i = 0; i < 16; ++i) p[blk][i] = 0.f;
#pragma unroll
        for (int s = 0; s < 4; ++s) p[blk] = MFMA32(kf[blk][s], qf[s], p[blk]);
    }
#pragma unroll
    for (int bi = 0; bi < 2; ++bi) {
        const int blk = 1 - bi;
        float R[16];
#pragma unroll
        for (int i = 0; i < 16; ++i) {
            float rv = __builtin_amdgcn_rcpf(1.f + __builtin_amdgcn_exp2f(p[blk][i]));
            if (DIAG) { const int krel = 32 * blk + (i & 3) + 8 * (i >> 2) + 4 * hh; if (krel >= qrel) rv = 1.f; }
            R[i] = rv;
        }
        float GG[4], sel[4];
#pragma unroll
        for (int g = 0; g < 4; ++g) { R[4 * g + 2] *= R[4 * g + 3]; R[4 * g + 1] *= R[4 * g + 2]; R[4 * g] *= R[4 * g + 1]; }
#pragma unroll
        for (int g = 0; g < 4; g += 2) {
            const unsigned ua = __builtin_bit_cast(unsigned, R[4 * g]), ub = __builtin_bit_cast(unsigned, R[4 * g + 4]);
            auto s1 = __builtin_amdgcn_permlane32_swap(ua, ub, false, false);
            auto s2 = __builtin_amdgcn_permlane32_swap(ub, ua, false, false);
            const float pa = __builtin_bit_cast(float, hh ? s2[0] : s1[1]), pb2 = __builtin_bit_cast(float, hh ? s1[0] : s2[1]);
            GG[g] = R[4 * g] * pa; GG[g + 1] = R[4 * g + 4] * pb2;
            sel[g] = hh ? 1.f : pa; sel[g + 1] = hh ? 1.f : pb2;
        }
        float T3 = carry, T2 = T3 * GG[3], T1 = T2 * GG[2], T0 = T1 * GG[1];
        carry = T0 * GG[0];
        const float base[4] = {T0 * sel[0], T1 * sel[1], T2 * sel[2], T3 * sel[3]};
        float w[16];
#pragma unroll
        for (int g = 0; g < 4; ++g) {
            w[4 * g + 3] = base[g] * (1.f - R[4 * g + 3]); w[4 * g + 2] = base[g] * (R[4 * g + 3] - R[4 * g + 2]);
            w[4 * g + 1] = base[g] * (R[4 * g + 2] - R[4 * g + 1]); w[4 * g] = base[g] * (R[4 * g + 1] - R[4 * g]);
        }
#pragma unroll
        for (int s = 0; s < 2; ++s) {
            v4u pk; pk.x = cvtpk(w[8 * s], w[8 * s + 1]); pk.y = cvtpk(w[8 * s + 2], w[8 * s + 3]); pk.z = cvtpk(w[8 * s + 4], w[8 * s + 5]); pk.w = cvtpk(w[8 * s + 6], w[8 * s + 7]);
            const bf16x8v pb = __builtin_bit_cast(bf16x8v, pk);
            const int rowoff = (32 * blk + 16 * s) * 128;
            const v4i16 a0l = __builtin_amdgcn_ds_read_tr16_b64_v4i16((LAS v4i16*)(Vb + vbase0 + rowoff));
            const v4i16 a0h = __builtin_amdgcn_ds_read_tr16_b64_v4i16((LAS v4i16*)(Vb + vbase0 + rowoff + 8 * 128));
            const v4i16 a1l = __builtin_amdgcn_ds_read_tr16_b64_v4i16((LAS v4i16*)(Vb + vbase1 + rowoff));
            const v4i16 a1h = __builtin_amdgcn_ds_read_tr16_b64_v4i16((LAS v4i16*)(Vb + vbase1 + rowoff + 8 * 128));
            const bf16x8v va0 = __builtin_shufflevector(a0l, a0h, 0, 1, 2, 3, 4, 5, 6, 7), va1 = __builtin_shufflevector(a1l, a1h, 0, 1, 2, 3, 4, 5, 6, 7);
            o0 = MFMA32(va0, pb, o0); o1 = MFMA32(va1, pb, o1);
        }
    }
}

__device__ __forceinline__ void attn_unit(const Args& a, LAS unsigned char* lds, int b, int h, int qb) {
    const int tid = threadIdx.x, lane = tid & 63, w = __builtin_amdgcn_readfirstlane(tid >> 6), l32 = lane & 31, hh = lane >> 5;
    const bf16* PROJ = (const bf16*)(a.ws + WS_PROJ); bf16* YC = (bf16*)(a.ws + WS_H);
    const size_t rowbase = (size_t)b * SEQ;
    const int q0 = qb * 256 + 32 * w, ktd = q0 >> 6, ktmax = 4 * qb + 3, qrel = 32 * (w & 1) + l32;
    bf16x8v qf[4];
    { const bf16* qp = PROJ + (rowbase + q0 + l32) * N1 + PQ + h * 64 + 8 * hh;
#pragma unroll
      for (int s = 0; s < 4; ++s) qf[s] = *(const bf16x8v*)(qp + 16 * s); }
    f32x16 o0, o1;
#pragma unroll
    for (int i = 0; i < 16; ++i) { o0[i] = 0.f; o1[i] = 0.f; }
    float carry = 1.f;
    const int skey = tid >> 3, sc = tid & 7;
    const bf16* kg = PROJ + (rowbase + skey) * N1 + PK + h * 64 + 8 * sc;
    const unsigned kwoff = skey * AT_KSTR + sc * 16, vwoff = AT_KBYTES + skey * 128 + ((sc * 16) ^ (((skey >> 1) & 1) << 6));
    const int gi = (lane >> 4) & 1, q4 = (lane & 15) >> 2, pp = lane & 3;
    const unsigned vb = (4 * hh + q4) * 128 + 32 * gi + 8 * pp, xq = (q4 >> 1) << 6;
    const unsigned vbase0 = vb + xq, vbase1 = vb + (64 ^ xq);
    LAS unsigned* dflag = (LAS unsigned*)(lds + 6 * AT_BUF);
    bool wdone = false;
    const int tlo = ktmax >= 5 ? ktmax - 5 : 0, nwin = ktmax - tlo + 1;
    {
        v4u kr[6], vr[6];
#pragma unroll
        for (int i = 0; i < 6; ++i) if (i < nwin) { const size_t t = (size_t)(tlo + i) * 64 * N1; kr[i] = *(const v4u*)(kg + t); vr[i] = *(const v4u*)(kg + t + (PV - PK)); }
#pragma unroll
        for (int i = 0; i < 6; ++i) if (i < nwin) { *(LAS v4u*)(lds + i * AT_BUF + kwoff) = kr[i]; *(LAS v4u*)(lds + i * AT_BUF + vwoff) = vr[i]; }
    }
    __syncthreads();
#pragma unroll 1
    for (int kt = ktd; kt >= tlo; --kt) {
        if (!wdone) {
            LAS unsigned char* bt = lds + (kt - tlo) * AT_BUF;
            if (kt == ktd) attn_tile<true>(bt, bt + AT_KBYTES, qf, o0, o1, carry, qrel, l32, hh, vbase0, vbase1);
            else attn_tile<false>(bt, bt + AT_KBYTES, qf, o0, o1, carry, qrel, l32, hh, vbase0, vbase1);
            wdone = __builtin_amdgcn_ballot_w64(carry >= 3.5527137e-15f) == 0ull;
        }
    }
    if (lane == 0) dflag[16 + w] = wdone ? 1u : 0u;
    __syncthreads();
    bool alldone;
    { const v4u f0 = *(const LAS v4u*)(dflag + 16), f1 = *(const LAS v4u*)(dflag + 20);
      alldone = __builtin_amdgcn_readfirstlane((f0.x & f0.y & f0.z & f0.w) & (f1.x & f1.y & f1.z & f1.w)) != 0u; }
    if (!alldone && tlo > 0) {
        const int npair = tlo >> 1;
        const bf16* kg2 = kg + (size_t)64 * N1;
        v4u kr0, vr0, kr1, vr1;
        { const size_t t = (size_t)(npair - 1) * 128 * N1;
          kr0 = *(const v4u*)(kg + t); vr0 = *(const v4u*)(kg + t + (PV - PK)); kr1 = *(const v4u*)(kg2 + t); vr1 = *(const v4u*)(kg2 + t + (PV - PK)); }
        *(LAS v4u*)(lds + AT_BUF + kwoff) = kr0; *(LAS v4u*)(lds + AT_BUF + vwoff) = vr0; *(LAS v4u*)(lds + kwoff) = kr1; *(LAS v4u*)(lds + vwoff) = vr1;
        __syncthreads();
        int cur = 0, it = 0;
        for (int pj = npair - 1; pj >= 0; --pj, ++it) {
            if (pj > 0) { const size_t t = (size_t)(pj - 1) * 128 * N1;
                kr0 = *(const v4u*)(kg + t); vr0 = *(const v4u*)(kg + t + (PV - PK)); kr1 = *(const v4u*)(kg2 + t); vr1 = *(const v4u*)(kg2 + t + (PV - PK)); }
            LAS unsigned char* bh = lds + cur * (2 * AT_BUF); LAS unsigned char* bl = bh + AT_BUF;
            if (!wdone) {
                attn_tile<false>(bh, bh + AT_KBYTES, qf, o0, o1, carry, qrel, l32, hh, vbase0, vbase1);
                if (__builtin_amdgcn_ballot_w64(carry >= 3.5527137e-15f) != 0ull)
                    attn_tile<false>(bl, bl + AT_KBYTES, qf, o0, o1, carry, qrel, l32, hh, vbase0, vbase1);
                wdone = __builtin_amdgcn_ballot_w64(carry >= 3.5527137e-15f) == 0ull;
            }
            if (lane == 0) dflag[(it & 1) * 8 + w] = wdone ? 1u : 0u;
            if (pj > 0) { LAS unsigned char* nb = lds + (cur ^ 1) * (2 * AT_BUF);
                *(LAS v4u*)(nb + AT_BUF + kwoff) = kr0; *(LAS v4u*)(nb + AT_BUF + vwoff) = vr0; *(LAS v4u*)(nb + kwoff) = kr1; *(LAS v4u*)(nb + vwoff) = vr1; }
            __syncthreads();
            cur ^= 1;
            const v4u f0 = *(const LAS v4u*)(dflag + (it & 1) * 8), f1 = *(const LAS v4u*)(dflag + (it & 1) * 8 + 4);
            if (__builtin_amdgcn_readfirstlane((f0.x & f0.y & f0.z & f0.w) & (f1.x & f1.y & f1.z & f1.w)) != 0u) break;
        }
    }
    float ss = 0.f;
#pragma unroll
    for (int i = 0; i < 16; ++i) ss += o0[i] * o0[i] + o1[i] * o1[i];
    ss += __shfl_xor(ss, 32);
    const float rstd = rsqrtf(ss * (1.f / 64.f) + EPS);
    bf16* yp = YC + (rowbase + q0 + l32) * 1024 + 512 + h * 64 + 4 * hh;
    const float* gp = a.sb_norm_gain + h * 64 + 4 * hh;
#pragma unroll
    for (int g = 0; g < 4; ++g) {
        const v4f g0 = *(const v4f*)(gp + 8 * g), g1 = *(const v4f*)(gp + 32 + 8 * g);
        v2u s0, s1;
        s0.x = pk2(o0[4 * g] * rstd * g0.x, o0[4 * g + 1] * rstd * g0.y); s0.y = pk2(o0[4 * g + 2] * rstd * g0.z, o0[4 * g + 3] * rstd * g0.w);
        s1.x = pk2(o1[4 * g] * rstd * g1.x, o1[4 * g + 1] * rstd * g1.y); s1.y = pk2(o1[4 * g + 2] * rstd * g1.z, o1[4 * g + 3] * rstd * g1.w);
        *(v2u*)(yp + 8 * g) = s0; *(v2u*)(yp + 32 + 8 * g) = s1;
    }
}

__device__ __forceinline__ void phase_attn(const Args& a, LAS unsigned char* lds) {
    for (int pid = blockIdx.x; pid < 256; pid += gridDim.x) {
        int bh, qp;
        if (gridDim.x == 256) { const int xcd = pid & 7, j = pid >> 3; bh = xcd * 8 + (j >> 2); qp = j & 3; }
        else { bh = pid >> 2; qp = pid & 3; }
        attn_unit(a, lds, bh >> 3, bh & 7, 7 - qp);
        attn_unit(a, lds, bh >> 3, bh & 7, qp);
    }
}

constexpr int SD_DT = 0, SD_ACS = 1024, SD_WB = 2048, SD_X = 4096, SD_XS = 576, SD_B = 40960, SD_BS = 320, SD_C = 61440, SD_Z = 81920, SD_ZS = 528;

__device__ __forceinline__ float ssd_dt_load(const Args& a, int b, int c, int g) {
    const int tid = threadIdx.x;
    if (tid >= 256) return 0.f;
    return ((const float*)(a.ws + WS_DT))[((size_t)b * SEQ + 64 * c + (tid & 63)) * 8 + 4 * g + (tid >> 6)];
}
template <bool S1>
__device__ __forceinline__ void ssd_dt(const Args& a, LAS unsigned char* lds, int b, int c, int g, float dtraw) {
    const int tid = threadIdx.x, lane = tid & 63;
    if (tid < 256) {
        const int hl = tid >> 6, h = 4 * g + hl;
        const float dtv = softplusf(dtraw + a.dt_bias[h]);
        float cs = dtv * (-__expf(a.a_log[h]));
#pragma unroll
        for (int o = 1; o < 64; o <<= 1) { const float t = __shfl_up(cs, o); if (lane >= o) cs += t; }
        ((LAS float*)(lds + SD_DT))[hl * 64 + lane] = dtv;
        ((LAS float*)(lds + SD_ACS))[hl * 64 + lane] = cs;
        if (S1) {
            const float tot = __shfl(cs, 63);
            ((LAS float*)(lds + SD_WB))[hl * 64 + lane] = __expf(tot - cs) * dtv;
            if (lane == 63) ((float*)(a.ws + WS_CD))[((size_t)b * NCH + c) * 8 + h] = __expf(tot);
        }
    }
}

struct ConvIn { unsigned halo[3]; unsigned vin[32]; };
__device__ __forceinline__ void ssd_conv_load(const Args& a, ConvIn& r, int b, int c, int th, int col) {
    const bf16* PROJ = (const bf16*)(a.ws + WS_PROJ);
    const int t0 = 64 * c + 32 * th;
    const bf16* src = PROJ + ((size_t)b * SEQ + t0) * N1 + PX + col;
#pragma unroll
    for (int j = 0; j < 3; ++j) { unsigned v = 0u; if (t0 - 3 + j >= 0) v = *(const unsigned*)(src + (ptrdiff_t)(j - 3) * N1); r.halo[j] = v; }
#pragma unroll
    for (int i = 0; i < 32; ++i) r.vin[i] = *(const unsigned*)(src + (size_t)i * N1);
}
template <bool SCALE>
__device__ __forceinline__ void ssd_conv_compute(const Args& a, const ConvIn& r, LAS unsigned char* dst, int dstride, int th, int col, const LAS float* wsc) {
    float w0[4], w1[4];
#pragma unroll
    for (int j = 0; j < 4; ++j) { w0[j] = a.conv_w[j * 1024 + col]; w1[j] = a.conv_w[j * 1024 + col + 1]; }
    const float b0 = a.conv_b[col], b1 = a.conv_b[col + 1];
    float u0[3], u1[3];
#pragma unroll
    for (int j = 0; j < 3; ++j) { u0[j] = bflo(r.halo[j]); u1[j] = bfhi(r.halo[j]); }
#pragma unroll
    for (int i = 0; i < 32; ++i) {
        const unsigned v = r.vin[i];
        const float c0 = bflo(v), c1 = bfhi(v);
        float y0 = b0 + w0[0] * u0[0] + w0[1] * u0[1] + w0[2] * u0[2] + w0[3] * c0;
        float y1 = b1 + w1[0] * u1[0] + w1[1] * u1[1] + w1[2] * u1[2] + w1[3] * c1;
        u0[0] = u0[1]; u0[1] = u0[2]; u0[2] = c0; u1[0] = u1[1]; u1[1] = u1[2]; u1[2] = c1;
        y0 = silu_fast(y0); y1 = silu_fast(y1);
        if (SCALE) { const float s = wsc[32 * th + i]; y0 *= s; y1 *= s; }
        *(LAS unsigned*)(dst + (32 * th + i) * dstride) = pk2(y0, y1);
    }
}

__device__ __forceinline__ bf16x8v tr_pair(LAS const unsigned char* p, int rowstride4) {
    const v4i16 lo = __builtin_amdgcn_ds_read_tr16_b64_v4i16((LAS v4i16*)p);
    const v4i16 hi = __builtin_amdgcn_ds_read_tr16_b64_v4i16((LAS v4i16*)(p + rowstride4));
    return __builtin_shufflevector(lo, hi, 0, 1, 2, 3, 4, 5, 6, 7);
}

__device__ __forceinline__ int ssd_item(int item);
__device__ __forceinline__ void phase_ssd_s1(const Args& a, LAS unsigned char* lds) {
    const int tid = threadIdx.x, lane = tid & 63, w = __builtin_amdgcn_readfirstlane(tid >> 6), l32 = lane & 31, hh = lane >> 5;
    const int hl = w >> 1, half = w & 1;
    const int gi = (lane >> 4) & 1, q4 = (lane & 15) >> 2, pp = lane & 3;
    bf16* CS = (bf16*)(a.ws + WS_CS);
    ConvIn cin; float dtraw = 0.f;
    const int cp = tid % 192, th = tid / 192;
    if (blockIdx.x < NB * NCH * 2) { const int it0 = ssd_item(blockIdx.x), g0 = it0 & 1, c0 = (it0 >> 1) & (NCH - 1), b0 = it0 >> 6;
        if (tid < 384) ssd_conv_load(a, cin, b0, c0, th, cp < 128 ? 256 * g0 + 2 * cp : 512 + 128 * g0 + 2 * (cp - 128));
        dtraw = ssd_dt_load(a, b0, c0, g0); }
    for (int item = blockIdx.x; item < NB * NCH * 2; item += gridDim.x) {
        const int it2 = ssd_item(item), g = it2 & 1, c = (it2 >> 1) & (NCH - 1), b = it2 >> 6;
        const int ccol = cp < 128 ? 256 * g + 2 * cp : 512 + 128 * g + 2 * (cp - 128);
        __syncthreads();
        ssd_dt<true>(a, lds, b, c, g, dtraw);
        __syncthreads();
        if (tid < 384) {
            if (cp < 128) ssd_conv_compute<true>(a, cin, lds + SD_X + 4 * cp, SD_XS, th, ccol, (const LAS float*)(lds + SD_WB) + (cp >> 5) * 64);
            else ssd_conv_compute<false>(a, cin, lds + SD_B + 4 * (cp - 128), SD_BS, th, ccol, nullptr);
        }
        __syncthreads();
        { const int itn = item + gridDim.x;
          if (itn < NB * NCH * 2) { const int in2 = ssd_item(itn), gn = in2 & 1, cn = (in2 >> 1) & (NCH - 1), bn = in2 >> 6;
              if (tid < 384) ssd_conv_load(a, cin, bn, cn, th, cp < 128 ? 256 * gn + 2 * cp : 512 + 128 * gn + 2 * (cp - 128));
              dtraw = ssd_dt_load(a, bn, cn, gn); } }
        f32x16 acc[2][2];
#pragma unroll
        for (int i = 0; i < 16; ++i) { acc[0][0][i] = 0.f; acc[0][1][i] = 0.f; acc[1][0][i] = 0.f; acc[1][1][i] = 0.f; }
#pragma unroll
        for (int s = 0; s < 4; ++s) {
            const int l0 = 16 * s + 8 * hh + q4;
            bf16x8v af[2], bfr[2];
#pragma unroll
            for (int nb = 0; nb < 2; ++nb) af[nb] = tr_pair(lds + SD_B + l0 * SD_BS + (32 * (2 * half + nb) + 16 * gi + 4 * pp) * 2, 4 * SD_BS);
#pragma unroll
            for (int pb = 0; pb < 2; ++pb) bfr[pb] = tr_pair(lds + SD_X + l0 * SD_XS + (64 * hl + 32 * pb + 16 * gi + 4 * pp) * 2, 4 * SD_XS);
#pragma unroll
            for (int nb = 0; nb < 2; ++nb)
#pragma unroll
                for (int pb = 0; pb < 2; ++pb) acc[nb][pb] = MFMA32(bfr[pb], af[nb], acc[nb][pb]);
        }
        bf16* dst = CS + ((((size_t)b * NCH + c) * 8 + 4 * g + hl) * 64) * 128;
#pragma unroll
        for (int nb = 0; nb < 2; ++nb)
#pragma unroll
            for (int pb = 0; pb < 2; ++pb)
#pragma unroll
                for (int i = 0; i < 16; ++i) { const int p = 32 * pb + (i & 3) + 8 * (i >> 2) + 4 * hh; dst[p * 128 + 32 * (2 * half + nb) + l32] = (bf16)f2bf(acc[nb][pb][i]); }
    }
}

__device__ __forceinline__ void phase_ssd_s2(const Args& a) {
    const bf16* CS = (const bf16*)(a.ws + WS_CS); const float* CD = (const float*)(a.ws + WS_CD);
    for (int gid = blockIdx.x * NTHR + threadIdx.x; gid < 64 * 2048; gid += gridDim.x * NTHR) {
        int bh = gid >> 11, e4 = gid & 2047;
        if (gridDim.x == 256) { const int blk = gid >> 9, grp = blk & 7, j = blk >> 3; bh = grp * 8 + (j >> 2); e4 = (j & 3) * 512 + (gid & 511); }
        const int b = bh >> 3, h = bh & 7;
        const v2u* p = (const v2u*)(CS + (((size_t)b * NCH) * 8 + h) * 8192) + e4;
        const float* cd = CD + (size_t)b * NCH * 8 + h;
        v2u* o = (v2u*)((bf16*)(a.ws + WS_PB) + (((size_t)b * NCH) * 8 + h) * 8192) + e4;
        v4f st = {0.f, 0.f, 0.f, 0.f};
        for (int c0 = 0; c0 < NCH; c0 += 16) {
            v2u v[16]; float d[16];
#pragma unroll
            for (int j = 0; j < 16; ++j) { v[j] = p[(size_t)(c0 + j) * 16384]; d[j] = cd[(c0 + j) * 8]; }
#pragma unroll
            for (int j = 0; j < 16; ++j) { v2u w2; w2.x = cvtpk(st.x, st.y); w2.y = cvtpk(st.z, st.w); wt8(o + (size_t)(c0 + j) * 16384, w2.x, w2.y);
                const v4f vv = {bflo(v[j].x), bfhi(v[j].x), bflo(v[j].y), bfhi(v[j].y)}; st = st * d[j] + vv; }
        }
    }
}

__device__ __forceinline__ void phase_ssd_s3(const Args& a, LAS unsigned char* lds) {
    const int tid = threadIdx.x, lane = tid & 63, w = __builtin_amdgcn_readfirstlane(tid >> 6), l32 = lane & 31, hh = lane >> 5;
    const int hl = w >> 1, half = w & 1;
    const int gi = (lane >> 4) & 1, q4 = (lane & 15) >> 2, pp = lane & 3;
    const bf16* PROJ = (const bf16*)(a.ws + WS_PROJ); bf16* YC = (bf16*)(a.ws + WS_H);
    for (int item = blockIdx.x; item < NB * NCH * 2; item += gridDim.x) {
        const int it2 = ssd_item(item), g = it2 & 1, c = (it2 >> 1) & (NCH - 1), b = it2 >> 6, h = 4 * g + hl;
        const size_t m0 = (size_t)b * SEQ + 64 * c;
        __syncthreads();
        bf16x8v pvf[8][2];
        { const bf16* pvb = (const bf16*)(a.ws + WS_PB) + ((((size_t)b * NCH + c) * 8 + h) * 64 + l32) * 128 + 8 * hh;
#pragma unroll
          for (int s = 0; s < 8; ++s) { pvf[s][0] = *(const bf16x8v*)(pvb + 16 * s); pvf[s][1] = *(const bf16x8v*)(pvb + 32 * 128 + 16 * s); } }
        ConvIn cin; v4u zr[4];
        {
            const int cp = tid & 255, th = tid >> 8;
            const int ccol = cp < 128 ? 256 * g + 2 * cp : (cp < 192 ? 512 + 128 * g + 2 * (cp - 128) : 768 + 128 * g + 2 * (cp - 192));
            ssd_conv_load(a, cin, b, c, th, ccol);
#pragma unroll
            for (int i = 0; i < 4; ++i) { const int id = tid + 512 * i, row = id >> 5, ck = id & 31; zr[i] = *(const v4u*)(PROJ + (m0 + row) * N1 + PZ + 256 * g + 8 * ck); }
            ssd_dt<false>(a, lds, b, c, g, ssd_dt_load(a, b, c, g));
            LAS unsigned char* cdst = cp < 128 ? lds + SD_X + 4 * cp : (cp < 192 ? lds + SD_B + 4 * (cp - 128) : lds + SD_C + 4 * (cp - 192));
            ssd_conv_compute<false>(a, cin, cdst, cp < 128 ? SD_XS : SD_BS, th, ccol, nullptr);
#pragma unroll
            for (int i = 0; i < 4; ++i) { const int id = tid + 512 * i, row = id >> 5, ck = id & 31; *(LAS v4u*)(lds + SD_Z + row * SD_ZS + 16 * ck) = zr[i]; }
        }
        __syncthreads();
        const int lcol = 32 * half + l32;
        bf16x8v cf[8];
        f32x16 yo[2], yd[2];
#pragma unroll
        for (int i = 0; i < 16; ++i) { yo[0][i] = 0.f; yo[1][i] = 0.f; yd[0][i] = 0.f; yd[1][i] = 0.f; }
#pragma unroll
        for (int s = 0; s < 8; ++s) {
            cf[s] = *(LAS const bf16x8v*)(lds + SD_C + lcol * SD_BS + (16 * s + 8 * hh) * 2);
            yo[0] = MFMA32(pvf[s][0], cf[s], yo[0]); yo[1] = MFMA32(pvf[s][1], cf[s], yo[1]);
        }
        const float acs_l = ((const LAS float*)(lds + SD_ACS))[hl * 64 + lcol];
#pragma unroll
        for (int sb = 0; sb < 2; ++sb) {
            if (sb <= half) {
                f32x16 cb;
#pragma unroll
                for (int i = 0; i < 16; ++i) cb[i] = 0.f;
#pragma unroll
                for (int s = 0; s < 8; ++s) { const bf16x8v bfrag = *(LAS const bf16x8v*)(lds + SD_B + (32 * sb + l32) * SD_BS + (16 * s + 8 * hh) * 2); cb = MFMA32(bfrag, cf[s], cb); }
                float mv[16];
#pragma unroll
                for (int gq = 0; gq < 4; ++gq) {
                    const v4f as4 = *(const LAS v4f*)(lds + SD_ACS + (hl * 64 + 32 * sb + 8 * gq + 4 * hh) * 4), dt4 = *(const LAS v4f*)(lds + SD_DT + (hl * 64 + 32 * sb + 8 * gq + 4 * hh) * 4);
#pragma unroll
                    for (int j = 0; j < 4; ++j) { const int srow = 32 * sb + 8 * gq + 4 * hh + j;
                        const float dec = __expf(fminf(acs_l - as4[j], 0.f)) * dt4[j];
                        mv[4 * gq + j] = (srow <= lcol) ? cb[4 * gq + j] * dec : 0.f; }
                }
#pragma unroll
                for (int k2 = 0; k2 < 2; ++k2) {
                    v4u pk; pk.x = cvtpk(mv[8 * k2], mv[8 * k2 + 1]); pk.y = cvtpk(mv[8 * k2 + 2], mv[8 * k2 + 3]); pk.z = cvtpk(mv[8 * k2 + 4], mv[8 * k2 + 5]); pk.w = cvtpk(mv[8 * k2 + 6], mv[8 * k2 + 7]);
                    const bf16x8v mf = __builtin_bit_cast(bf16x8v, pk);
#pragma unroll
                    for (int pb = 0; pb < 2; ++pb) {
                        const bf16x8v xf = tr_pair(lds + SD_X + (32 * sb + 16 * k2 + 4 * hh + q4) * SD_XS + (64 * hl + 32 * pb + 16 * gi + 4 * pp) * 2, 8 * SD_XS);
                        yd[pb] = MFMA32(xf, mf, yd[pb]);
                    }
                }
            }
        }
        const float eal = __expf(acs_l), dsk = a.d_skip[h];
        float y[2][16]; float ss = 0.f;
#pragma unroll
        for (int pb = 0; pb < 2; ++pb)
#pragma unroll
            for (int gq = 0; gq < 4; ++gq) {
                const int ch = 64 * hl + 32 * pb + 8 * gq + 4 * hh;
                const v2u xv = *(const LAS v2u*)(lds + SD_X + lcol * SD_XS + ch * 2), zv = *(const LAS v2u*)(lds + SD_Z + lcol * SD_ZS + ch * 2);
                const float xs[4] = {bflo(xv.x), bfhi(xv.x), bflo(xv.y), bfhi(xv.y)}, zs[4] = {bflo(zv.x), bfhi(zv.x), bflo(zv.y), bfhi(zv.y)};
#pragma unroll
                for (int j = 0; j < 4; ++j) { float t = yd[pb][4 * gq + j] + yo[pb][4 * gq + j] * eal + dsk * xs[j]; t *= silu_fast(zs[j]); y[pb][4 * gq + j] = t; ss += t * t; }
            }
        ss += __shfl_xor(ss, 32);
        if (hh == 0) ((LAS float*)(lds + SD_WB))[hl * 64 + lcol] = ss;
        __syncthreads();
        const LAS float* sred = (const LAS float*)(lds + SD_WB);
        const float tot = (sred[lcol] + sred[64 + lcol]) + (sred[128 + lcol] + sred[192 + lcol]);
        const float rstd = rsqrtf(tot * (1.f / 256.f) + EPS);
        bf16* yp = YC + (m0 + lcol) * 1024 + 256 * g + 64 * hl + 4 * hh;
        const float* gp = a.ssd_norm_gain + 256 * g + 64 * hl + 4 * hh;
#pragma unroll
        for (int pb = 0; pb < 2; ++pb)
#pragma unroll
            for (int gq = 0; gq < 4; ++gq) {
                const v4f gn = *(const v4f*)(gp + 32 * pb + 8 * gq);
                v2u o; o.x = pk2(y[pb][4 * gq] * rstd * gn.x, y[pb][4 * gq + 1] * rstd * gn.y); o.y = pk2(y[pb][4 * gq + 2] * rstd * gn.z, y[pb][4 * gq + 3] * rstd * gn.w);
                *(v2u*)(yp + 32 * pb + 8 * gq) = o;
            }
    }
}

__device__ __forceinline__ void phase_norm1(const Args& a) {
    const int lane = threadIdx.x & 63, wave = threadIdx.x >> 6, gw = blockIdx.x * NWAVES + wave, NGW = gridDim.x * NWAVES;
    const bf16* MIX = (const bf16*)(a.ws + WS_PROJ); bf16* H = (bf16*)(a.ws + WS_H);
    v4f g1[4], g2[4];
#pragma unroll
    for (int j = 0; j < 4; ++j) { g1[j] = ((const v4f*)a.post_mix_gain)[lane + 64 * j]; g2[j] = ((const v4f*)a.pre_ffn_gain)[lane + 64 * j]; }
    v2u mv[4], mvn[4]; v4f xv[4], xvn[4];
    if (gw < M) {
#pragma unroll
        for (int j = 0; j < 4; ++j) { mv[j] = ((const v2u*)(MIX + (size_t)gw * DM))[lane + 64 * j]; xv[j] = ((const v4f*)(a.x + (size_t)gw * DM))[lane + 64 * j]; }
    }
    for (int m = gw; m < M; m += NGW) {
        const int mn = m + NGW;
        if (mn < M) {
#pragma unroll
            for (int j = 0; j < 4; ++j) { mvn[j] = ((const v2u*)(MIX + (size_t)mn * DM))[lane + 64 * j]; xvn[j] = ((const v4f*)(a.x + (size_t)mn * DM))[lane + 64 * j]; }
        }
        v4f* orow = (v4f*)(a.out + (size_t)m * DM) + lane;
        v4f v[4]; float s = 0.f;
#pragma unroll
        for (int j = 0; j < 4; ++j) { v[j] = (v4f){bflo(mv[j].x), bfhi(mv[j].x), bflo(mv[j].y), bfhi(mv[j].y)}; s += (v[j].x * v[j].x + v[j].y * v[j].y) + (v[j].z * v[j].z + v[j].w * v[j].w); }
        const float rstd = rsqrtf(wave_sum(s) * (1.f / DM) + EPS);
        float s2 = 0.f;
#pragma unroll
        for (int j = 0; j < 4; ++j) { xv[j] = xv[j] + v[j] * rstd * g1[j]; orow[64 * j] = xv[j];
            s2 += (xv[j].x * xv[j].x + xv[j].y * xv[j].y) + (xv[j].z * xv[j].z + xv[j].w * xv[j].w); }
        const float rstd2 = rsqrtf(wave_sum(s2) * (1.f / DM) + EPS);
        unsigned long long* o8 = (unsigned long long*)(H + (size_t)m * DM) + lane;
#pragma unroll
        for (int j = 0; j < 4; ++j) { const v4f hv = xv[j] * rstd2 * g2[j];
            o8[64 * j] = (unsigned long long)pk2(hv.x, hv.y) | ((unsigned long long)pk2(hv.z, hv.w) << 32); }
#pragma unroll
        for (int j = 0; j < 4; ++j) { mv[j] = mvn[j]; xv[j] = xvn[j]; }
    }
}
__device__ __forceinline__ void phase_norm2(const Args& a) {
    const int lane = threadIdx.x & 63, wave = threadIdx.x >> 6, gw = blockIdx.x * NWAVES + wave, NGW = gridDim.x * NWAVES;
    const bf16* F = (const bf16*)(a.ws + WS_CS);
    v4f g1[4];
#pragma unroll
    for (int j = 0; j < 4; ++j) g1[j] = ((const v4f*)a.post_ffn_gain)[lane + 64 * j];
    v2u fv[4], fvn[4]; v4f xv[4], xvn[4];
    if (gw < M) {
#pragma unroll
        for (int j = 0; j < 4; ++j) { fv[j] = ((const v2u*)(F + (size_t)gw * DM))[lane + 64 * j]; xv[j] = ((const v4f*)(a.out + (size_t)gw * DM))[lane + 64 * j]; }
    }
    for (int m = gw; m < M; m += NGW) {
        const int mn = m + NGW;
        if (mn < M) {
#pragma unroll
            for (int j = 0; j < 4; ++j) { fvn[j] = ((const v2u*)(F + (size_t)mn * DM))[lane + 64 * j]; xvn[j] = ((const v4f*)(a.out + (size_t)mn * DM))[lane + 64 * j]; }
        }
        v4f* orow = (v4f*)(a.out + (size_t)m * DM) + lane;
        v4f v[4]; float s = 0.f;
#pragma unroll
        for (int j = 0; j < 4; ++j) { v[j] = (v4f){bflo(fv[j].x), bfhi(fv[j].x), bflo(fv[j].y), bfhi(fv[j].y)}; s += (v[j].x * v[j].x + v[j].y * v[j].y) + (v[j].z * v[j].z + v[j].w * v[j].w); }
        const float rstd = rsqrtf(wave_sum(s) * (1.f / DM) + EPS);
#pragma unroll
        for (int j = 0; j < 4; ++j) orow[64 * j] = xv[j] + v[j] * rstd * g1[j];
#pragma unroll
        for (int j = 0; j < 4; ++j) { fv[j] = fvn[j]; xv[j] = xvn[j]; }
    }
}

#define XB_TMO      128
#define XB_XCNT(j)  (256  + 64 * (j))
#define XB_XSUB(j)  (1280 + 64 * (j))
#define XB_XGEN(j)  (2304 + 64 * (j))
#define XB_TOP      3328
#define XB_TOPGEN   3392
#define XCD_BAR_WORDS 3456
#define XB_SPIN_CAP (1u << 18)

__device__ __forceinline__ unsigned xb_ld(unsigned* p)              { return __hip_atomic_load(p, __ATOMIC_RELAXED, __HIP_MEMORY_SCOPE_AGENT); }
__device__ __forceinline__ unsigned xb_add(unsigned* p, unsigned v) { return __hip_atomic_fetch_add(p, v, __ATOMIC_RELAXED, __HIP_MEMORY_SCOPE_AGENT); }
__device__ __forceinline__ unsigned xb_xcc_id() { return (unsigned)__builtin_amdgcn_s_getreg((3 << 11) | 20) & 0xFu; }
#define XB_SPIN(cond, bar) do { unsigned _sp = 0; while (cond) { __builtin_amdgcn_s_sleep(1); \
    if ((++_sp & 255u) == 0u) { if (xb_ld(&(bar)[XB_TMO])) break; if (_sp > XB_SPIN_CAP) { atomicAdd(&(bar)[XB_TMO], 1u); break; } } } } while (0)

struct XcdBarrier {
    unsigned* bar; unsigned x;
    volatile LAS unsigned* st;
};

__device__ __forceinline__ XcdBarrier xcd_barrier_post(unsigned* bar, volatile LAS unsigned* st) {
    XcdBarrier b; b.bar = bar; b.x = xb_xcc_id(); b.st = st;
    if (threadIdx.x == 0) (void)xb_add(&bar[XB_XCNT(b.x)], 1u);
    return b;
}
__device__ __forceinline__ void xcd_barrier_complete(unsigned* bar, unsigned x, unsigned& nloc, unsigned& nx) {
    const unsigned G = gridDim.x * gridDim.y * gridDim.z;
    unsigned sum, cnt, mine, sp = 0u;
    for (;;) {
        sum = 0u; cnt = 0u; mine = 0u;
#pragma unroll
        for (unsigned j = 0; j < 16; ++j) { const unsigned c = xb_ld(&bar[XB_XCNT(j)]); sum += c; cnt += (c > 0u) ? 1u : 0u; mine = (j == x) ? c : mine; }
        if (sum == G) break;
        __builtin_amdgcn_s_sleep(1);
        if ((++sp & 255u) == 0u) { if (xb_ld(&bar[XB_TMO])) break; if (sp > XB_SPIN_CAP) { atomicAdd(&bar[XB_TMO], 1u); break; } }
    }
    nloc = mine > 0u ? mine : 1u; nx = cnt > 0u ? cnt : 1u;
}

__device__ __forceinline__ void xcd_barrier(const XcdBarrier& b) {
    asm volatile("s_waitcnt vmcnt(0)" ::: "memory");
    __syncthreads();
    if (threadIdx.x == 0) {
        unsigned* bar = b.bar;
        __builtin_amdgcn_s_waitcnt(0);
        unsigned nloc = b.st[0], nx = b.st[1];
        if (nloc == 0u) { xcd_barrier_complete(bar, b.x, nloc, nx); b.st[0] = nloc; b.st[1] = nx; }
        const unsigned old = xb_add(&bar[XB_XSUB(b.x)], 1u);
        const unsigned gen = old / nloc;
        if (old + 1u == (gen + 1u) * nloc) {
            __builtin_amdgcn_fence(__ATOMIC_RELEASE, "agent");
            asm volatile("s_waitcnt vmcnt(0)" ::: "memory");
            const unsigned og = xb_add(&bar[XB_TOP], 1u);
            const unsigned tg = og / nx;
            if (og + 1u == (tg + 1u) * nx) xb_add(&bar[XB_TOPGEN], 1u);
            else XB_SPIN(xb_ld(&bar[XB_TOPGEN]) == tg, bar);
            __builtin_amdgcn_fence(__ATOMIC_ACQUIRE, "agent");
            xb_add(&bar[XB_XGEN(b.x)], 1u);
            asm volatile("s_waitcnt vmcnt(0)" ::: "memory");
        } else {
            XB_SPIN(xb_ld(&bar[XB_XGEN(b.x)]) == gen, bar);
            __builtin_amdgcn_fence(__ATOMIC_ACQUIRE, "agent");
            asm volatile("s_waitcnt vmcnt(0)" ::: "memory");
        }
    }
    __syncthreads();
}


__device__ __forceinline__ int ssd_item(int item) {
    if (gridDim.x != 256) return item;
    const int blk = item & 255, k = item >> 8, grp = blk & 7, j = blk >> 3;
    return (grp << 6) | (j + 32 * k);
}
#define XL_SUB(g) (3472 + 16 * (g))
#define XL_GEN(g) (3600 + 16 * (g))
#define XL_MASK(g) (3456 + (g))
__device__ __forceinline__ void local_barrier(unsigned* ctl, int g) {
    asm volatile("s_waitcnt vmcnt(0)" ::: "memory");
    __syncthreads();
    if (threadIdx.x == 0) {
        const unsigned old = xb_add(&ctl[XL_SUB(g)], 1u), gen = old / 32u;
        if (old + 1u == (gen + 1u) * 32u) xb_add(&ctl[XL_GEN(g)], 1u);
        else { unsigned sp = 0u; while (xb_ld(&ctl[XL_GEN(g)]) == gen) { __builtin_amdgcn_s_sleep(1); if (++sp > (1u << 22)) break; } }
        __builtin_amdgcn_fence(__ATOMIC_ACQUIRE, "agent");
        asm volatile("s_waitcnt vmcnt(0)" ::: "memory");
    }
    __syncthreads();
}
constexpr int NPHASE = 10;
__global__ void __launch_bounds__(NTHR, 2) fwd(Args a) {
    extern __shared__ __attribute__((aligned(16))) unsigned char lds_raw[];
    LAS unsigned char* lds = (LAS unsigned char*)lds_raw;
    const int lo = a.ph_lo, hi = a.ph_hi;
#ifndef REPMASK
#define REPMASK 0
#endif
#define REP(k) for (int _r = 0; _r < (((REPMASK) >> (k)) & 1) + 1; ++_r)
#define IN(k) (lo <= (k) && (k) < hi)
#define SEAM(k) do { if (IN(k) && IN((k) + 1)) xcd_barrier(bar); } while (0)
    unsigned char* ws = a.ws;
    volatile LAS unsigned* misc = (volatile LAS unsigned*)(lds + 131072);
    if (threadIdx.x < 2) misc[threadIdx.x] = 0u;
    __syncthreads();
    XcdBarrier bar = xcd_barrier_post((unsigned*)(ws + WS_CTL), misc);
    unsigned* ctlw = (unsigned*)(ws + WS_CTL);
    if (threadIdx.x == 0) __hip_atomic_fetch_or(&ctlw[XL_MASK(blockIdx.x & 7)], 1u << bar.x, __ATOMIC_RELAXED, __HIP_MEMORY_SCOPE_AGENT);
    if ((REPMASK) & 16384) { for (int i = 0; i < 10; ++i) xcd_barrier(bar); }
    const bool defer_w4 = (gridDim.x == 256) && lo == 0 && hi > 7;
    const bool defer_w23 = defer_w4;
    if (IN(0)) REP(0) { phase_p0(a, lds, defer_w4, defer_w23); __syncthreads(); }
    SEAM(0);
    bool colo = false;
    if ((gridDim.x == 256) && lo == 0 && hi > 5) {
        unsigned seen = 0u; colo = true;
#pragma unroll
        for (int g8 = 0; g8 < 8; ++g8) { const unsigned mk = xb_ld(&ctlw[XL_MASK(g8)]); colo = colo && mk != 0u && (mk & (mk - 1u)) == 0u && (seen & mk) == 0u; seen |= mk; }
        colo = __builtin_amdgcn_readfirstlane(colo ? 1 : 0) != 0;
    }
#define SEAM_L(k) do { if (IN(k) && IN((k) + 1)) { if (colo) local_barrier(ctlw, blockIdx.x & 7); else xcd_barrier(bar); } } while (0)
    if (defer_w23 && IN(1) && !(blockIdx.x & 1)) { phase_w23(a, lds); __syncthreads(); }
    if (IN(1)) REP(1) { pg8::Gemm g{(const bf16*)(ws + WS_H), (const bf16*)(ws + WS_W1), M, N1, DM}; pg8::StaticOrder S; S.init(M, N1, gridDim.x, blockIdx.x);
        pg8::EpiProj E{(bf16*)(ws + WS_PROJ)}; pg8::gemm_phase<pg8::EpiProj, pg8::StaticOrder, true, true>(lds, g, S, E); }
    if (defer_w23 && IN(1) && (blockIdx.x & 1)) { __syncthreads(); phase_w23(a, lds); __syncthreads(); }
    SEAM_L(1);
    const bool att_first = colo && (blockIdx.x & 1) && IN(2) && IN(4);
    if (att_first) { phase_attn(a, lds); __syncthreads(); }
    if (IN(2)) REP(2) { phase_ssd_s1(a, lds); }
    SEAM_L(2);
    if (IN(3)) REP(3) { phase_ssd_s2(a); }
    SEAM_L(3);
    if (IN(4)) { REP(10) { phase_ssd_s3(a, lds); __syncthreads(); } if (!att_first) REP(11) { phase_attn(a, lds); __syncthreads(); } }
    SEAM_L(4);
    if (defer_w23 && IN(5)) {
        if (threadIdx.x == 0) { unsigned sp = 0u; while (xb_ld(&ctlw[3744]) < (unsigned)(gridDim.x * NWAVES)) { __builtin_amdgcn_s_sleep(2); if (++sp > (1u << 22)) break; }
            __builtin_amdgcn_fence(__ATOMIC_ACQUIRE, "agent"); asm volatile("s_waitcnt vmcnt(0)" ::: "memory"); }
        __syncthreads();
    }
    const bool fuse_n1 = (gridDim.x == 256) && lo <= 5 && hi > 7;
    if (IN(5)) { pg8::Gemm g{(const bf16*)(ws + WS_H), (const bf16*)(ws + WS_W2), M, DM, DM}; pg8::StaticOrder S; S.init(M, DM, gridDim.x, blockIdx.x);
        if (fuse_n1) {
            pg8::EpiRmsResRms E{a.x, (bf16*)(ws + WS_CS), (bf16*)(ws + WS_PB), a.post_mix_gain, a.pre_ffn_gain, (float*)(ws + WS_CTL + 65536 + 262144), (unsigned*)(ws + WS_CTL + 32768), (float*)(ws + WS_CTL + 65536 + 524288), (unsigned*)(ws + WS_CTL + 49152)};
            pg8::gemm_phase<pg8::EpiRmsResRms, pg8::StaticOrder, false, true>(lds, g, S, E);
        } else {
            pg8::EpiBf16 E{(bf16*)(ws + WS_PROJ), DM}; pg8::gemm_phase<pg8::EpiBf16, pg8::StaticOrder, true, true>(lds, g, S, E);
        }
    }
    if (!fuse_n1) {
    SEAM(5);
    if (IN(6)) REP(6) { phase_norm1(a); }
    }
    SEAM_L(6);
    if (IN(7)) REP(7) { pg8::Gemm g{(const bf16*)(ws + (fuse_n1 ? WS_PB : WS_H)), (const bf16*)(ws + WS_W3), M, N3, DM}; pg8::StaticOrder S; S.init(M, N3, gridDim.x, blockIdx.x);
        pg8::EpiSwiglu E{(bf16*)(ws + WS_PROJ)}; pg8::gemm_phase<pg8::EpiSwiglu, pg8::StaticOrder, true, true>(lds, g, S, E);
        if (defer_w4) { __syncthreads(); phase_w4(a, lds); } }
    SEAM(7);
    if (IN(8)) { pg8::Gemm g{(const bf16*)(ws + WS_PROJ), (const bf16*)(ws + WS_W4), M, DM, DFF, (size_t)1 << 20}; pg8::StaticOrder S; S.init(M, DM, gridDim.x, blockIdx.x);
        if (gridDim.x == 256 && hi > 9 && lo <= 5) {
            pg8::EpiRmsRes E{(const bf16*)(ws + WS_CS), a.out, a.post_ffn_gain, (float*)(ws + WS_CTL + 65536), (unsigned*)(ws + WS_CTL + 16384)};
            pg8::gemm_phase<pg8::EpiRmsRes, pg8::StaticOrder, false, true>(lds, g, S, E);
        } else {
            pg8::EpiBf16 E{(bf16*)(ws + WS_CS), DM}; pg8::gemm_phase<pg8::EpiBf16, pg8::StaticOrder, true, true>(lds, g, S, E);
            SEAM(8);
            if (IN(9)) { phase_norm2(a); }
        }
    }
#undef IN
#undef SEAM
}

#ifndef N_LAUNCHES
#define N_LAUNCHES 1
#endif
extern "C" void kernel_launch(void* const* d_in, const int* in_sizes, int n_in, void* d_out, int out_size, void* d_ws, size_t ws_size, hipStream_t stream) {
    static int grid = 0;
    if (grid == 0) {
        if (n_in != 17 || out_size != M * DM || ws_size < WS_END) { fprintf(stderr, "kernel_launch: unexpected problem (n_in %d out %d ws %zu)\n", n_in, out_size, ws_size); grid = -1; return; }
        int dev = 0, cus = 0, per_cu = 0;
        hipGetDevice(&dev); hipDeviceGetAttribute(&cus, hipDeviceAttributeMultiprocessorCount, dev);
        if (hipFuncSetAttribute((const void*)fwd, hipFuncAttributeMaxDynamicSharedMemorySize, LDS_BYTES) != hipSuccess) { fprintf(stderr, "kernel_launch: hipFuncSetAttribute failed\n"); grid = -1; return; }
        if (hipOccupancyMaxActiveBlocksPerMultiprocessor(&per_cu, (const void*)fwd, NTHR, LDS_BYTES) != hipSuccess || per_cu < 1) { fprintf(stderr, "kernel_launch: occupancy query says %d blocks per CU\n", per_cu); per_cu = 1; }
        (void)hipGetLastError();
        grid = cus;
    }
    if (grid < 0) return;
    if (hipMemsetAsync((char*)d_ws + WS_CTL, 0, 65536, stream) != hipSuccess) { fprintf(stderr, "kernel_launch: memset failed\n"); return; }
    Args a{};
    const float** ap = (const float**)&a;
    for (int i = 0; i < 17; ++i) ap[i] = (const float*)d_in[i];
    a.out = (float*)d_out; a.ws = (unsigned char*)d_ws;
#if N_LAUNCHES == 1
    a.ph_lo = 0; a.ph_hi = NPHASE;
    void* args[] = {&a};
    hipError_t e = hipLaunchCooperativeKernel((const void*)fwd, dim3(grid), dim3(NTHR), args, LDS_BYTES, stream);
    if (e != hipSuccess) fprintf(stderr, "cooperative launch failed: %s (grid %d)\n", hipGetErrorString(e), grid);
#else
    for (int ph = 0; ph < NPHASE; ++ph) { a.ph_lo = ph; a.ph_hi = ph + 1; hipLaunchKernelGGL(fwd, dim3(grid), dim3(NTHR), LDS_BYTES, stream, a); }
#endif
}
```

```cpp
#define REPMASK 0
#include <hip/hip_runtime.h>
#include <hip/hip_cooperative_groups.h>
#include <cstdio>
#include <cstdint>
namespace cg = cooperative_groups;
#ifndef REPMASK
#define REPMASK 0
#endif

constexpr int NB = 8, SEQ = 2048, DM = 1024, M = NB * SEQ;
constexpr int DIN = 3080;
constexpr int N1 = 3072;
constexpr int PZ = 0, PX = 512, PQ = 1536, PK = 2048, PV = 2560;
constexpr int DFF = 2816, N3 = 2 * DFF;
constexpr int NH = 8, HD = 64, NST = 128, CH = 64, NCH = SEQ / CH;
constexpr float EPS = 1e-6f;
constexpr float LOG2E = 1.4426950408889634f;
constexpr float QSCALE = 0.125f * LOG2E;

constexpr size_t MiB = 1u << 20;
constexpr size_t WS_W1 = 0, WS_W2 = 6 * MiB, WS_W3 = 8 * MiB, WS_W4 = 19 * MiB;
constexpr size_t WS_DT = 25 * MiB;
constexpr size_t WS_CD = 25 * MiB + 512 * 1024;
constexpr size_t WS_H = 26 * MiB;
constexpr size_t WS_PROJ = 58 * MiB;
constexpr size_t WS_CS = 154 * MiB;
constexpr size_t WS_CTL = 218 * MiB;
constexpr size_t WS_PB = 219 * MiB;
constexpr size_t WS_END = 251 * MiB;

constexpr int LDS_BYTES = 147456;
constexpr int NTHR = 512, NWAVES = 8;

#define LAS __attribute__((address_space(3)))
typedef unsigned short bf16;
typedef unsigned v4u __attribute__((ext_vector_type(4)));
typedef unsigned v2u __attribute__((ext_vector_type(2)));
typedef float v4f __attribute__((ext_vector_type(4)));
typedef float f32x16 __attribute__((ext_vector_type(16)));

__device__ __forceinline__ unsigned f2bf(float f) { unsigned u = __builtin_bit_cast(unsigned, f); return (u + 0x7fffu + ((u >> 16) & 1u)) >> 16; }
typedef float f32x2_t __attribute__((ext_vector_type(2)));
typedef __bf16 bf16x2_t __attribute__((ext_vector_type(2)));
__device__ __forceinline__ unsigned cvtpk(float lo, float hi) { f32x2_t v = {lo, hi}; bf16x2_t b = __builtin_convertvector(v, bf16x2_t); return __builtin_bit_cast(unsigned, b); }
__device__ __forceinline__ unsigned pk2(float lo, float hi) { return cvtpk(lo, hi); }
__device__ __forceinline__ void wt8(void* p, unsigned lo, unsigned hi) { __hip_atomic_store((unsigned long long*)p, (unsigned long long)lo | ((unsigned long long)hi << 32), __ATOMIC_RELAXED, __HIP_MEMORY_SCOPE_AGENT); }
__device__ __forceinline__ __amdgpu_buffer_rsrc_t wt_rsrc(void* base, unsigned bytes) { return __builtin_amdgcn_make_buffer_rsrc(base, 0, (int)bytes, 0x00020000); }
__device__ __forceinline__ void wt16(__amdgpu_buffer_rsrc_t r, unsigned byte_off, v4u v) { __builtin_amdgcn_raw_buffer_store_b128(v, r, (int)byte_off, 0, 16); }
__device__ __forceinline__ float bf2f(unsigned b) { return __builtin_bit_cast(float, b << 16); }
__device__ __forceinline__ float bflo(unsigned w) { return __builtin_bit_cast(float, w << 16); }
__device__ __forceinline__ float bfhi(unsigned w) { return __builtin_bit_cast(float, w & 0xffff0000u); }
__device__ __forceinline__ float wave_sum(float v) {
#pragma unroll
    for (int o = 1; o < 64; o <<= 1) v += __shfl_xor(v, o);
    return v;
}
__device__ __forceinline__ float siluf(float v) { return v / (1.f + __expf(-v)); }
__device__ __forceinline__ float silu_fast(float v) { return v * __builtin_amdgcn_rcpf(1.f + __builtin_amdgcn_exp2f(-LOG2E * v)); }
__device__ __forceinline__ float softplusf(float v) { return fmaxf(v, 0.f) + log1pf(__expf(-fabsf(v))); }

namespace pg8 {
#define PG8_LAS __attribute__((address_space(3)))
typedef unsigned short bf16_t;
typedef short bf16x8 __attribute__((ext_vector_type(8)));
typedef float f32x4 __attribute__((ext_vector_type(4)));
typedef unsigned u32x4 __attribute__((ext_vector_type(4)));
constexpr int BM = 256, BK = 64, HALF = 128, HTB = HALF * BK * 2  , STAGE_BYTES = 8 * HTB, NXCD = 8, WGM = 8;

__host__ __device__ __forceinline__ int lds_byte(int r, int c) { const int st = (r >> 4) * 2 + (c >> 5), rr = r & 15, cc = c & 31, ob = rr * 64 + cc * 2; return st * 1024 + (ob ^ (((ob >> 9) & 1) << 5)); }
__host__ __device__ __forceinline__ void stage_rc(int b, int& R, int& C) { const int st = b / 1024, sb = b % 1024, swz = sb ^ (((sb >> 9) & 1) << 5); R = (st >> 1) * 16 + swz / 64; C = (st & 1) * 32 + (swz % 64) / 2; }
__host__ __device__ __forceinline__ int perm32(int rho) { const int n = rho >> 4, i = rho & 15; return 8 * (i >> 2) + 4 * n + (i & 3); }

struct Unit { int pm, pn; };
struct Gemm { const bf16_t* A; const bf16_t* Bt; int M, N, K; size_t agap; };

struct StaticOrder {
    int nM, nN, nwg, G, c;
    __host__ __device__ void init(int M, int N, int G_, int c_) { nM = M / BM; nN = N / BM; nwg = nM * nN; G = G_; c = c_; }
    __host__ __device__ bool next(int i, Unit& u) const {
        const long L = (long)i * G + c; if (L >= nwg) return false;
        int wgid = (int)L; { const int q = nwg / NXCD, r = nwg % NXCD, xcd = wgid % NXCD, off = wgid / NXCD; wgid = (xcd < r ? xcd * (q + 1) : r * (q + 1) + (xcd - r) * q) + off; }
        const int nig = WGM * nN, gid = wgid / nig, fm = gid * WGM, gsz = (nM - fm) < WGM ? (nM - fm) : WGM;
        u.pm = fm + ((wgid % nig) % gsz); u.pn = (wgid % nig) / gsz; return true;
    }
    __device__ __forceinline__ void a_ready(const Unit&) const {}
    __device__ __forceinline__ void done(const Unit&) const {}
};

__device__ __forceinline__ unsigned cvt_pk_bf16(float lo, float hi) { unsigned r; asm volatile("v_cvt_pk_bf16_f32 %0, %1, %2" : "=v"(r) : "v"(lo), "v"(hi)); return r; }
template <class Epi, class Sched, bool ALIGN_EPI = false, bool SP2 = false>
__device__ __forceinline__ void gemm_phase(PG8_LAS unsigned char* lds, const Gemm g, const Sched& S, const Epi& E) {
    const int tid = threadIdx.x, wid = __builtin_amdgcn_readfirstlane(tid >> 6), lane = tid & 63, wr = wid >> 2, wc = wid & 3, fr = lane & 15, fq = lane >> 4;
    const int K = g.K, nt = K / BK;
    unsigned voffA[2], voffB[2];
#pragma unroll
    for (int i = 0; i < 2; ++i) { int R, C; stage_rc(tid * 16 + i * 8192, R, C); const int Rb = Epi::PERM ? ((R & ~31) + perm32(R & 31)) : R;
        voffA[i] = (unsigned)(R * K + C) * 2u; voffB[i] = (unsigned)(Rb * K + C) * 2u; }
    const size_t kstep = (size_t)(BK * 2);
    const size_t hstep = (size_t)HALF * K * 2;
    const size_t tstep = 2 * hstep;
    const unsigned ldsw = (unsigned)wid * 1024u;
    const int aoff = lds_byte(wr * 64 + fr, fq * 8), boff = lds_byte(wc * 32 + fr, fq * 8);
#define PG8_SA(b, h) (((b) * 2 + (h)) * HTB)
#define PG8_SB(b, h) ((4 + (b) * 2 + (h)) * HTB)
#define PG8_STAGE(bufoff, gbase, voff) do { _Pragma("unroll") for (int _i = 0; _i < 2; ++_i) \
        __builtin_amdgcn_global_load_lds((const unsigned*)((const char*)(gbase) + (voff)[_i]), (PG8_LAS unsigned*)(lds + (bufoff) + ldsw + _i * 8192), 16, 0, 0); } while (0)
#define PG8_LDA(dst, b, h) do { _Pragma("unroll") for (int m = 0; m < 4; ++m) _Pragma("unroll") for (int k = 0; k < 2; ++k) dst[m][k] = *(const PG8_LAS bf16x8*)(lds + PG8_SA(b, h) + aoff + m * 2048 + k * 1024); } while (0)
#define PG8_LDB(dst, b, h) do { _Pragma("unroll") for (int n = 0; n < 2; ++n) _Pragma("unroll") for (int k = 0; k < 2; ++k) dst[n][k] = *(const PG8_LAS bf16x8*)(lds + PG8_SB(b, h) + boff + n * 2048 + k * 1024); } while (0)
#define PG8_MMA(ai, bj, At, Bt) do { __builtin_amdgcn_s_setprio(1); _Pragma("unroll") for (int m = 0; m < 4; ++m) _Pragma("unroll") for (int n = 0; n < 2; ++n) _Pragma("unroll") for (int k = 0; k < 2; ++k) \
        acc[ai][bj][m][n] = __builtin_amdgcn_mfma_f32_16x16x32_bf16(Bt[n][k], At[m][k], acc[ai][bj][m][n], 0, 0, 0); __builtin_amdgcn_s_setprio(0); } while (0)
#define PG8_WAIT_V(n) asm volatile("s_waitcnt vmcnt(" #n ")" ::: "memory")
#define PG8_WAIT_L(n) asm volatile("s_waitcnt lgkmcnt(" #n ")" ::: "memory")
#define PG8_BAR __builtin_amdgcn_s_barrier()
#define PG8_SCHED __builtin_amdgcn_sched_barrier(0)
    Unit cur, nxt; int ui = 0;
    if (!S.next(0, cur)) return;
    f32x4 acc[2][2][4][2];
#pragma unroll
    for (int a = 0; a < 2; ++a)
#pragma unroll
        for (int b = 0; b < 2; ++b)
#pragma unroll
            for (int m = 0; m < 4; ++m)
#pragma unroll
                for (int n = 0; n < 2; ++n) acc[a][b][m][n] = (f32x4){0.f, 0.f, 0.f, 0.f};
    bf16x8 At[4][2], B0[2][2], B1[2][2];
    const char* cA = (const char*)g.A + (size_t)cur.pm * tstep + (size_t)(cur.pm >> 3) * g.agap; const char* cB = (const char*)g.Bt + (size_t)cur.pn * tstep;
    S.a_ready(cur);
    if constexpr (SP2) {
        PG8_STAGE(PG8_SB(0, 0), cB, voffB); PG8_STAGE(PG8_SB(0, 1), cB + hstep, voffB); PG8_STAGE(PG8_SA(0, 0), cA, voffA); PG8_STAGE(PG8_SA(0, 1), cA + hstep, voffA);
        if (wr == 1) PG8_BAR;
        PG8_WAIT_V(2); PG8_BAR;
        PG8_STAGE(PG8_SB(1, 0), cB + kstep, voffB); PG8_STAGE(PG8_SA(1, 0), cA + kstep, voffA); PG8_STAGE(PG8_SB(1, 1), cB + hstep + kstep, voffB);
        PG8_WAIT_V(6); PG8_BAR;
    } else {
        PG8_STAGE(PG8_SB(0, 0), cB, voffB); PG8_STAGE(PG8_SA(0, 0), cA, voffA); PG8_STAGE(PG8_SB(0, 1), cB + hstep, voffB); PG8_STAGE(PG8_SA(0, 1), cA + hstep, voffA);
        if (wr == 1) PG8_BAR;
        PG8_WAIT_V(4); PG8_BAR;
        PG8_STAGE(PG8_SB(1, 0), cB + kstep, voffB); PG8_STAGE(PG8_SA(1, 0), cA + kstep, voffA); PG8_STAGE(PG8_SB(1, 1), cB + hstep + kstep, voffB);
        PG8_WAIT_V(6); PG8_BAR;
    }
    for (;;) {
        const bool has_next = S.next(ui + 1, nxt);
        const char* nA = has_next ? (const char*)g.A + (size_t)nxt.pm * tstep + (size_t)(nxt.pm >> 3) * g.agap : cA; const char* nB = has_next ? (const char*)g.Bt + (size_t)nxt.pn * tstep : cB;
        for (int t = 0; t < nt; t += 2) {
            const bool last = (t == nt - 2);
            const char* a1 = cA + (size_t)(t + 1) * kstep;
            const char* a2 = last ? nA : cA + (size_t)(t + 2) * kstep; const char* b2 = last ? nB : cB + (size_t)(t + 2) * kstep;
            const char* a3 = a2 + kstep; const char* b3 = b2 + kstep;
            if (last && has_next) S.a_ready(nxt);
            if constexpr (SP2) {
            PG8_LDB(B0, 0, 0); PG8_LDB(B1, 0, 1); PG8_SCHED; PG8_LDA(At, 0, 0); PG8_STAGE(PG8_SA(1, 1), a1 + hstep, voffA);
            PG8_WAIT_V(8); PG8_WAIT_L(0); PG8_BAR; PG8_MMA(0, 0, At, B0); PG8_MMA(0, 1, At, B1); PG8_BAR; PG8_SCHED;
            PG8_LDA(At, 0, 1); PG8_STAGE(PG8_SB(0, 0), b2, voffB); PG8_STAGE(PG8_SB(0, 1), b2 + hstep, voffB); PG8_STAGE(PG8_SA(0, 0), a2, voffA);
            PG8_WAIT_V(8); PG8_WAIT_L(0); PG8_BAR; PG8_MMA(1, 0, At, B0); PG8_MMA(1, 1, At, B1); PG8_BAR; PG8_SCHED;
            PG8_LDB(B0, 1, 0); PG8_LDB(B1, 1, 1); PG8_SCHED; PG8_LDA(At, 1, 0); PG8_STAGE(PG8_SA(0, 1), a2 + hstep, voffA);
            PG8_WAIT_V(8); PG8_WAIT_L(0); PG8_BAR; PG8_MMA(0, 0, At, B0); PG8_MMA(0, 1, At, B1); PG8_BAR; PG8_SCHED;
            PG8_LDA(At, 1, 1); PG8_STAGE(PG8_SB(1, 0), b3, voffB); PG8_STAGE(PG8_SB(1, 1), b3 + hstep, voffB); PG8_STAGE(PG8_SA(1, 0), a3, voffA);
            PG8_WAIT_V(8); PG8_WAIT_L(0); PG8_BAR; PG8_MMA(1, 0, At, B0); PG8_MMA(1, 1, At, B1); PG8_BAR; PG8_SCHED;
            } else {
            PG8_LDB(B0, 0, 0); PG8_SCHED; PG8_LDA(At, 0, 0); PG8_STAGE(PG8_SA(1, 1), a1 + hstep, voffA);
            PG8_WAIT_L(8); PG8_BAR; PG8_WAIT_L(0); PG8_MMA(0, 0, At, B0); PG8_BAR; PG8_SCHED;
            PG8_LDB(B1, 0, 1); PG8_STAGE(PG8_SB(0, 0), b2, voffB);
            PG8_BAR; PG8_WAIT_L(0); PG8_MMA(0, 1, At, B1); PG8_BAR;
            PG8_LDA(At, 0, 1); PG8_STAGE(PG8_SA(0, 0), a2, voffA);
            PG8_BAR; PG8_WAIT_L(0); PG8_MMA(1, 0, At, B0); PG8_BAR; PG8_SCHED;
            PG8_STAGE(PG8_SB(0, 1), b2 + hstep, voffB);
            PG8_WAIT_V(6); PG8_BAR; PG8_MMA(1, 1, At, B1); PG8_BAR;
            PG8_LDB(B0, 1, 0); PG8_SCHED; PG8_LDA(At, 1, 0); PG8_STAGE(PG8_SA(0, 1), a2 + hstep, voffA);
            PG8_WAIT_L(8); PG8_BAR; PG8_WAIT_L(0); PG8_MMA(0, 0, At, B0); PG8_BAR; PG8_SCHED;
            PG8_LDB(B1, 1, 1); PG8_STAGE(PG8_SB(1, 0), b3, voffB);
            PG8_BAR; PG8_WAIT_L(0); PG8_MMA(0, 1, At, B1); PG8_BAR;
            PG8_LDA(At, 1, 1); PG8_STAGE(PG8_SA(1, 0), a3, voffA);
            PG8_BAR; PG8_WAIT_L(0); PG8_MMA(1, 0, At, B0); PG8_BAR; PG8_SCHED;
            PG8_STAGE(PG8_SB(1, 1), b3 + hstep, voffB);
            PG8_WAIT_V(6); PG8_BAR; PG8_MMA(1, 1, At, B1); PG8_BAR;
            }
        }
        if constexpr (ALIGN_EPI) { if (wr == 0) PG8_BAR; }
        if constexpr (!Epi::AFTER_DRAIN) { E(acc, cur, wr, wc, fr, fq); S.done(cur); }
        if (!has_next) break;
#pragma unroll
        for (int a = 0; a < 2; ++a)
#pragma unroll
            for (int b = 0; b < 2; ++b)
#pragma unroll
                for (int m = 0; m < 4; ++m)
#pragma unroll
                    for (int n = 0; n < 2; ++n) acc[a][b][m][n] = (f32x4){0.f, 0.f, 0.f, 0.f};
        cur = nxt; cA = nA; cB = nB; ++ui;
        if constexpr (ALIGN_EPI) { if (wr == 1) PG8_BAR; }
    }
    PG8_WAIT_V(0);
    if constexpr (!ALIGN_EPI) { if (wr == 0) PG8_BAR; }
    PG8_BAR;
    if constexpr (Epi::AFTER_DRAIN) { E.fused(acc, cur, wr, wc, fr, fq, lds, wid, lane); S.done(cur); }
#undef PG8_SA
#undef PG8_SB
#undef PG8_STAGE
#undef PG8_LDA
#undef PG8_LDB
#undef PG8_MMA
#undef PG8_WAIT_V
#undef PG8_WAIT_L
#undef PG8_BAR
#undef PG8_SCHED
}
}

namespace pg8 {
struct EpiProj {
    static constexpr bool PERM = true, AFTER_DRAIN = false;
    bf16_t* O;
    __device__ __forceinline__ void operator()(const f32x4 (&acc)[2][2][4][2], const Unit& u, int wr, int wc, int fr, int fq) const {
        const int row0 = u.pm * BM + wr * 64 + fr, col0 = u.pn * BM + wc * 32 + 8 * fq;
        const float sc = (u.pn == 6 || u.pn == 7) ? QSCALE : 1.f;
        const __amdgpu_buffer_rsrc_t rs = wt_rsrc(O, (unsigned)((size_t)16384 * N1 * 2));
#pragma unroll
        for (int ai = 0; ai < 2; ++ai)
#pragma unroll
            for (int m = 0; m < 4; ++m) { const unsigned rowb = (unsigned)(((size_t)(row0 + ai * HALF + m * 16) * N1 + col0) * 2);
#pragma unroll
                for (int bj = 0; bj < 2; ++bj) { const f32x4 v0 = acc[ai][bj][m][0] * sc, v1 = acc[ai][bj][m][1] * sc;
                    u32x4 w; w.x = cvt_pk_bf16(v0[0], v0[1]); w.y = cvt_pk_bf16(v0[2], v0[3]); w.z = cvt_pk_bf16(v1[0], v1[1]); w.w = cvt_pk_bf16(v1[2], v1[3]);
                    wt16(rs, rowb + bj * HALF * 2, w); } }
    }
};
struct EpiBf16 {
    static constexpr bool PERM = true, AFTER_DRAIN = false;
    bf16_t* O; int ldc;
    __device__ __forceinline__ void operator()(const f32x4 (&acc)[2][2][4][2], const Unit& u, int wr, int wc, int fr, int fq) const {
        const int row0 = u.pm * BM + wr * 64 + fr, col0 = u.pn * BM + wc * 32 + 8 * fq;
#pragma unroll
        for (int ai = 0; ai < 2; ++ai)
#pragma unroll
            for (int m = 0; m < 4; ++m) { bf16_t* rowp = O + (size_t)(row0 + ai * HALF + m * 16) * ldc + col0;
#pragma unroll
                for (int bj = 0; bj < 2; ++bj) { const f32x4 v0 = acc[ai][bj][m][0], v1 = acc[ai][bj][m][1];
                    u32x4 w; w.x = cvt_pk_bf16(v0[0], v0[1]); w.y = cvt_pk_bf16(v0[2], v0[3]); w.z = cvt_pk_bf16(v1[0], v1[1]); w.w = cvt_pk_bf16(v1[2], v1[3]);
                    *(u32x4*)(rowp + bj * HALF) = w; } }
    }
};
__device__ __forceinline__ void rms_exchange(const f32x4 (&v)[2][2][4][2], const Unit& u, int wr, int wc, int fr, int fq, PG8_LAS unsigned char* lds, int wid, int lane, float* xbuf, unsigned* cnt) {
    PG8_LAS float* P = (PG8_LAS float*)lds;
    PG8_LAS float* S = (PG8_LAS float*)(lds + 4096);
#pragma unroll
    for (int ai = 0; ai < 2; ++ai)
#pragma unroll
        for (int m = 0; m < 4; ++m) {
            float s = 0.f;
#pragma unroll
            for (int bj = 0; bj < 2; ++bj)
#pragma unroll
                for (int n = 0; n < 2; ++n) { const f32x4 x = v[ai][bj][m][n]; s += (x[0] * x[0] + x[1] * x[1]) + (x[2] * x[2] + x[3] * x[3]); }
            s += __shfl_xor(s, 16); s += __shfl_xor(s, 32);
            if (fq == 0) P[(ai * HALF + wr * 64 + m * 16 + fr) * 4 + wc] = s;
        }
    asm volatile("s_waitcnt lgkmcnt(0)" ::: "memory"); __builtin_amdgcn_s_barrier(); asm volatile("" ::: "memory");
    const int row = wid * 32 + (lane & 31);
    if (lane < 32) {
        const float tot = (P[row * 4 + 0] + P[row * 4 + 1]) + (P[row * 4 + 2] + P[row * 4 + 3]);
        __hip_atomic_store((unsigned*)xbuf + (size_t)(u.pm * BM + row) * 4 + u.pn, __builtin_bit_cast(unsigned, tot), __ATOMIC_RELAXED, __HIP_MEMORY_SCOPE_AGENT);
    }
    asm volatile("s_waitcnt vmcnt(0)" ::: "memory");
    if (lane == 0) __hip_atomic_fetch_add(cnt + 64 * u.pm, 1u, __ATOMIC_RELAXED, __HIP_MEMORY_SCOPE_AGENT);
    if (wid == 0) {
        unsigned sp = 0u;
        while ((unsigned)__builtin_amdgcn_readfirstlane(__hip_atomic_load(cnt + 64 * u.pm, __ATOMIC_RELAXED, __HIP_MEMORY_SCOPE_AGENT)) < 32u) { __builtin_amdgcn_s_sleep(2); if (++sp > (1u << 22)) break; }
        __builtin_amdgcn_fence(__ATOMIC_ACQUIRE, "agent");
    }
    asm volatile("s_waitcnt vmcnt(0) lgkmcnt(0)" ::: "memory"); __builtin_amdgcn_s_barrier(); asm volatile("" ::: "memory");
    if (lane < 32) {
        const unsigned* slot = (const unsigned*)xbuf + (size_t)(u.pm * BM + row) * 4; float q = 0.f;
#pragma unroll
        for (int t = 0; t < 4; ++t) q += __builtin_bit_cast(float, __hip_atomic_load(slot + t, __ATOMIC_RELAXED, __HIP_MEMORY_SCOPE_AGENT));
        S[row] = rsqrtf(q * (1.f / 1024.f) + 1e-6f);
    }
    asm volatile("s_waitcnt vmcnt(0) lgkmcnt(0)" ::: "memory"); __builtin_amdgcn_s_barrier(); asm volatile("" ::: "memory");
}
struct EpiRmsRes {
    static constexpr bool PERM = false, AFTER_DRAIN = true;
    const bf16_t* x1b; float* out; const float* gain; float* xbuf; unsigned* cnt;
    __device__ __forceinline__ void fused(f32x4 (&acc)[2][2][4][2], const Unit& u, int wr, int wc, int fr, int fq, PG8_LAS unsigned char* lds, int wid, int lane) const {
        typedef unsigned u32x2v __attribute__((ext_vector_type(2)));
        const PG8_LAS float* S = (const PG8_LAS float*)(lds + 4096);
        const int col0 = u.pn * BM + wc * 32 + 4 * fq;
        u32x2v pre[2][4][2][2];
#pragma unroll
        for (int ai = 0; ai < 2; ++ai)
#pragma unroll
            for (int m = 0; m < 4; ++m) { const size_t off = (size_t)(u.pm * BM + ai * HALF + wr * 64 + m * 16 + fr) * 1024 + col0;
#pragma unroll
                for (int bj = 0; bj < 2; ++bj)
#pragma unroll
                    for (int n = 0; n < 2; ++n) pre[ai][m][bj][n] = *(const u32x2v*)(x1b + off + bj * HALF + n * 16); }
        rms_exchange(acc, u, wr, wc, fr, fq, lds, wid, lane, xbuf, cnt);
        f32x4 gv[2][2];
#pragma unroll
        for (int bj = 0; bj < 2; ++bj)
#pragma unroll
            for (int n = 0; n < 2; ++n) gv[bj][n] = *(const f32x4*)(gain + col0 + bj * HALF + n * 16);
#pragma unroll
        for (int ai = 0; ai < 2; ++ai)
#pragma unroll
            for (int m = 0; m < 4; ++m) { const int r = ai * HALF + wr * 64 + m * 16 + fr; const float rs = S[r]; const size_t off = (size_t)(u.pm * BM + r) * 1024 + col0;
#pragma unroll
                for (int bj = 0; bj < 2; ++bj)
#pragma unroll
                    for (int n = 0; n < 2; ++n) { const u32x2v pv = pre[ai][m][bj][n];
                        const f32x4 bs = {__builtin_bit_cast(float, pv.x << 16), __builtin_bit_cast(float, pv.x & 0xffff0000u), __builtin_bit_cast(float, pv.y << 16), __builtin_bit_cast(float, pv.y & 0xffff0000u)};
                        *(f32x4*)(out + off + bj * HALF + n * 16) = bs + acc[ai][bj][m][n] * rs * gv[bj][n]; } }
    }
};
struct EpiRmsResRms {
    static constexpr bool PERM = false, AFTER_DRAIN = true;
    const float* x; bf16_t* x1b; bf16_t* h2; const float* g1; const float* g2; float* xbuf1; unsigned* cnt1; float* xbuf2; unsigned* cnt2;
    __device__ __forceinline__ void fused(f32x4 (&acc)[2][2][4][2], const Unit& u, int wr, int wc, int fr, int fq, PG8_LAS unsigned char* lds, int wid, int lane) const {
        typedef unsigned u32x2v __attribute__((ext_vector_type(2)));
        const PG8_LAS float* S = (const PG8_LAS float*)(lds + 4096);
        const int col0 = u.pn * BM + wc * 32 + 4 * fq;
        rms_exchange(acc, u, wr, wc, fr, fq, lds, wid, lane, xbuf1, cnt1);
        {
            f32x4 gv[2][2];
#pragma unroll
            for (int bj = 0; bj < 2; ++bj)
#pragma unroll
                for (int n = 0; n < 2; ++n) gv[bj][n] = *(const f32x4*)(g1 + col0 + bj * HALF + n * 16);
#pragma unroll
            for (int ai = 0; ai < 2; ++ai)
#pragma unroll
                for (int m = 0; m < 4; ++m) { const int r = ai * HALF + wr * 64 + m * 16 + fr; const float rs = S[r]; const size_t off = (size_t)(u.pm * BM + r) * 1024 + col0;
#pragma unroll
                    for (int bj = 0; bj < 2; ++bj)
#pragma unroll
                        for (int n = 0; n < 2; ++n) { const f32x4 bs = *(const f32x4*)(x + off + bj * HALF + n * 16); acc[ai][bj][m][n] = bs + acc[ai][bj][m][n] * rs * gv[bj][n]; }
                    asm volatile("" : "+v"(acc[ai][0][m][0]), "+v"(acc[ai][0][m][1]), "+v"(acc[ai][1][m][0]), "+v"(acc[ai][1][m][1]));
                    if (m & 1) asm volatile("" ::: "memory"); }
        }
        rms_exchange(acc, u, wr, wc, fr, fq, lds, wid, lane, xbuf2, cnt2);
        f32x4 gv[2][2];
#pragma unroll
        for (int bj = 0; bj < 2; ++bj)
#pragma unroll
            for (int n = 0; n < 2; ++n) gv[bj][n] = *(const f32x4*)(g2 + col0 + bj * HALF + n * 16);
#pragma unroll
        for (int ai = 0; ai < 2; ++ai)
#pragma unroll
            for (int m = 0; m < 4; ++m) { const int r = ai * HALF + wr * 64 + m * 16 + fr; const float rs = S[r]; const size_t off = (size_t)(u.pm * BM + r) * 1024 + col0;
#pragma unroll
                for (int bj = 0; bj < 2; ++bj)
#pragma unroll
                    for (int n = 0; n < 2; ++n) { const f32x4 x1 = acc[ai][bj][m][n]; { u32x2v xw; xw.x = cvt_pk_bf16(x1[0], x1[1]); xw.y = cvt_pk_bf16(x1[2], x1[3]); *(u32x2v*)(x1b + off + bj * HALF + n * 16) = xw; }
                        const f32x4 o = x1 * rs * gv[bj][n]; u32x2v w; w.x = cvt_pk_bf16(o[0], o[1]); w.y = cvt_pk_bf16(o[2], o[3]); *(u32x2v*)(h2 + off + bj * HALF + n * 16) = w; }
                asm volatile("" ::: "memory"); }
    }
};
struct EpiF32 {
    static constexpr bool PERM = true, AFTER_DRAIN = false;
    float* O; int ldc;
    __device__ __forceinline__ void operator()(const f32x4 (&acc)[2][2][4][2], const Unit& u, int wr, int wc, int fr, int fq) const {
        const int row0 = u.pm * BM + wr * 64 + fr, col0 = u.pn * BM + wc * 32 + 8 * fq;
#pragma unroll
        for (int ai = 0; ai < 2; ++ai)
#pragma unroll
            for (int m = 0; m < 4; ++m) { float* rowp = O + (size_t)(row0 + ai * HALF + m * 16) * ldc + col0;
#pragma unroll
                for (int bj = 0; bj < 2; ++bj) { *(f32x4*)(rowp + bj * HALF) = acc[ai][bj][m][0]; *(f32x4*)(rowp + bj * HALF + 4) = acc[ai][bj][m][1]; } }
    }
};
struct EpiSwiglu {
    static constexpr bool PERM = true, AFTER_DRAIN = false;
    bf16_t* O;
    __device__ __forceinline__ void operator()(const f32x4 (&acc)[2][2][4][2], const Unit& u, int wr, int wc, int fr, int fq) const {
        const int row0 = u.pm * BM + wr * 64 + fr, col0 = u.pn * HALF + wc * 32 + 8 * fq;
        const __amdgpu_buffer_rsrc_t rs = wt_rsrc(O, 96u << 20);
        const unsigned bshift = (unsigned)(u.pm >> 3) << 20;
#pragma unroll
        for (int ai = 0; ai < 2; ++ai)
#pragma unroll
            for (int m = 0; m < 4; ++m) { const unsigned rowb = (unsigned)(((size_t)(row0 + ai * HALF + m * 16) * DFF + col0) * 2) + bshift;
                float r[8];
#pragma unroll
                for (int n = 0; n < 2; ++n)
#pragma unroll
                    for (int e = 0; e < 4; ++e) { const float g = acc[ai][0][m][n][e], up = acc[ai][1][m][n][e];
                        r[4 * n + e] = g * __builtin_amdgcn_rcpf(1.f + __expf(-g)) * up; }
                u32x4 w; w.x = cvt_pk_bf16(r[0], r[1]); w.y = cvt_pk_bf16(r[2], r[3]); w.z = cvt_pk_bf16(r[4], r[5]); w.w = cvt_pk_bf16(r[6], r[7]);
                wt16(rs, rowb, w); }
    }
};
}

struct Args {
    const float* x; const float* pre_mix_gain; const float* w_in; const float* conv_w; const float* conv_b; const float* dt_bias; const float* a_log; const float* d_skip;
    const float* ssd_norm_gain; const float* sb_norm_gain; const float* w_out; const float* post_mix_gain; const float* pre_ffn_gain; const float* w_gate; const float* w_up;
    const float* w_down; const float* post_ffn_gain; float* out; unsigned char* ws; int ph_lo, ph_hi;
};

__device__ __forceinline__ void transpose_item(const float* src, int ldw, bf16* dst, int K, LAS float* scr, int lane, __amdgpu_buffer_rsrc_t wr, const bf16* wbase) {
    float tv[32];
#pragma unroll
    for (int i = 0; i < 32; ++i) tv[i] = __builtin_nontemporal_load(src + (size_t)(2 * i + (lane >> 5)) * ldw + (lane & 31));
#pragma unroll
    for (int i = 0; i < 32; ++i) scr[(2 * i + (lane >> 5)) * 33 + (lane & 31)] = tv[i];
    asm volatile("s_waitcnt lgkmcnt(0)" ::: "memory");
    const int c = lane & 7;
#pragma unroll
    for (int j = 0; j < 4; ++j) { const int n = (lane >> 3) + 8 * j; const LAS float* s = scr + (8 * c) * 33 + n;
        v4u o; o.x = pk2(s[0 * 33], s[1 * 33]); o.y = pk2(s[2 * 33], s[3 * 33]); o.z = pk2(s[4 * 33], s[5 * 33]); o.w = pk2(s[6 * 33], s[7 * 33]);
        wt16(wr, (unsigned)((dst + (size_t)n * K + 8 * c - wbase) * 2), o); }
    asm volatile("s_waitcnt lgkmcnt(0)" ::: "memory");
}

__device__ __forceinline__ void phase_p0(const Args& a, LAS unsigned char* lds, bool defer_w4) {
    const int tid = threadIdx.x, lane = tid & 63, wave = tid >> 6;
    const int gw = blockIdx.x * NWAVES + wave, NGW = gridDim.x * NWAVES;
    unsigned char* ws = a.ws;
    LAS float* scr = (LAS float*)(lds + wave * 8704);
    LAS float* wdt = (LAS float*)(lds + 73728);
    for (int i = tid; i < 8192; i += NTHR) { const int hd = i & 7, k = i >> 3; wdt[hd * 1024 + k] = a.w_in[(size_t)k * DIN + 1536 + hd]; }
    __syncthreads();
    bf16* W1 = (bf16*)(ws + WS_W1); bf16* W2 = (bf16*)(ws + WS_W2); bf16* W3 = (bf16*)(ws + WS_W3); bf16* W4 = (bf16*)(ws + WS_W4);
    const __amdgpu_buffer_rsrc_t wrs = wt_rsrc(W1, 25u << 20);
    constexpr int I1 = 16 * 48, I2 = 16 * 32, I3 = 16 * 88, I4 = 44 * 32;
    const int NITEMS = 2 * I1 + I2 + 2 * I3 + (defer_w4 ? 0 : I4);
    for (int _rp = 0; _rp < 1 + (((REPMASK) >> 12) & 1); ++_rp)
    for (int it = gw; it < NITEMS; it += NGW) {
        int r = it;
        if (r < I1) { const int kb = r / 48, nb = r % 48; transpose_item(a.w_in + (size_t)(64 * kb) * DIN + 32 * nb, DIN, W1 + (size_t)(32 * nb) * 1024 + 64 * kb, 1024, scr, lane, wrs, W1); continue; } r -= I1;
        if (r < I1) { const int kb = r / 48, nb = r % 48; transpose_item(a.w_in + (size_t)(64 * kb) * DIN + 1544 + 32 * nb, DIN, W1 + (size_t)(1536 + 32 * nb) * 1024 + 64 * kb, 1024, scr, lane, wrs, W1); continue; } r -= I1;
        if (r < I2) { const int kb = r / 32, nb = r % 32; transpose_item(a.w_out + (size_t)(64 * kb) * 1024 + 32 * nb, 1024, W2 + (size_t)(32 * nb) * 1024 + 64 * kb, 1024, scr, lane, wrs, W1); continue; } r -= I2;
        if (r < I3) { const int kb = r / 88, nb = r % 88, n0 = 32 * nb; transpose_item(a.w_gate + (size_t)(64 * kb) * DFF + n0, DFF, W3 + (size_t)(256 * (n0 >> 7) + (n0 & 127)) * 1024 + 64 * kb, 1024, scr, lane, wrs, W1); continue; } r -= I3;
        if (r < I3) { const int kb = r / 88, nb = r % 88, n0 = 32 * nb; transpose_item(a.w_up + (size_t)(64 * kb) * DFF + n0, DFF, W3 + (size_t)(256 * (n0 >> 7) + 128 + (n0 & 127)) * 1024 + 64 * kb, 1024, scr, lane, wrs, W1); continue; } r -= I3;
        { const int kb = r / 32, nb = r % 32; transpose_item(a.w_down + (size_t)(64 * kb) * 1024 + 32 * nb, 1024, W4 + (size_t)(32 * nb) * DFF + 64 * kb, DFF, scr, lane, wrs, W1); }
    }
    bf16* H = (bf16*)(ws + WS_H); float* DT = (float*)(ws + WS_DT);
    const int hh = lane >> 5, b4 = (lane >> 4) & 1, b3 = (lane >> 3) & 1;
    v4f gpm[4];
#pragma unroll
    for (int j = 0; j < 4; ++j) gpm[j] = ((const v4f*)a.pre_mix_gain)[lane + 64 * j];
    v4f v[4], vn[4];
    if (gw < M) {
#pragma unroll
        for (int j = 0; j < 4; ++j) v[j] = __builtin_nontemporal_load((const v4f*)(a.x + (size_t)gw * DM) + lane + 64 * j);
    }
    for (int _rq = 0; _rq < 1 + (((REPMASK) >> 13) & 1); ++_rq)
    for (int m = gw; m < M; m += NGW) {
        const int mn = m + NGW < M ? m + NGW : gw;
        if (true) {
#pragma unroll
            for (int j = 0; j < 4; ++j) vn[j] = __builtin_nontemporal_load((const v4f*)(a.x + (size_t)mn * DM) + lane + 64 * j);
        }
        float s = 0.f;
#pragma unroll
        for (int j = 0; j < 4; ++j) s += (v[j].x * v[j].x + v[j].y * v[j].y) + (v[j].z * v[j].z + v[j].w * v[j].w);
        const float rstd = rsqrtf(wave_sum(s) * (1.f / DM) + EPS);
        float da[8];
#pragma unroll
        for (int hd = 0; hd < 8; ++hd) da[hd] = 0.f;
        unsigned long long* o8 = (unsigned long long*)(H + (size_t)m * DM) + lane;
#pragma unroll
        for (int j = 0; j < 4; ++j) {
            const v4f hv = v[j] * rstd * gpm[j];
            wt8(o8 + 64 * j, pk2(hv.x, hv.y), pk2(hv.z, hv.w));
#pragma unroll
            for (int hd = 0; hd < 8; ++hd) { const v4f w = *(const LAS v4f*)(wdt + hd * 1024 + 4 * lane + 256 * j); da[hd] += (hv.x * w.x + hv.y * w.y) + (hv.z * w.z + hv.w * w.w); }
        }
        float k4[4], k2[2], k1;
#pragma unroll
        for (int i = 0; i < 4; ++i) { const float keep = hh ? da[4 + i] : da[i], send = hh ? da[i] : da[4 + i]; k4[i] = keep + __shfl_xor(send, 32); }
#pragma unroll
        for (int i = 0; i < 2; ++i) { const float keep = b4 ? k4[2 + i] : k4[i], send = b4 ? k4[i] : k4[2 + i]; k2[i] = keep + __shfl_xor(send, 16); }
        { const float keep = b3 ? k2[1] : k2[0], send = b3 ? k2[0] : k2[1]; k1 = keep + __shfl_xor(send, 8); }
        k1 += __shfl_xor(k1, 4); k1 += __shfl_xor(k1, 2); k1 += __shfl_xor(k1, 1);
        if ((lane & 7) == 0) DT[(size_t)m * 8 + (lane >> 3)] = k1;
#pragma unroll
        for (int j = 0; j < 4; ++j) v[j] = vn[j];
    }
}

__device__ __forceinline__ void phase_w4(const Args& a, LAS unsigned char* lds) {
    if (blockIdx.x < 128) return;
    const int lane = threadIdx.x & 63, wave = threadIdx.x >> 6, gw = (blockIdx.x - 128) * NWAVES + wave, NGW = 128 * NWAVES;
    LAS float* scr = (LAS float*)(lds + wave * 8704);
    bf16* W1 = (bf16*)(a.ws + WS_W1); bf16* W4 = (bf16*)(a.ws + WS_W4);
    const __amdgpu_buffer_rsrc_t wrs = wt_rsrc(W1, 25u << 20);
    for (int r = gw; r < 44 * 32; r += NGW) { const int kb = r / 32, nb = r % 32; transpose_item(a.w_down + (size_t)(64 * kb) * 1024 + 32 * nb, 1024, W4 + (size_t)(32 * nb) * DFF + 64 * kb, DFF, scr, lane, wrs, W1); }
}

__device__ __forceinline__ void phase_conv_naive(const Args& a) {
    const bf16* PROJ = (const bf16*)(a.ws + WS_PROJ); float* XC = (float*)(a.ws + WS_CS);
    const size_t total = (size_t)M * 1024, stride = (size_t)gridDim.x * NTHR;
    for (size_t idx = (size_t)blockIdx.x * NTHR + threadIdx.x; idx < total; idx += stride) {
        const int m = (int)(idx >> 10), ch = (int)(idx & 1023), t = m & (SEQ - 1);
        float acc = a.conv_b[ch];
#pragma unroll
        for (int j = 0; j < 4; ++j) { const int tt = t - 3 + j; if (tt >= 0) acc += a.conv_w[j * 1024 + ch] * bf2f(PROJ[(size_t)(m - 3 + j) * N1 + PX + ch]); }
        XC[idx] = siluf(acc);
    }
}

__device__ __forceinline__ void phase_ssd_naive(const Args& a, LAS unsigned char* lds) {
    if (blockIdx.x >= 16) return;
    const int tid = threadIdx.x, lane = tid & 63, wave = tid >> 6;
    const int b = blockIdx.x >> 1, g = blockIdx.x & 1;
    const bool act = tid < 256;
    const int hl = (tid >> 6) & 3, p = tid & 63, h = 4 * g + hl;
    const bf16* PROJ = (const bf16*)(a.ws + WS_PROJ); const float* XC = (const float*)(a.ws + WS_CS); const float* DT = (const float*)(a.ws + WS_DT);
    bf16* YC = (bf16*)(a.ws + WS_H);
    LAS float* sBC = (LAS float*)lds; LAS float* red = (LAS float*)(lds + 1024);
    float st[128];
#pragma unroll
    for (int n = 0; n < 128; ++n) st[n] = 0.f;
    const float av = -__expf(a.a_log[h]), dtb = a.dt_bias[h], dsk = a.d_skip[h], gain = a.ssd_norm_gain[g * 256 + hl * 64 + p];
    for (int t = 0; t < SEQ; ++t) {
        const size_t m = (size_t)b * SEQ + t;
        if (act) sBC[tid] = XC[m * 1024 + (tid < 128 ? 512 + g * 128 + tid : 768 + g * 128 + (tid - 128))];
        __syncthreads();
        float y = 0.f;
        if (act) {
            const float dt = softplusf(DT[m * 8 + h] + dtb), dA = __expf(dt * av), xv = XC[m * 1024 + h * 64 + p], dx = dt * xv;
#pragma unroll
            for (int n = 0; n < 128; ++n) { st[n] = st[n] * dA + dx * sBC[n]; y += sBC[128 + n] * st[n]; }
            y += dsk * xv;
            y *= siluf(bf2f(PROJ[m * N1 + PZ + h * 64 + p]));
        }
        const float ss = wave_sum(y * y);
        if (lane == 0) red[wave] = ss;
        __syncthreads();
        const float tot = (red[0] + red[1]) + (red[2] + red[3]);
        if (act) YC[m * 1024 + h * 64 + p] = (bf16)f2bf(y * rsqrtf(tot * (1.f / 256.f) + EPS) * gain);
    }
}

__device__ __forceinline__ void phase_attn_naive(const Args& a, LAS unsigned char* lds) {
    const int tid = threadIdx.x;
    const bf16* PROJ = (const bf16*)(a.ws + WS_PROJ); bf16* YC = (bf16*)(a.ws + WS_H);
    LAS float* sK = (LAS float*)(lds + 4096); LAS float* sV = (LAS float*)(lds + 4096 + 16384);
    for (int unit = blockIdx.x; unit < 256; unit += gridDim.x) {
        const int b = unit >> 5, h = (unit >> 2) & 7, qb = unit & 3;
        const int t = qb * 512 + tid; const size_t m = (size_t)b * SEQ + t;
        float q[64], o[64];
#pragma unroll
        for (int d = 0; d < 64; ++d) { q[d] = bf2f(PROJ[m * N1 + PQ + h * 64 + d]); o[d] = 0.f; }
        float P = 1.f;
        for (int kt = qb * 8 + 7; kt >= 0; --kt) {
            __syncthreads();
#pragma unroll
            for (int i = 0; i < 8; ++i) { const int idx = tid + 512 * i, key = idx >> 6, d = idx & 63; const size_t mk = (size_t)b * SEQ + kt * 64 + key;
                sK[idx] = bf2f(PROJ[mk * N1 + PK + h * 64 + d]); sV[idx] = bf2f(PROJ[mk * N1 + PV + h * 64 + d]); }
            __syncthreads();
            for (int kk = 63; kk >= 0; --kk) {
                const int s = kt * 64 + kk;
                if (s < t) {
                    float z = 0.f;
#pragma unroll
                    for (int d = 0; d < 64; ++d) z += q[d] * sK[kk * 64 + d];
                    z = fminf(z, 100.f);
                    const float e = exp2f(z), r = 1.f / (1.f + e);
                    P *= r;
                    const float w = e * P;
#pragma unroll
                    for (int d = 0; d < 64; ++d) o[d] += w * sV[kk * 64 + d];
                }
            }
        }
        float ss = 0.f;
#pragma unroll
        for (int d = 0; d < 64; ++d) ss += o[d] * o[d];
        const float rstd = rsqrtf(ss * (1.f / 64.f) + EPS);
#pragma unroll
        for (int d = 0; d < 64; ++d) YC[m * 1024 + 512 + h * 64 + d] = (bf16)f2bf(o[d] * rstd * a.sb_norm_gain[h * 64 + d]);
    }
}


typedef short v4i16 __attribute__((ext_vector_type(4)));
typedef short bf16x8v __attribute__((ext_vector_type(8)));
constexpr int AT_KSTR = 144, AT_KBYTES = 64 * AT_KSTR, AT_VBYTES = 64 * 128, AT_BUF = AT_KBYTES + AT_VBYTES;
#define MFMA32(a, b, c) __builtin_amdgcn_mfma_f32_32x32x16_bf16((a), (b), (c), 0, 0, 0)

template <bool DIAG>
__device__ __forceinline__ void attn_tile(LAS const unsigned char* Kb, LAS const unsigned char* Vb, const bf16x8v (&qf)[4], f32x16& o0, f32x16& o1, float& carry,
                                          int qrel, int l32, int hh, unsigned vbase0, unsigned vbase1) {
    f32x16 p[2];
    bf16x8v kf[2][4];
#pragma unroll
    for (int blk = 0; blk < 2; ++blk)
#pragma unroll
        for (int s = 0; s < 4; ++s) kf[blk][s] = *(LAS const bf16x8v*)(Kb + (32 * blk + l32) * AT_KSTR + 32 * s + 16 * hh);
    asm volatile("s_waitcnt lgkmcnt(0)" ::: "memory");
#pragma unroll
    for (int bi = 0; bi < 2; ++bi) {
        const int blk = 1 - bi;
#pragma unroll
        for (int i = 0; i < 16; ++i) p[blk][i] = 0.f;
#pragma unroll
        for (int s = 0; s < 4; ++s) p[blk] = MFMA32(kf[blk][s], qf[s], p[blk]);
    }
#pragma unroll
    for (int bi = 0; bi < 2; ++bi) {
        const int blk = 1 - bi;
        float R[16];
#pragma unroll
        for (int i = 0; i < 16; ++i) {
            float rv = __builtin_amdgcn_rcpf(1.f + __builtin_amdgcn_exp2f(p[blk][i]));
            if (DIAG) { const int krel = 32 * blk + (i & 3) + 8 * (i >> 2) + 4 * hh; if (krel >= qrel) rv = 1.f; }
            R[i] = rv;
        }
        float GG[4], sel[4];
#pragma unroll
        for (int g = 0; g < 4; ++g) { R[4 * g + 2] *= R[4 * g + 3]; R[4 * g + 1] *= R[4 * g + 2]; R[4 * g] *= R[4 * g + 1]; }
#pragma unroll
        for (int g = 0; g < 4; g += 2) {
            const unsigned ua = __builtin_bit_cast(unsigned, R[4 * g]), ub = __builtin_bit_cast(unsigned, R[4 * g + 4]);
            auto s1 = __builtin_amdgcn_permlane32_swap(ua, ub, false, false);
            auto s2 = __builtin_amdgcn_permlane32_swap(ub, ua, false, false);
            const float pa = __builtin_bit_cast(float, hh ? s2[0] : s1[1]), pb2 = __builtin_bit_cast(float, hh ? s1[0] : s2[1]);
            GG[g] = R[4 * g] * pa; GG[g + 1] = R[4 * g + 4] * pb2;
            sel[g] = hh ? 1.f : pa; sel[g + 1] = hh ? 1.f : pb2;
        }
        float T3 = carry, T2 = T3 * GG[3], T1 = T2 * GG[2], T0 = T1 * GG[1];
        carry = T0 * GG[0];
        const float base[4] = {T0 * sel[0], T1 * sel[1], T2 * sel[2], T3 * sel[3]};
        float w[16];
#pragma unroll
        for (int g = 0; g < 4; ++g) {
            w[4 * g + 3] = base[g] * (1.f - R[4 * g + 3]); w[4 * g + 2] = base[g] * (R[4 * g + 3] - R[4 * g + 2]);
            w[4 * g + 1] = base[g] * (R[4 * g + 2] - R[4 * g + 1]); w[4 * g] = base[g] * (R[4 * g + 1] - R[4 * g]);
        }
#pragma unroll
        for (int s = 0; s < 2; ++s) {
            v4u pk; pk.x = cvtpk(w[8 * s], w[8 * s + 1]); pk.y = cvtpk(w[8 * s + 2], w[8 * s + 3]); pk.z = cvtpk(w[8 * s + 4], w[8 * s + 5]); pk.w = cvtpk(w[8 * s + 6], w[8 * s + 7]);
            const bf16x8v pb = __builtin_bit_cast(bf16x8v, pk);
            const int rowoff = (32 * blk + 16 * s) * 128;
            const v4i16 a0l = __builtin_amdgcn_ds_read_tr16_b64_v4i16((LAS v4i16*)(Vb + vbase0 + rowoff));
            const v4i16 a0h = __builtin_amdgcn_ds_read_tr16_b64_v4i16((LAS v4i16*)(Vb + vbase0 + rowoff + 8 * 128));
            const v4i16 a1l = __builtin_amdgcn_ds_read_tr16_b64_v4i16((LAS v4i16*)(Vb + vbase1 + rowoff));
            const v4i16 a1h = __builtin_amdgcn_ds_read_tr16_b64_v4i16((LAS v4i16*)(Vb + vbase1 + rowoff + 8 * 128));
            const bf16x8v va0 = __builtin_shufflevector(a0l, a0h, 0, 1, 2, 3, 4, 5, 6, 7), va1 = __builtin_shufflevector(a1l, a1h, 0, 1, 2, 3, 4, 5, 6, 7);
            o0 = MFMA32(va0, pb, o0); o1 = MFMA32(va1, pb, o1);
        }
    }
}

__device__ __forceinline__ void attn_unit(const Args& a, LAS unsigned char* lds, int b, int h, int qb) {
    const int tid = threadIdx.x, lane = tid & 63, w = __builtin_amdgcn_readfirstlane(tid >> 6), l32 = lane & 31, hh = lane >> 5;
    const bf16* PROJ = (const bf16*)(a.ws + WS_PROJ); bf16* YC = (bf16*)(a.ws + WS_H);
    const size_t rowbase = (size_t)b * SEQ;
    const int q0 = qb * 256 + 32 * w, ktd = q0 >> 6, ktmax = 4 * qb + 3, qrel = 32 * (w & 1) + l32;
    bf16x8v qf[4];
    { const bf16* qp = PROJ + (rowbase + q0 + l32) * N1 + PQ + h * 64 + 8 * hh;
#pragma unroll
      for (int s = 0; s < 4; ++s) qf[s] = *(const bf16x8v*)(qp + 16 * s); }
    f32x16 o0, o1;
#pragma unroll
    for (int i = 0; i < 16; ++i) { o0[i] = 0.f; o1[i] = 0.f; }
    float carry = 1.f;
    const int skey = tid >> 3, sc = tid & 7;
    const bf16* kg = PROJ + (rowbase + skey) * N1 + PK + h * 64 + 8 * sc;
    const unsigned kwoff = skey * AT_KSTR + sc * 16, vwoff = AT_KBYTES + skey * 128 + ((sc * 16) ^ (((skey >> 1) & 1) << 6));
    const int gi = (lane >> 4) & 1, q4 = (lane & 15) >> 2, pp = lane & 3;
    const unsigned vb = (4 * hh + q4) * 128 + 32 * gi + 8 * pp, xq = (q4 >> 1) << 6;
    const unsigned vbase0 = vb + xq, vbase1 = vb + (64 ^ xq);
    LAS unsigned* dflag = (LAS unsigned*)(lds + 6 * AT_BUF);
    bool wdone = false;
    const int tlo = ktmax >= 5 ? ktmax - 5 : 0, nwin = ktmax - tlo + 1;
    {
        v4u kr[6], vr[6];
#pragma unroll
        for (int i = 0; i < 6; ++i) if (i < nwin) { const size_t t = (size_t)(tlo + i) * 64 * N1; kr[i] = *(const v4u*)(kg + t); vr[i] = *(const v4u*)(kg + t + (PV - PK)); }
#pragma unroll
        for (int i = 0; i < 6; ++i) if (i < nwin) { *(LAS v4u*)(lds + i * AT_BUF + kwoff) = kr[i]; *(LAS v4u*)(lds + i * AT_BUF + vwoff) = vr[i]; }
    }
    __syncthreads();
#pragma unroll 1
    for (int kt = ktd; kt >= tlo; --kt) {
        if (!wdone) {
            LAS unsigned char* bt = lds + (kt - tlo) * AT_BUF;
            if (kt == ktd) attn_tile<true>(bt, bt + AT_KBYTES, qf, o0, o1, carry, qrel, l32, hh, vbase0, vbase1);
            else attn_tile<false>(bt, bt + AT_KBYTES, qf, o0, o1, carry, qrel, l32, hh, vbase0, vbase1);
            wdone = __builtin_amdgcn_ballot_w64(carry >= 3.5527137e-15f) == 0ull;
        }
    }
    if (lane == 0) dflag[16 + w] = wdone ? 1u : 0u;
    __syncthreads();
    bool alldone;
    { const v4u f0 = *(const LAS v4u*)(dflag + 16), f1 = *(const LAS v4u*)(dflag + 20);
      alldone = __builtin_amdgcn_readfirstlane((f0.x & f0.y & f0.z & f0.w) & (f1.x & f1.y & f1.z & f1.w)) != 0u; }
    if (!alldone && tlo > 0) {
        const int npair = tlo >> 1;
        const bf16* kg2 = kg + (size_t)64 * N1;
        v4u kr0, vr0, kr1, vr1;
        { const size_t t = (size_t)(npair - 1) * 128 * N1;
          kr0 = *(const v4u*)(kg + t); vr0 = *(const v4u*)(kg + t + (PV - PK)); kr1 = *(const v4u*)(kg2 + t); vr1 = *(const v4u*)(kg2 + t + (PV - PK)); }
        *(LAS v4u*)(lds + AT_BUF + kwoff) = kr0; *(LAS v4u*)(lds + AT_BUF + vwoff) = vr0; *(LAS v4u*)(lds + kwoff) = kr1; *(LAS v4u*)(lds + vwoff) = vr1;
        __syncthreads();
        int cur = 0, it = 0;
        for (int pj = npair - 1; pj >= 0; --pj, ++it) {
            if (pj > 0) { const size_t t = (size_t)(pj - 1) * 128 * N1;
                kr0 = *(const v4u*)(kg + t); vr0 = *(const v4u*)(kg + t + (PV - PK)); kr1 = *(const v4u*)(kg2 + t); vr1 = *(const v4u*)(kg2 + t + (PV - PK)); }
            LAS unsigned char* bh = lds + cur * (2 * AT_BUF); LAS unsigned char* bl = bh + AT_BUF;
            if (!wdone) {
                attn_tile<false>(bh, bh + AT_KBYTES, qf, o0, o1, carry, qrel, l32, hh, vbase0, vbase1);
                if (__builtin_amdgcn_ballot_w64(carry >= 3.5527137e-15f) != 0ull)
                    attn_tile<false>(bl, bl + AT_KBYTES, qf, o0, o1, carry, qrel, l32, hh, vbase0, vbase1);
                wdone = __builtin_amdgcn_ballot_w64(carry >= 3.5527137e-15f) == 0ull;
            }
            if (lane == 0) dflag[(it & 1) * 8 + w] = wdone ? 1u : 0u;
            if (pj > 0) { LAS unsigned char* nb = lds + (cur ^ 1) * (2 * AT_BUF);
                *(LAS v4u*)(nb + AT_BUF + kwoff) = kr0; *(LAS v4u*)(nb + AT_BUF + vwoff) = vr0; *(LAS v4u*)(nb + kwoff) = kr1; *(LAS v4u*)(nb + vwoff) = vr1; }
            __syncthreads();
            cur ^= 1;
            const v4u f0 = *(const LAS v4u*)(dflag + (it & 1) * 8), f1 = *(const LAS v4u*)(dflag + (it & 1) * 8 + 4);
            if (__builtin_amdgcn_readfirstlane((f0.x & f0.y & f0.z & f0.w) & (f1.x & f1.y & f1.z & f1.w)) != 0u) break;
        }
    }
    float ss = 0.f;
#pragma unroll
    for (int i = 0; i < 16; ++i) ss += o0[i] * o0[i] + o1[i] * o1[i];
    ss += __shfl_xor(ss, 32);
    const float rstd = rsqrtf(ss * (1.f / 64.f) + EPS);
    bf16* yp = YC + (rowbase + q0 + l32) * 1024 + 512 + h * 64 + 4 * hh;
    const float* gp = a.sb_norm_gain + h * 64 + 4 * hh;
#pragma unroll
    for (int g = 0; g < 4; ++g) {
        const v4f g0 = *(const v4f*)(gp + 8 * g), g1 = *(const v4f*)(gp + 32 + 8 * g);
        v2u s0, s1;
        s0.x = pk2(o0[4 * g] * rstd * g0.x, o0[4 * g + 1] * rstd * g0.y); s0.y = pk2(o0[4 * g + 2] * rstd * g0.z, o0[4 * g + 3] * rstd * g0.w);
        s1.x = pk2(o1[4 * g] * rstd * g1.x, o1[4 * g + 1] * rstd * g1.y); s1.y = pk2(o1[4 * g + 2] * rstd * g1.z, o1[4 * g + 3] * rstd * g1.w);
        *(v2u*)(yp + 8 * g) = s0; *(v2u*)(yp + 32 + 8 * g) = s1;
    }
}

__device__ __forceinline__ void phase_attn(const Args& a, LAS unsigned char* lds) {
    for (int pid = blockIdx.x; pid < 256; pid += gridDim.x) {
        int bh, qp;
        if (gridDim.x == 256) { const int xcd = pid & 7, j = pid >> 3; bh = xcd * 8 + (j >> 2); qp = j & 3; }
        else { bh = pid >> 2; qp = pid & 3; }
        attn_unit(a, lds, bh >> 3, bh & 7, 7 - qp);
        attn_unit(a, lds, bh >> 3, bh & 7, qp);
    }
}

constexpr int SD_DT = 0, SD_ACS = 1024, SD_WB = 2048, SD_X = 4096, SD_XS = 576, SD_B = 40960, SD_BS = 320, SD_C = 61440, SD_Z = 81920, SD_ZS = 528;

__device__ __forceinline__ float ssd_dt_load(const Args& a, int b, int c, int g) {
    const int tid = threadIdx.x;
    if (tid >= 256) return 0.f;
    return ((const float*)(a.ws + WS_DT))[((size_t)b * SEQ + 64 * c + (tid & 63)) * 8 + 4 * g + (tid >> 6)];
}
template <bool S1>
__device__ __forceinline__ void ssd_dt(const Args& a, LAS unsigned char* lds, int b, int c, int g, float dtraw) {
    const int tid = threadIdx.x, lane = tid & 63;
    if (tid < 256) {
        const int hl = tid >> 6, h = 4 * g + hl;
        const float dtv = softplusf(dtraw + a.dt_bias[h]);
        float cs = dtv * (-__expf(a.a_log[h]));
#pragma unroll
        for (int o = 1; o < 64; o <<= 1) { const float t = __shfl_up(cs, o); if (lane >= o) cs += t; }
        ((LAS float*)(lds + SD_DT))[hl * 64 + lane] = dtv;
        ((LAS float*)(lds + SD_ACS))[hl * 64 + lane] = cs;
        if (S1) {
            const float tot = __shfl(cs, 63);
            ((LAS float*)(lds + SD_WB))[hl * 64 + lane] = __expf(tot - cs) * dtv;
            if (lane == 63) ((float*)(a.ws + WS_CD))[((size_t)b * NCH + c) * 8 + h] = __expf(tot);
        }
    }
}

struct ConvIn { unsigned halo[3]; unsigned vin[32]; };
__device__ __forceinline__ void ssd_conv_load(const Args& a, ConvIn& r, int b, int c, int th, int col) {
    const bf16* PROJ = (const bf16*)(a.ws + WS_PROJ);
    const int t0 = 64 * c + 32 * th;
    const bf16* src = PROJ + ((size_t)b * SEQ + t0) * N1 + PX + col;
#pragma unroll
    for (int j = 0; j < 3; ++j) { unsigned v = 0u; if (t0 - 3 + j >= 0) v = *(const unsigned*)(src + (ptrdiff_t)(j - 3) * N1); r.halo[j] = v; }
#pragma unroll
    for (int i = 0; i < 32; ++i) r.vin[i] = *(const unsigned*)(src + (size_t)i * N1);
}
template <bool SCALE>
__device__ __forceinline__ void ssd_conv_compute(const Args& a, const ConvIn& r, LAS unsigned char* dst, int dstride, int th, int col, const LAS float* wsc) {
    float w0[4], w1[4];
#pragma unroll
    for (int j = 0; j < 4; ++j) { w0[j] = a.conv_w[j * 1024 + col]; w1[j] = a.conv_w[j * 1024 + col + 1]; }
    const float b0 = a.conv_b[col], b1 = a.conv_b[col + 1];
    float u0[3], u1[3];
#pragma unroll
    for (int j = 0; j < 3; ++j) { u0[j] = bflo(r.halo[j]); u1[j] = bfhi(r.halo[j]); }
#pragma unroll
    for (int i = 0; i < 32; ++i) {
        const unsigned v = r.vin[i];
        const float c0 = bflo(v), c1 = bfhi(v);
        float y0 = b0 + w0[0] * u0[0] + w0[1] * u0[1] + w0[2] * u0[2] + w0[3] * c0;
        float y1 = b1 + w1[0] * u1[0] + w1[1] * u1[1] + w1[2] * u1[2] + w1[3] * c1;
        u0[0] = u0[1]; u0[1] = u0[2]; u0[2] = c0; u1[0] = u1[1]; u1[1] = u1[2]; u1[2] = c1;
        y0 = silu_fast(y0); y1 = silu_fast(y1);
        if (SCALE) { const float s = wsc[32 * th + i]; y0 *= s; y1 *= s; }
        *(LAS unsigned*)(dst + (32 * th + i) * dstride) = pk2(y0, y1);
    }
}

__device__ __forceinline__ bf16x8v tr_pair(LAS const unsigned char* p, int rowstride4) {
    const v4i16 lo = __builtin_amdgcn_ds_read_tr16_b64_v4i16((LAS v4i16*)p);
    const v4i16 hi = __builtin_amdgcn_ds_read_tr16_b64_v4i16((LAS v4i16*)(p + rowstride4));
    return __builtin_shufflevector(lo, hi, 0, 1, 2, 3, 4, 5, 6, 7);
}

__device__ __forceinline__ int ssd_item(int item);
__device__ __forceinline__ void phase_ssd_s1(const Args& a, LAS unsigned char* lds) {
    const int tid = threadIdx.x, lane = tid & 63, w = __builtin_amdgcn_readfirstlane(tid >> 6), l32 = lane & 31, hh = lane >> 5;
    const int hl = w >> 1, half = w & 1;
    const int gi = (lane >> 4) & 1, q4 = (lane & 15) >> 2, pp = lane & 3;
    bf16* CS = (bf16*)(a.ws + WS_CS);
    ConvIn cin; float dtraw = 0.f;
    const int cp = tid % 192, th = tid / 192;
    if (blockIdx.x < NB * NCH * 2) { const int it0 = ssd_item(blockIdx.x), g0 = it0 & 1, c0 = (it0 >> 1) & (NCH - 1), b0 = it0 >> 6;
        if (tid < 384) ssd_conv_load(a, cin, b0, c0, th, cp < 128 ? 256 * g0 + 2 * cp : 512 + 128 * g0 + 2 * (cp - 128));
        dtraw = ssd_dt_load(a, b0, c0, g0); }
    for (int item = blockIdx.x; item < NB * NCH * 2; item += gridDim.x) {
        const int it2 = ssd_item(item), g = it2 & 1, c = (it2 >> 1) & (NCH - 1), b = it2 >> 6;
        const int ccol = cp < 128 ? 256 * g + 2 * cp : 512 + 128 * g + 2 * (cp - 128);
        __syncthreads();
        ssd_dt<true>(a, lds, b, c, g, dtraw);
        __syncthreads();
        if (tid < 384) {
            if (cp < 128) ssd_conv_compute<true>(a, cin, lds + SD_X + 4 * cp, SD_XS, th, ccol, (const LAS float*)(lds + SD_WB) + (cp >> 5) * 64);
            else ssd_conv_compute<false>(a, cin, lds + SD_B + 4 * (cp - 128), SD_BS, th, ccol, nullptr);
        }
        __syncthreads();
        { const int itn = item + gridDim.x;
          if (itn < NB * NCH * 2) { const int in2 = ssd_item(itn), gn = in2 & 1, cn = (in2 >> 1) & (NCH - 1), bn = in2 >> 6;
              if (tid < 384) ssd_conv_load(a, cin, bn, cn, th, cp < 128 ? 256 * gn + 2 * cp : 512 + 128 * gn + 2 * (cp - 128));
              dtraw = ssd_dt_load(a, bn, cn, gn); } }
        f32x16 acc[2][2];
#pragma unroll
        for (int i = 0; i < 16; ++i) { acc[0][0][i] = 0.f; acc[0][1][i] = 0.f; acc[1][0][i] = 0.f; acc[1][1][i] = 0.f; }
#pragma unroll
        for (int s = 0; s < 4; ++s) {
            const int l0 = 16 * s + 8 * hh + q4;
            bf16x8v af[2], bfr[2];
#pragma unroll
            for (int nb = 0; nb < 2; ++nb) af[nb] = tr_pair(lds + SD_B + l0 * SD_BS + (32 * (2 * half + nb) + 16 * gi + 4 * pp) * 2, 4 * SD_BS);
#pragma unroll
            for (int pb = 0; pb < 2; ++pb) bfr[pb] = tr_pair(lds + SD_X + l0 * SD_XS + (64 * hl + 32 * pb + 16 * gi + 4 * pp) * 2, 4 * SD_XS);
#pragma unroll
            for (int nb = 0; nb < 2; ++nb)
#pragma unroll
                for (int pb = 0; pb < 2; ++pb) acc[nb][pb] = MFMA32(bfr[pb], af[nb], acc[nb][pb]);
        }
        bf16* dst = CS + ((((size_t)b * NCH + c) * 8 + 4 * g + hl) * 64) * 128;
#pragma unroll
        for (int nb = 0; nb < 2; ++nb)
#pragma unroll
            for (int pb = 0; pb < 2; ++pb)
#pragma unroll
                for (int i = 0; i < 16; ++i) { const int p = 32 * pb + (i & 3) + 8 * (i >> 2) + 4 * hh; dst[p * 128 + 32 * (2 * half + nb) + l32] = (bf16)f2bf(acc[nb][pb][i]); }
    }
}

__device__ __forceinline__ void phase_ssd_s2(const Args& a) {
    const bf16* CS = (const bf16*)(a.ws + WS_CS); const float* CD = (const float*)(a.ws + WS_CD);
    for (int gid = blockIdx.x * NTHR + threadIdx.x; gid < 64 * 2048; gid += gridDim.x * NTHR) {
        int bh = gid >> 11, e4 = gid & 2047;
        if (gridDim.x == 256) { const int blk = gid >> 9, grp = blk & 7, j = blk >> 3; bh = grp * 8 + (j >> 2); e4 = (j & 3) * 512 + (gid & 511); }
        const int b = bh >> 3, h = bh & 7;
        const v2u* p = (const v2u*)(CS + (((size_t)b * NCH) * 8 + h) * 8192) + e4;
        const float* cd = CD + (size_t)b * NCH * 8 + h;
        v2u* o = (v2u*)((bf16*)(a.ws + WS_PB) + (((size_t)b * NCH) * 8 + h) * 8192) + e4;
        v4f st = {0.f, 0.f, 0.f, 0.f};
        for (int c0 = 0; c0 < NCH; c0 += 16) {
            v2u v[16]; float d[16];
#pragma unroll
            for (int j = 0; j < 16; ++j) { v[j] = p[(size_t)(c0 + j) * 16384]; d[j] = cd[(c0 + j) * 8]; }
#pragma unroll
            for (int j = 0; j < 16; ++j) { v2u w2; w2.x = cvtpk(st.x, st.y); w2.y = cvtpk(st.z, st.w); wt8(o + (size_t)(c0 + j) * 16384, w2.x, w2.y);
                const v4f vv = {bflo(v[j].x), bfhi(v[j].x), bflo(v[j].y), bfhi(v[j].y)}; st = st * d[j] + vv; }
        }
    }
}

__device__ __forceinline__ void phase_ssd_s3(const Args& a, LAS unsigned char* lds) {
    const int tid = threadIdx.x, lane = tid & 63, w = __builtin_amdgcn_readfirstlane(tid >> 6), l32 = lane & 31, hh = lane >> 5;
    const int hl = w >> 1, half = w & 1;
    const int gi = (lane >> 4) & 1, q4 = (lane & 15) >> 2, pp = lane & 3;
    const bf16* PROJ = (const bf16*)(a.ws + WS_PROJ); bf16* YC = (bf16*)(a.ws + WS_H);
    for (int item = blockIdx.x; item < NB * NCH * 2; item += gridDim.x) {
        const int it2 = ssd_item(item), g = it2 & 1, c = (it2 >> 1) & (NCH - 1), b = it2 >> 6, h = 4 * g + hl;
        const size_t m0 = (size_t)b * SEQ + 64 * c;
        __syncthreads();
        bf16x8v pvf[8][2];
        { const bf16* pvb = (const bf16*)(a.ws + WS_PB) + ((((size_t)b * NCH + c) * 8 + h) * 64 + l32) * 128 + 8 * hh;
#pragma unroll
          for (int s = 0; s < 8; ++s) { pvf[s][0] = *(const bf16x8v*)(pvb + 16 * s); pvf[s][1] = *(const bf16x8v*)(pvb + 32 * 128 + 16 * s); } }
        ConvIn cin; v4u zr[4];
        {
            const int cp = tid & 255, th = tid >> 8;
            const int ccol = cp < 128 ? 256 * g + 2 * cp : (cp < 192 ? 512 + 128 * g + 2 * (cp - 128) : 768 + 128 * g + 2 * (cp - 192));
            ssd_conv_load(a, cin, b, c, th, ccol);
#pragma unroll
            for (int i = 0; i < 4; ++i) { const int id = tid + 512 * i, row = id >> 5, ck = id & 31; zr[i] = *(const v4u*)(PROJ + (m0 + row) * N1 + PZ + 256 * g + 8 * ck); }
            ssd_dt<false>(a, lds, b, c, g, ssd_dt_load(a, b, c, g));
            LAS unsigned char* cdst = cp < 128 ? lds + SD_X + 4 * cp : (cp < 192 ? lds + SD_B + 4 * (cp - 128) : lds + SD_C + 4 * (cp - 192));
            ssd_conv_compute<false>(a, cin, cdst, cp < 128 ? SD_XS : SD_BS, th, ccol, nullptr);
#pragma unroll
            for (int i = 0; i < 4; ++i) { const int id = tid + 512 * i, row = id >> 5, ck = id & 31; *(LAS v4u*)(lds + SD_Z + row * SD_ZS + 16 * ck) = zr[i]; }
        }
        __syncthreads();
        const int lcol = 32 * half + l32;
        bf16x8v cf[8];
        f32x16 yo[2], yd[2];
#pragma unroll
        for (int i = 0; i < 16; ++i) { yo[0][i] = 0.f; yo[1][i] = 0.f; yd[0][i] = 0.f; yd[1][i] = 0.f; }
#pragma unroll
        for (int s = 0; s < 8; ++s) {
            cf[s] = *(LAS const bf16x8v*)(lds + SD_C + lcol * SD_BS + (16 * s + 8 * hh) * 2);
            yo[0] = MFMA32(pvf[s][0], cf[s], yo[0]); yo[1] = MFMA32(pvf[s][1], cf[s], yo[1]);
        }
        const float acs_l = ((const LAS float*)(lds + SD_ACS))[hl * 64 + lcol];
#pragma unroll
        for (int sb = 0; sb < 2; ++sb) {
            if (sb <= half) {
                f32x16 cb;
#pragma unroll
                for (int i = 0; i < 16; ++i) cb[i] = 0.f;
#pragma unroll
                for (int s = 0; s < 8; ++s) { const bf16x8v bfrag = *(LAS const bf16x8v*)(lds + SD_B + (32 * sb + l32) * SD_BS + (16 * s + 8 * hh) * 2); cb = MFMA32(bfrag, cf[s], cb); }
                float mv[16];
#pragma unroll
                for (int gq = 0; gq < 4; ++gq) {
                    const v4f as4 = *(const LAS v4f*)(lds + SD_ACS + (hl * 64 + 32 * sb + 8 * gq + 4 * hh) * 4), dt4 = *(const LAS v4f*)(lds + SD_DT + (hl * 64 + 32 * sb + 8 * gq + 4 * hh) * 4);
#pragma unroll
                    for (int j = 0; j < 4; ++j) { const int srow = 32 * sb + 8 * gq + 4 * hh + j;
                        const float dec = __expf(fminf(acs_l - as4[j], 0.f)) * dt4[j];
                        mv[4 * gq + j] = (srow <= lcol) ? cb[4 * gq + j] * dec : 0.f; }
                }
#pragma unroll
                for (int k2 = 0; k2 < 2; ++k2) {
                    v4u pk; pk.x = cvtpk(mv[8 * k2], mv[8 * k2 + 1]); pk.y = cvtpk(mv[8 * k2 + 2], mv[8 * k2 + 3]); pk.z = cvtpk(mv[8 * k2 + 4], mv[8 * k2 + 5]); pk.w = cvtpk(mv[8 * k2 + 6], mv[8 * k2 + 7]);
                    const bf16x8v mf = __builtin_bit_cast(bf16x8v, pk);
#pragma unroll
                    for (int pb = 0; pb < 2; ++pb) {
                        const bf16x8v xf = tr_pair(lds + SD_X + (32 * sb + 16 * k2 + 4 * hh + q4) * SD_XS + (64 * hl + 32 * pb + 16 * gi + 4 * pp) * 2, 8 * SD_XS);
                        yd[pb] = MFMA32(xf, mf, yd[pb]);
                    }
                }
            }
        }
        const float eal = __expf(acs_l), dsk = a.d_skip[h];
        float y[2][16]; float ss = 0.f;
#pragma unroll
        for (int pb = 0; pb < 2; ++pb)
#pragma unroll
            for (int gq = 0; gq < 4; ++gq) {
                const int ch = 64 * hl + 32 * pb + 8 * gq + 4 * hh;
                const v2u xv = *(const LAS v2u*)(lds + SD_X + lcol * SD_XS + ch * 2), zv = *(const LAS v2u*)(lds + SD_Z + lcol * SD_ZS + ch * 2);
                const float xs[4] = {bflo(xv.x), bfhi(xv.x), bflo(xv.y), bfhi(xv.y)}, zs[4] = {bflo(zv.x), bfhi(zv.x), bflo(zv.y), bfhi(zv.y)};
#pragma unroll
                for (int j = 0; j < 4; ++j) { float t = yd[pb][4 * gq + j] + yo[pb][4 * gq + j] * eal + dsk * xs[j]; t *= silu_fast(zs[j]); y[pb][4 * gq + j] = t; ss += t * t; }
            }
        ss += __shfl_xor(ss, 32);
        if (hh == 0) ((LAS float*)(lds + SD_WB))[hl * 64 + lcol] = ss;
        __syncthreads();
        const LAS float* sred = (const LAS float*)(lds + SD_WB);
        const float tot = (sred[lcol] + sred[64 + lcol]) + (sred[128 + lcol] + sred[192 + lcol]);
        const float rstd = rsqrtf(tot * (1.f / 256.f) + EPS);
        bf16* yp = YC + (m0 + lcol) * 1024 + 256 * g + 64 * hl + 4 * hh;
        const float* gp = a.ssd_norm_gain + 256 * g + 64 * hl + 4 * hh;
#pragma unroll
        for (int pb = 0; pb < 2; ++pb)
#pragma unroll
            for (int gq = 0; gq < 4; ++gq) {
                const v4f gn = *(const v4f*)(gp + 32 * pb + 8 * gq);
                v2u o; o.x = pk2(y[pb][4 * gq] * rstd * gn.x, y[pb][4 * gq + 1] * rstd * gn.y); o.y = pk2(y[pb][4 * gq + 2] * rstd * gn.z, y[pb][4 * gq + 3] * rstd * gn.w);
                *(v2u*)(yp + 32 * pb + 8 * gq) = o;
            }
    }
}

__device__ __forceinline__ void phase_norm1(const Args& a) {
    const int lane = threadIdx.x & 63, wave = threadIdx.x >> 6, gw = blockIdx.x * NWAVES + wave, NGW = gridDim.x * NWAVES;
    const bf16* MIX = (const bf16*)(a.ws + WS_PROJ); bf16* H = (bf16*)(a.ws + WS_H);
    v4f g1[4], g2[4];
#pragma unroll
    for (int j = 0; j < 4; ++j) { g1[j] = ((const v4f*)a.post_mix_gain)[lane + 64 * j]; g2[j] = ((const v4f*)a.pre_ffn_gain)[lane + 64 * j]; }
    v2u mv[4], mvn[4]; v4f xv[4], xvn[4];
    if (gw < M) {
#pragma unroll
        for (int j = 0; j < 4; ++j) { mv[j] = ((const v2u*)(MIX + (size_t)gw * DM))[lane + 64 * j]; xv[j] = ((const v4f*)(a.x + (size_t)gw * DM))[lane + 64 * j]; }
    }
    for (int m = gw; m < M; m += NGW) {
        const int mn = m + NGW;
        if (mn < M) {
#pragma unroll
            for (int j = 0; j < 4; ++j) { mvn[j] = ((const v2u*)(MIX + (size_t)mn * DM))[lane + 64 * j]; xvn[j] = ((const v4f*)(a.x + (size_t)mn * DM))[lane + 64 * j]; }
        }
        v4f* orow = (v4f*)(a.out + (size_t)m * DM) + lane;
        v4f v[4]; float s = 0.f;
#pragma unroll
        for (int j = 0; j < 4; ++j) { v[j] = (v4f){bflo(mv[j].x), bfhi(mv[j].x), bflo(mv[j].y), bfhi(mv[j].y)}; s += (v[j].x * v[j].x + v[j].y * v[j].y) + (v[j].z * v[j].z + v[j].w * v[j].w); }
        const float rstd = rsqrtf(wave_sum(s) * (1.f / DM) + EPS);
        float s2 = 0.f;
#pragma unroll
        for (int j = 0; j < 4; ++j) { xv[j] = xv[j] + v[j] * rstd * g1[j]; orow[64 * j] = xv[j];
            s2 += (xv[j].x * xv[j].x + xv[j].y * xv[j].y) + (xv[j].z * xv[j].z + xv[j].w * xv[j].w); }
        const float rstd2 = rsqrtf(wave_sum(s2) * (1.f / DM) + EPS);
        unsigned long long* o8 = (unsigned long long*)(H + (size_t)m * DM) + lane;
#pragma unroll
        for (int j = 0; j < 4; ++j) { const v4f hv = xv[j] * rstd2 * g2[j];
            o8[64 * j] = (unsigned long long)pk2(hv.x, hv.y) | ((unsigned long long)pk2(hv.z, hv.w) << 32); }
#pragma unroll
        for (int j = 0; j < 4; ++j) { mv[j] = mvn[j]; xv[j] = xvn[j]; }
    }
}
__device__ __forceinline__ void phase_norm2(const Args& a) {
    const int lane = threadIdx.x & 63, wave = threadIdx.x >> 6, gw = blockIdx.x * NWAVES + wave, NGW = gridDim.x * NWAVES;
    const bf16* F = (const bf16*)(a.ws + WS_CS);
    v4f g1[4];
#pragma unroll
    for (int j = 0; j < 4; ++j) g1[j] = ((const v4f*)a.post_ffn_gain)[lane + 64 * j];
    v2u fv[4], fvn[4]; v4f xv[4], xvn[4];
    if (gw < M) {
#pragma unroll
        for (int j = 0; j < 4; ++j) { fv[j] = ((const v2u*)(F + (size_t)gw * DM))[lane + 64 * j]; xv[j] = ((const v4f*)(a.out + (size_t)gw * DM))[lane + 64 * j]; }
    }
    for (int m = gw; m < M; m += NGW) {
        const int mn = m + NGW;
        if (mn < M) {
#pragma unroll
            for (int j = 0; j < 4; ++j) { fvn[j] = ((const v2u*)(F + (size_t)mn * DM))[lane + 64 * j]; xvn[j] = ((const v4f*)(a.out + (size_t)mn * DM))[lane + 64 * j]; }
        }
        v4f* orow = (v4f*)(a.out + (size_t)m * DM) + lane;
        v4f v[4]; float s = 0.f;
#pragma unroll
        for (int j = 0; j < 4; ++j) { v[j] = (v4f){bflo(fv[j].x), bfhi(fv[j].x), bflo(fv[j].y), bfhi(fv[j].y)}; s += (v[j].x * v[j].x + v[j].y * v[j].y) + (v[j].z * v[j].z + v[j].w * v[j].w); }
        const float rstd = rsqrtf(wave_sum(s) * (1.f / DM) + EPS);
#pragma unroll
        for (int j = 0; j < 4; ++j) orow[64 * j] = xv[j] + v[j] * rstd * g1[j];
#pragma unroll
        for (int j = 0; j < 4; ++j) { fv[j] = fvn[j]; xv[j] = xvn[j]; }
    }
}

#define XB_TMO      128
#define XB_XCNT(j)  (256  + 64 * (j))
#define XB_XSUB(j)  (1280 + 64 * (j))
#define XB_XGEN(j)  (2304 + 64 * (j))
#define XB_TOP      3328
#define XB_TOPGEN   3392
#define XCD_BAR_WORDS 3456
#define XB_SPIN_CAP (1u << 18)

__device__ __forceinline__ unsigned xb_ld(unsigned* p)              { return __hip_atomic_load(p, __ATOMIC_RELAXED, __HIP_MEMORY_SCOPE_AGENT); }
__device__ __forceinline__ unsigned xb_add(unsigned* p, unsigned v) { return __hip_atomic_fetch_add(p, v, __ATOMIC_RELAXED, __HIP_MEMORY_SCOPE_AGENT); }
__device__ __forceinline__ unsigned xb_xcc_id() { return (unsigned)__builtin_amdgcn_s_getreg((3 << 11) | 20) & 0xFu; }
#define XB_SPIN(cond, bar) do { unsigned _sp = 0; while (cond) { __builtin_amdgcn_s_sleep(1); \
    if ((++_sp & 255u) == 0u) { if (xb_ld(&(bar)[XB_TMO])) break; if (_sp > XB_SPIN_CAP) { atomicAdd(&(bar)[XB_TMO], 1u); break; } } } } while (0)

struct XcdBarrier {
    unsigned* bar; unsigned x;
    volatile LAS unsigned* st;
};

__device__ __forceinline__ XcdBarrier xcd_barrier_post(unsigned* bar, volatile LAS unsigned* st) {
    XcdBarrier b; b.bar = bar; b.x = xb_xcc_id(); b.st = st;
    if (threadIdx.x == 0) (void)xb_add(&bar[XB_XCNT(b.x)], 1u);
    return b;
}
__device__ __forceinline__ void xcd_barrier_complete(unsigned* bar, unsigned x, unsigned& nloc, unsigned& nx) {
    const unsigned G = gridDim.x * gridDim.y * gridDim.z;
    unsigned sum, cnt, mine, sp = 0u;
    for (;;) {
        sum = 0u; cnt = 0u; mine = 0u;
#pragma unroll
        for (unsigned j = 0; j < 16; ++j) { const unsigned c = xb_ld(&bar[XB_XCNT(j)]); sum += c; cnt += (c > 0u) ? 1u : 0u; mine = (j == x) ? c : mine; }
        if (sum == G) break;
        __builtin_amdgcn_s_sleep(1);
        if ((++sp & 255u) == 0u) { if (xb_ld(&bar[XB_TMO])) break; if (sp > XB_SPIN_CAP) { atomicAdd(&bar[XB_TMO], 1u); break; } }
    }
    nloc = mine > 0u ? mine : 1u; nx = cnt > 0u ? cnt : 1u;
}

__device__ __forceinline__ void xcd_barrier(const XcdBarrier& b) {
    asm volatile("s_waitcnt vmcnt(0)" ::: "memory");
    __syncthreads();
    if (threadIdx.x == 0) {
        unsigned* bar = b.bar;
        __builtin_amdgcn_s_waitcnt(0);
        unsigned nloc = b.st[0], nx = b.st[1];
        if (nloc == 0u) { xcd_barrier_complete(bar, b.x, nloc, nx); b.st[0] = nloc; b.st[1] = nx; }
        const unsigned old = xb_add(&bar[XB_XSUB(b.x)], 1u);
        const unsigned gen = old / nloc;
        if (old + 1u == (gen + 1u) * nloc) {
            __builtin_amdgcn_fence(__ATOMIC_RELEASE, "agent");
            asm volatile("s_waitcnt vmcnt(0)" ::: "memory");
            const unsigned og = xb_add(&bar[XB_TOP], 1u);
            const unsigned tg = og / nx;
            if (og + 1u == (tg + 1u) * nx) xb_add(&bar[XB_TOPGEN], 1u);
            else XB_SPIN(xb_ld(&bar[XB_TOPGEN]) == tg, bar);
            __builtin_amdgcn_fence(__ATOMIC_ACQUIRE, "agent");
            xb_add(&bar[XB_XGEN(b.x)], 1u);
            asm volatile("s_waitcnt vmcnt(0)" ::: "memory");
        } else {
            XB_SPIN(xb_ld(&bar[XB_XGEN(b.x)]) == gen, bar);
            __builtin_amdgcn_fence(__ATOMIC_ACQUIRE, "agent");
            asm volatile("s_waitcnt vmcnt(0)" ::: "memory");
        }
    }
    __syncthreads();
}


__device__ __forceinline__ int ssd_item(int item) {
    if (gridDim.x != 256) return item;
    const int blk = item & 255, k = item >> 8, grp = blk & 7, j = blk >> 3;
    return (grp << 6) | (j + 32 * k);
}
#define XL_SUB(g) (3472 + 16 * (g))
#define XL_GEN(g) (3600 + 16 * (g))
#define XL_MASK(g) (3456 + (g))
__device__ __forceinline__ void local_barrier(unsigned* ctl, int g) {
    asm volatile("s_waitcnt vmcnt(0)" ::: "memory");
    __syncthreads();
    if (threadIdx.x == 0) {
        const unsigned old = xb_add(&ctl[XL_SUB(g)], 1u), gen = old / 32u;
        if (old + 1u == (gen + 1u) * 32u) xb_add(&ctl[XL_GEN(g)], 1u);
        else { unsigned sp = 0u; while (xb_ld(&ctl[XL_GEN(g)]) == gen) { __builtin_amdgcn_s_sleep(1); if (++sp > (1u << 22)) break; } }
        __builtin_amdgcn_fence(__ATOMIC_ACQUIRE, "agent");
        asm volatile("s_waitcnt vmcnt(0)" ::: "memory");
    }
    __syncthreads();
}
constexpr int NPHASE = 10;
__global__ void __launch_bounds__(NTHR, 2) fwd(Args a) {
    extern __shared__ __attribute__((aligned(16))) unsigned char lds_raw[];
    LAS unsigned char* lds = (LAS unsigned char*)lds_raw;
    const int lo = a.ph_lo, hi = a.ph_hi;
#ifndef REPMASK
#define REPMASK 0
#endif
#define REP(k) for (int _r = 0; _r < (((REPMASK) >> (k)) & 1) + 1; ++_r)
#define IN(k) (lo <= (k) && (k) < hi)
#define SEAM(k) do { if (IN(k) && IN((k) + 1)) xcd_barrier(bar); } while (0)
    unsigned char* ws = a.ws;
    volatile LAS unsigned* misc = (volatile LAS unsigned*)(lds + 131072);
    if (threadIdx.x < 2) misc[threadIdx.x] = 0u;
    __syncthreads();
    XcdBarrier bar = xcd_barrier_post((unsigned*)(ws + WS_CTL), misc);
    unsigned* ctlw = (unsigned*)(ws + WS_CTL);
    if (threadIdx.x == 0) __hip_atomic_fetch_or(&ctlw[XL_MASK(blockIdx.x & 7)], 1u << bar.x, __ATOMIC_RELAXED, __HIP_MEMORY_SCOPE_AGENT);
    if ((REPMASK) & 16384) { for (int i = 0; i < 10; ++i) xcd_barrier(bar); }
    const bool defer_w4 = (gridDim.x == 256) && lo == 0 && hi > 7;
    if (IN(0)) REP(0) { phase_p0(a, lds, defer_w4); __syncthreads(); }
    SEAM(0);
    bool colo = false;
    if ((gridDim.x == 256) && lo == 0 && hi > 5) {
        unsigned seen = 0u; colo = true;
#pragma unroll
        for (int g8 = 0; g8 < 8; ++g8) { const unsigned mk = xb_ld(&ctlw[XL_MASK(g8)]); colo = colo && mk != 0u && (mk & (mk - 1u)) == 0u && (seen & mk) == 0u; seen |= mk; }
        colo = __builtin_amdgcn_readfirstlane(colo ? 1 : 0) != 0;
    }
#define SEAM_L(k) do { if (IN(k) && IN((k) + 1)) { if (colo) local_barrier(ctlw, blockIdx.x & 7); else xcd_barrier(bar); } } while (0)
    if (IN(1)) REP(1) { pg8::Gemm g{(const bf16*)(ws + WS_H), (const bf16*)(ws + WS_W1), M, N1, DM}; pg8::StaticOrder S; S.init(M, N1, gridDim.x, blockIdx.x);
        pg8::EpiProj E{(bf16*)(ws + WS_PROJ)}; pg8::gemm_phase<pg8::EpiProj, pg8::StaticOrder, true, true>(lds, g, S, E); }
    SEAM_L(1);
    const bool att_first = colo && (blockIdx.x & 1) && IN(2) && IN(4);
    if (att_first) { phase_attn(a, lds); __syncthreads(); }
    if (IN(2)) REP(2) { phase_ssd_s1(a, lds); }
    SEAM_L(2);
    if (IN(3)) REP(3) { phase_ssd_s2(a); }
    SEAM_L(3);
    if (IN(4)) { REP(10) { phase_ssd_s3(a, lds); __syncthreads(); } if (!att_first) REP(11) { phase_attn(a, lds); __syncthreads(); } }
    SEAM_L(4);
    const bool fuse_n1 = (gridDim.x == 256) && lo <= 5 && hi > 7;
    if (IN(5)) { pg8::Gemm g{(const bf16*)(ws + WS_H), (const bf16*)(ws + WS_W2), M, DM, DM}; pg8::StaticOrder S; S.init(M, DM, gridDim.x, blockIdx.x);
        if (fuse_n1) {
            pg8::EpiRmsResRms E{a.x, (bf16*)(ws + WS_CS), (bf16*)(ws + WS_PB), a.post_mix_gain, a.pre_ffn_gain, (float*)(ws + WS_CTL + 65536 + 262144), (unsigned*)(ws + WS_CTL + 32768), (float*)(ws + WS_CTL + 65536 + 524288), (unsigned*)(ws + WS_CTL + 49152)};
            pg8::gemm_phase<pg8::EpiRmsResRms, pg8::StaticOrder, false, true>(lds, g, S, E);
        } else {
            pg8::EpiBf16 E{(bf16*)(ws + WS_PROJ), DM}; pg8::gemm_phase<pg8::EpiBf16, pg8::StaticOrder, true, true>(lds, g, S, E);
        }
    }
    if (!fuse_n1) {
    SEAM(5);
    if (IN(6)) REP(6) { phase_norm1(a); }
    }
    SEAM_L(6);
    if (IN(7)) REP(7) { pg8::Gemm g{(const bf16*)(ws + (fuse_n1 ? WS_PB : WS_H)), (const bf16*)(ws + WS_W3), M, N3, DM}; pg8::StaticOrder S; S.init(M, N3, gridDim.x, blockIdx.x);
        pg8::EpiSwiglu E{(bf16*)(ws + WS_PROJ)}; pg8::gemm_phase<pg8::EpiSwiglu, pg8::StaticOrder, true, true>(lds, g, S, E);
        if (defer_w4) { __syncthreads(); phase_w4(a, lds); } }
    SEAM(7);
    if (IN(8)) { pg8::Gemm g{(const bf16*)(ws + WS_PROJ), (const bf16*)(ws + WS_W4), M, DM, DFF, (size_t)1 << 20}; pg8::StaticOrder S; S.init(M, DM, gridDim.x, blockIdx.x);
        if (gridDim.x == 256 && hi > 9 && lo <= 5) {
            pg8::EpiRmsRes E{(const bf16*)(ws + WS_CS), a.out, a.post_ffn_gain, (float*)(ws + WS_CTL + 65536), (unsigned*)(ws + WS_CTL + 16384)};
            pg8::gemm_phase<pg8::EpiRmsRes, pg8::StaticOrder, false, true>(lds, g, S, E);
        } else {
            pg8::EpiBf16 E{(bf16*)(ws + WS_CS), DM}; pg8::gemm_phase<pg8::EpiBf16, pg8::StaticOrder, true, true>(lds, g, S, E);
            SEAM(8);
            if (IN(9)) { phase_norm2(a); }
        }
    }
#undef IN
#undef SEAM
}

#ifndef N_LAUNCHES
#define N_LAUNCHES 1
#endif
extern "C" void kernel_launch(void* const* d_in, const int* in_sizes, int n_in, void* d_out, int out_size, void* d_ws, size_t ws_size, hipStream_t stream) {
    static int grid = 0;
    if (grid == 0) {
        if (n_in != 17 || out_size != M * DM || ws_size < WS_END) { fprintf(stderr, "kernel_launch: unexpected problem (n_in %d out %d ws %zu)\n", n_in, out_size, ws_size); grid = -1; return; }
        int dev = 0, cus = 0, per_cu = 0;
        hipGetDevice(&dev); hipDeviceGetAttribute(&cus, hipDeviceAttributeMultiprocessorCount, dev);
        if (hipFuncSetAttribute((const void*)fwd, hipFuncAttributeMaxDynamicSharedMemorySize, LDS_BYTES) != hipSuccess) { fprintf(stderr, "kernel_launch: hipFuncSetAttribute failed\n"); grid = -1; return; }
        if (hipOccupancyMaxActiveBlocksPerMultiprocessor(&per_cu, (const void*)fwd, NTHR, LDS_BYTES) != hipSuccess || per_cu < 1) { fprintf(stderr, "kernel_launch: occupancy query says %d blocks per CU\n", per_cu); per_cu = 1; }
        (void)hipGetLastError();
        grid = cus;
    }
    if (grid < 0) return;
    if (hipMemsetAsync((char*)d_ws + WS_CTL, 0, 65536, stream) != hipSuccess) { fprintf(stderr, "kernel_launch: memset failed\n"); return; }
    Args a{};
    const float** ap = (const float**)&a;
    for (int i = 0; i < 17; ++i) ap[i] = (const float*)d_in[i];
    a.out = (float*)d_out; a.ws = (unsigned char*)d_ws;
#if N_LAUNCHES == 1
    a.ph_lo = 0; a.ph_hi = NPHASE;
    void* args[] = {&a};
    hipError_t e = hipLaunchCooperativeKernel((const void*)fwd, dim3(grid), dim3(NTHR), args, LDS_BYTES, stream);
    if (e != hipSuccess) fprintf(stderr, "cooperative launch failed: %s (grid %d)\n", hipGetErrorString(e), grid);
#else
    for (int ph = 0; ph < NPHASE; ++ph) { a.ph_lo = ph; a.ph_hi = ph + 1; hipLaunchKernelGGL(fwd, dim3(grid), dim3(NTHR), LDS_BYTES, stream, a); }
#endif
}
```

```cpp
#define REPMASK 0
#include <hip/hip_runtime.h>
#include <hip/hip_cooperative_groups.h>
#include <cstdio>
#include <cstdint>
namespace cg = cooperative_groups;
#ifndef REPMASK
#define REPMASK 0
#endif

constexpr int NB = 8, SEQ = 2048, DM = 1024, M = NB * SEQ;
constexpr int DIN = 3080;
constexpr int N1 = 3072;
constexpr int PZ = 0, PX = 512, PQ = 1536, PK = 2048, PV = 2560;
constexpr int DFF = 2816, N3 = 2 * DFF;
constexpr int NH = 8, HD = 64, NST = 128, CH = 64, NCH = SEQ / CH;
constexpr float EPS = 1e-6f;
constexpr float LOG2E = 1.4426950408889634f;
constexpr float QSCALE = 0.125f * LOG2E;

constexpr size_t MiB = 1u << 20;
constexpr size_t WS_W1 = 0, WS_W2 = 6 * MiB, WS_W3 = 8 * MiB, WS_W4 = 19 * MiB;
constexpr size_t WS_DT = 25 * MiB;
constexpr size_t WS_CD = 25 * MiB + 512 * 1024;
constexpr size_t WS_H = 26 * MiB;
constexpr size_t WS_PROJ = 58 * MiB;
constexpr size_t WS_CS = 154 * MiB;
constexpr size_t WS_CTL = 218 * MiB;
constexpr size_t WS_PB = 219 * MiB;
constexpr size_t WS_END = 251 * MiB;

constexpr int LDS_BYTES = 147456;
constexpr int NTHR = 512, NWAVES = 8;

#define LAS __attribute__((address_space(3)))
typedef unsigned short bf16;
typedef unsigned v4u __attribute__((ext_vector_type(4)));
typedef unsigned v2u __attribute__((ext_vector_type(2)));
typedef float v4f __attribute__((ext_vector_type(4)));
typedef float f32x16 __attribute__((ext_vector_type(16)));

__device__ __forceinline__ unsigned f2bf(float f) { unsigned u = __builtin_bit_cast(unsigned, f); return (u + 0x7fffu + ((u >> 16) & 1u)) >> 16; }
typedef float f32x2_t __attribute__((ext_vector_type(2)));
typedef __bf16 bf16x2_t __attribute__((ext_vector_type(2)));
__device__ __forceinline__ unsigned cvtpk(float lo, float hi) { f32x2_t v = {lo, hi}; bf16x2_t b = __builtin_convertvector(v, bf16x2_t); return __builtin_bit_cast(unsigned, b); }
__device__ __forceinline__ unsigned pk2(float lo, float hi) { return cvtpk(lo, hi); }
__device__ __forceinline__ void wt8(void* p, unsigned lo, unsigned hi) { __hip_atomic_store((unsigned long long*)p, (unsigned long long)lo | ((unsigned long long)hi << 32), __ATOMIC_RELAXED, __HIP_MEMORY_SCOPE_AGENT); }
__device__ __forceinline__ __amdgpu_buffer_rsrc_t wt_rsrc(void* base, unsigned bytes) { return __builtin_amdgcn_make_buffer_rsrc(base, 0, (int)bytes, 0x00020000); }
__device__ __forceinline__ void wt16(__amdgpu_buffer_rsrc_t r, unsigned byte_off, v4u v) { __builtin_amdgcn_raw_buffer_store_b128(v, r, (int)byte_off, 0, 16); }
__device__ __forceinline__ float bf2f(unsigned b) { return __builtin_bit_cast(float, b << 16); }
__device__ __forceinline__ float bflo(unsigned w) { return __builtin_bit_cast(float, w << 16); }
__device__ __forceinline__ float bfhi(unsigned w) { return __builtin_bit_cast(float, w & 0xffff0000u); }
__device__ __forceinline__ float wave_sum(float v) {
#pragma unroll
    for (int o = 1; o < 64; o <<= 1) v += __shfl_xor(v, o);
    return v;
}
__device__ __forceinline__ float siluf(float v) { return v / (1.f + __expf(-v)); }
__device__ __forceinline__ float silu_fast(float v) { return v * __builtin_amdgcn_rcpf(1.f + __builtin_amdgcn_exp2f(-LOG2E * v)); }
__device__ __forceinline__ float softplusf(float v) { return fmaxf(v, 0.f) + log1pf(__expf(-fabsf(v))); }

namespace pg8 {
#define PG8_LAS __attribute__((address_space(3)))
typedef unsigned short bf16_t;
typedef short bf16x8 __attribute__((ext_vector_type(8)));
typedef float f32x4 __attribute__((ext_vector_type(4)));
typedef unsigned u32x4 __attribute__((ext_vector_type(4)));
constexpr int BM = 256, BK = 64, HALF = 128, HTB = HALF * BK * 2  , STAGE_BYTES = 8 * HTB, NXCD = 8, WGM = 8;

__host__ __device__ __forceinline__ int lds_byte(int r, int c) { const int st = (r >> 4) * 2 + (c >> 5), rr = r & 15, cc = c & 31, ob = rr * 64 + cc * 2; return st * 1024 + (ob ^ (((ob >> 9) & 1) << 5)); }
__host__ __device__ __forceinline__ void stage_rc(int b, int& R, int& C) { const int st = b / 1024, sb = b % 1024, swz = sb ^ (((sb >> 9) & 1) << 5); R = (st >> 1) * 16 + swz / 64; C = (st & 1) * 32 + (swz % 64) / 2; }
__host__ __device__ __forceinline__ int perm32(int rho) { const int n = rho >> 4, i = rho & 15; return 8 * (i >> 2) + 4 * n + (i & 3); }

struct Unit { int pm, pn; };
struct Gemm { const bf16_t* A; const bf16_t* Bt; int M, N, K; size_t agap; };

struct StaticOrder {
    int nM, nN, nwg, G, c;
    __host__ __device__ void init(int M, int N, int G_, int c_) { nM = M / BM; nN = N / BM; nwg = nM * nN; G = G_; c = c_; }
    __host__ __device__ bool next(int i, Unit& u) const {
        const long L = (long)i * G + c; if (L >= nwg) return false;
        int wgid = (int)L; { const int q = nwg / NXCD, r = nwg % NXCD, xcd = wgid % NXCD, off = wgid / NXCD; wgid = (xcd < r ? xcd * (q + 1) : r * (q + 1) + (xcd - r) * q) + off; }
        const int nig = WGM * nN, gid = wgid / nig, fm = gid * WGM, gsz = (nM - fm) < WGM ? (nM - fm) : WGM;
        u.pm = fm + ((wgid % nig) % gsz); u.pn = (wgid % nig) / gsz; return true;
    }
    __device__ __forceinline__ void a_ready(const Unit&) const {}
    __device__ __forceinline__ void done(const Unit&) const {}
};

__device__ __forceinline__ unsigned cvt_pk_bf16(float lo, float hi) { unsigned r; asm volatile("v_cvt_pk_bf16_f32 %0, %1, %2" : "=v"(r) : "v"(lo), "v"(hi)); return r; }
template <class Epi, class Sched, bool ALIGN_EPI = false, bool SP2 = false>
__device__ __forceinline__ void gemm_phase(PG8_LAS unsigned char* lds, const Gemm g, const Sched& S, const Epi& E) {
    const int tid = threadIdx.x, wid = __builtin_amdgcn_readfirstlane(tid >> 6), lane = tid & 63, wr = wid >> 2, wc = wid & 3, fr = lane & 15, fq = lane >> 4;
    const int K = g.K, nt = K / BK;
    unsigned voffA[2], voffB[2];
#pragma unroll
    for (int i = 0; i < 2; ++i) { int R, C; stage_rc(tid * 16 + i * 8192, R, C); const int Rb = Epi::PERM ? ((R & ~31) + perm32(R & 31)) : R;
        voffA[i] = (unsigned)(R * K + C) * 2u; voffB[i] = (unsigned)(Rb * K + C) * 2u; }
    const size_t kstep = (size_t)(BK * 2);
    const size_t hstep = (size_t)HALF * K * 2;
    const size_t tstep = 2 * hstep;
    const unsigned ldsw = (unsigned)wid * 1024u;
    const int aoff = lds_byte(wr * 64 + fr, fq * 8), boff = lds_byte(wc * 32 + fr, fq * 8);
#define PG8_SA(b, h) (((b) * 2 + (h)) * HTB)
#define PG8_SB(b, h) ((4 + (b) * 2 + (h)) * HTB)
#define PG8_STAGE(bufoff, gbase, voff) do { _Pragma("unroll") for (int _i = 0; _i < 2; ++_i) \
        __builtin_amdgcn_global_load_lds((const unsigned*)((const char*)(gbase) + (voff)[_i]), (PG8_LAS unsigned*)(lds + (bufoff) + ldsw + _i * 8192), 16, 0, 0); } while (0)
#define PG8_LDA(dst, b, h) do { _Pragma("unroll") for (int m = 0; m < 4; ++m) _Pragma("unroll") for (int k = 0; k < 2; ++k) dst[m][k] = *(const PG8_LAS bf16x8*)(lds + PG8_SA(b, h) + aoff + m * 2048 + k * 1024); } while (0)
#define PG8_LDB(dst, b, h) do { _Pragma("unroll") for (int n = 0; n < 2; ++n) _Pragma("unroll") for (int k = 0; k < 2; ++k) dst[n][k] = *(const PG8_LAS bf16x8*)(lds + PG8_SB(b, h) + boff + n * 2048 + k * 1024); } while (0)
#define PG8_MMA(ai, bj, At, Bt) do { __builtin_amdgcn_s_setprio(1); _Pragma("unroll") for (int m = 0; m < 4; ++m) _Pragma("unroll") for (int n = 0; n < 2; ++n) _Pragma("unroll") for (int k = 0; k < 2; ++k) \
        acc[ai][bj][m][n] = __builtin_amdgcn_mfma_f32_16x16x32_bf16(Bt[n][k], At[m][k], acc[ai][bj][m][n], 0, 0, 0); __builtin_amdgcn_s_setprio(0); } while (0)
#define PG8_WAIT_V(n) asm volatile("s_waitcnt vmcnt(" #n ")" ::: "memory")
#define PG8_WAIT_L(n) asm volatile("s_waitcnt lgkmcnt(" #n ")" ::: "memory")
#define PG8_BAR __builtin_amdgcn_s_barrier()
#define PG8_SCHED __builtin_amdgcn_sched_barrier(0)
    Unit cur, nxt; int ui = 0;
    if (!S.next(0, cur)) return;
    f32x4 acc[2][2][4][2];
#pragma unroll
    for (int a = 0; a < 2; ++a)
#pragma unroll
        for (int b = 0; b < 2; ++b)
#pragma unroll
            for (int m = 0; m < 4; ++m)
#pragma unroll
                for (int n = 0; n < 2; ++n) acc[a][b][m][n] = (f32x4){0.f, 0.f, 0.f, 0.f};
    bf16x8 At[4][2], B0[2][2], B1[2][2];
    const char* cA = (const char*)g.A + (size_t)cur.pm * tstep + (size_t)(cur.pm >> 3) * g.agap; const char* cB = (const char*)g.Bt + (size_t)cur.pn * tstep;
    S.a_ready(cur);
    if constexpr (SP2) {
        PG8_STAGE(PG8_SB(0, 0), cB, voffB); PG8_STAGE(PG8_SB(0, 1), cB + hstep, voffB); PG8_STAGE(PG8_SA(0, 0), cA, voffA); PG8_STAGE(PG8_SA(0, 1), cA + hstep, voffA);
        if (wr == 1) PG8_BAR;
        PG8_WAIT_V(2); PG8_BAR;
        PG8_STAGE(PG8_SB(1, 0), cB + kstep, voffB); PG8_STAGE(PG8_SA(1, 0), cA + kstep, voffA); PG8_STAGE(PG8_SB(1, 1), cB + hstep + kstep, voffB);
        PG8_WAIT_V(6); PG8_BAR;
    } else {
        PG8_STAGE(PG8_SB(0, 0), cB, voffB); PG8_STAGE(PG8_SA(0, 0), cA, voffA); PG8_STAGE(PG8_SB(0, 1), cB + hstep, voffB); PG8_STAGE(PG8_SA(0, 1), cA + hstep, voffA);
        if (wr == 1) PG8_BAR;
        PG8_WAIT_V(4); PG8_BAR;
        PG8_STAGE(PG8_SB(1, 0), cB + kstep, voffB); PG8_STAGE(PG8_SA(1, 0), cA + kstep, voffA); PG8_STAGE(PG8_SB(1, 1), cB + hstep + kstep, voffB);
        PG8_WAIT_V(6); PG8_BAR;
    }
    for (;;) {
        const bool has_next = S.next(ui + 1, nxt);
        const char* nA = has_next ? (const char*)g.A + (size_t)nxt.pm * tstep + (size_t)(nxt.pm >> 3) * g.agap : cA; const char* nB = has_next ? (const char*)g.Bt + (size_t)nxt.pn * tstep : cB;
        for (int t = 0; t < nt; t += 2) {
            const bool last = (t == nt - 2);
            const char* a1 = cA + (size_t)(t + 1) * kstep;
            const char* a2 = last ? nA : cA + (size_t)(t + 2) * kstep; const char* b2 = last ? nB : cB + (size_t)(t + 2) * kstep;
            const char* a3 = a2 + kstep; const char* b3 = b2 + kstep;
            if (last && has_next) S.a_ready(nxt);
            if constexpr (SP2) {
            PG8_LDB(B0, 0, 0); PG8_LDB(B1, 0, 1); PG8_SCHED; PG8_LDA(At, 0, 0); PG8_STAGE(PG8_SA(1, 1), a1 + hstep, voffA);
            PG8_WAIT_V(8); PG8_WAIT_L(0); PG8_BAR; PG8_MMA(0, 0, At, B0); PG8_MMA(0, 1, At, B1); PG8_BAR; PG8_SCHED;
            PG8_LDA(At, 0, 1); PG8_STAGE(PG8_SB(0, 0), b2, voffB); PG8_STAGE(PG8_SB(0, 1), b2 + hstep, voffB); PG8_STAGE(PG8_SA(0, 0), a2, voffA);
            PG8_WAIT_V(8); PG8_WAIT_L(0); PG8_BAR; PG8_MMA(1, 0, At, B0); PG8_MMA(1, 1, At, B1); PG8_BAR; PG8_SCHED;
            PG8_LDB(B0, 1, 0); PG8_LDB(B1, 1, 1); PG8_SCHED; PG8_LDA(At, 1, 0); PG8_STAGE(PG8_SA(0, 1), a2 + hstep, voffA);
            PG8_WAIT_V(8); PG8_WAIT_L(0); PG8_BAR; PG8_MMA(0, 0, At, B0); PG8_MMA(0, 1, At, B1); PG8_BAR; PG8_SCHED;
            PG8_LDA(At, 1, 1); PG8_STAGE(PG8_SB(1, 0), b3, voffB); PG8_STAGE(PG8_SB(1, 1), b3 + hstep, voffB); PG8_STAGE(PG8_SA(1, 0), a3, voffA);
            PG8_WAIT_V(8); PG8_WAIT_L(0); PG8_BAR; PG8_MMA(1, 0, At, B0); PG8_MMA(1, 1, At, B1); PG8_BAR; PG8_SCHED;
            } else {
            PG8_LDB(B0, 0, 0); PG8_SCHED; PG8_LDA(At, 0, 0); PG8_STAGE(PG8_SA(1, 1), a1 + hstep, voffA);
            PG8_WAIT_L(8); PG8_BAR; PG8_WAIT_L(0); PG8_MMA(0, 0, At, B0); PG8_BAR; PG8_SCHED;
            PG8_LDB(B1, 0, 1); PG8_STAGE(PG8_SB(0, 0), b2, voffB);
            PG8_BAR; PG8_WAIT_L(0); PG8_MMA(0, 1, At, B1); PG8_BAR;
            PG8_LDA(At, 0, 1); PG8_STAGE(PG8_SA(0, 0), a2, voffA);
            PG8_BAR; PG8_WAIT_L(0); PG8_MMA(1, 0, At, B0); PG8_BAR; PG8_SCHED;
            PG8_STAGE(PG8_SB(0, 1), b2 + hstep, voffB);
            PG8_WAIT_V(6); PG8_BAR; PG8_MMA(1, 1, At, B1); PG8_BAR;
            PG8_LDB(B0, 1, 0); PG8_SCHED; PG8_LDA(At, 1, 0); PG8_STAGE(PG8_SA(0, 1), a2 + hstep, voffA);
            PG8_WAIT_L(8); PG8_BAR; PG8_WAIT_L(0); PG8_MMA(0, 0, At, B0); PG8_BAR; PG8_SCHED;
            PG8_LDB(B1, 1, 1); PG8_STAGE(PG8_SB(1, 0), b3, voffB);
            PG8_BAR; PG8_WAIT_L(0); PG8_MMA(0, 1, At, B1); PG8_BAR;
            PG8_LDA(At, 1, 1); PG8_STAGE(PG8_SA(1, 0), a3, voffA);
            PG8_BAR; PG8_WAIT_L(0); PG8_MMA(1, 0, At, B0); PG8_BAR; PG8_SCHED;
            PG8_STAGE(PG8_SB(1, 1), b3 + hstep, voffB);
            PG8_WAIT_V(6); PG8_BAR; PG8_MMA(1, 1, At, B1); PG8_BAR;
            }
        }
        if constexpr (ALIGN_EPI) { if (wr == 0) PG8_BAR; }
        if constexpr (!Epi::AFTER_DRAIN) { E(acc, cur, wr, wc, fr, fq); S.done(cur); }
        if (!has_next) break;
#pragma unroll
        for (int a = 0; a < 2; ++a)
#pragma unroll
            for (int b = 0; b < 2; ++b)
#pragma unroll
                for (int m = 0; m < 4; ++m)
#pragma unroll
                    for (int n = 0; n < 2; ++n) acc[a][b][m][n] = (f32x4){0.f, 0.f, 0.f, 0.f};
        cur = nxt; cA = nA; cB = nB; ++ui;
        if constexpr (ALIGN_EPI) { if (wr == 1) PG8_BAR; }
    }
    PG8_WAIT_V(0);
    if constexpr (!ALIGN_EPI) { if (wr == 0) PG8_BAR; }
    PG8_BAR;
    if constexpr (Epi::AFTER_DRAIN) { E.fused(acc, cur, wr, wc, fr, fq, lds, wid, lane); S.done(cur); }
#undef PG8_SA
#undef PG8_SB
#undef PG8_STAGE
#undef PG8_LDA
#undef PG8_LDB
#undef PG8_MMA
#undef PG8_WAIT_V
#undef PG8_WAIT_L
#undef PG8_BAR
#undef PG8_SCHED
}
}

namespace pg8 {
struct EpiProj {
    static constexpr bool PERM = true, AFTER_DRAIN = false;
    bf16_t* O;
    __device__ __forceinline__ void operator()(const f32x4 (&acc)[2][2][4][2], const Unit& u, int wr, int wc, int fr, int fq) const {
        const int row0 = u.pm * BM + wr * 64 + fr, col0 = u.pn * BM + wc * 32 + 8 * fq;
        const float sc = (u.pn == 6 || u.pn == 7) ? QSCALE : 1.f;
        const __amdgpu_buffer_rsrc_t rs = wt_rsrc(O, (unsigned)((size_t)16384 * N1 * 2));
#pragma unroll
        for (int ai = 0; ai < 2; ++ai)
#pragma unroll
            for (int m = 0; m < 4; ++m) { const unsigned rowb = (unsigned)(((size_t)(row0 + ai * HALF + m * 16) * N1 + col0) * 2);
#pragma unroll
                for (int bj = 0; bj < 2; ++bj) { const f32x4 v0 = acc[ai][bj][m][0] * sc, v1 = acc[ai][bj][m][1] * sc;
                    u32x4 w; w.x = cvt_pk_bf16(v0[0], v0[1]); w.y = cvt_pk_bf16(v0[2], v0[3]); w.z = cvt_pk_bf16(v1[0], v1[1]); w.w = cvt_pk_bf16(v1[2], v1[3]);
                    wt16(rs, rowb + bj * HALF * 2, w); } }
    }
};
struct EpiBf16 {
    static constexpr bool PERM = true, AFTER_DRAIN = false;
    bf16_t* O; int ldc;
    __device__ __forceinline__ void operator()(const f32x4 (&acc)[2][2][4][2], const Unit& u, int wr, int wc, int fr, int fq) const {
        const int row0 = u.pm * BM + wr * 64 + fr, col0 = u.pn * BM + wc * 32 + 8 * fq;
#pragma unroll
        for (int ai = 0; ai < 2; ++ai)
#pragma unroll
            for (int m = 0; m < 4; ++m) { bf16_t* rowp = O + (size_t)(row0 + ai * HALF + m * 16) * ldc + col0;
#pragma unroll
                for (int bj = 0; bj < 2; ++bj) { const f32x4 v0 = acc[ai][bj][m][0], v1 = acc[ai][bj][m][1];
                    u32x4 w; w.x = cvt_pk_bf16(v0[0], v0[1]); w.y = cvt_pk_bf16(v0[2], v0[3]); w.z = cvt_pk_bf16(v1[0], v1[1]); w.w = cvt_pk_bf16(v1[2], v1[3]);
                    *(u32x4*)(rowp + bj * HALF) = w; } }
    }
};
__device__ __forceinline__ void rms_exchange(const f32x4 (&v)[2][2][4][2], const Unit& u, int wr, int wc, int fr, int fq, PG8_LAS unsigned char* lds, int wid, int lane, float* xbuf, unsigned* cnt) {
    PG8_LAS float* P = (PG8_LAS float*)lds;
    PG8_LAS float* S = (PG8_LAS float*)(lds + 4096);
#pragma unroll
    for (int ai = 0; ai < 2; ++ai)
#pragma unroll
        for (int m = 0; m < 4; ++m) {
            float s = 0.f;
#pragma unroll
            for (int bj = 0; bj < 2; ++bj)
#pragma unroll
                for (int n = 0; n < 2; ++n) { const f32x4 x = v[ai][bj][m][n]; s += (x[0] * x[0] + x[1] * x[1]) + (x[2] * x[2] + x[3] * x[3]); }
            s += __shfl_xor(s, 16); s += __shfl_xor(s, 32);
            if (fq == 0) P[(ai * HALF + wr * 64 + m * 16 + fr) * 4 + wc] = s;
        }
    asm volatile("s_waitcnt lgkmcnt(0)" ::: "memory"); __builtin_amdgcn_s_barrier(); asm volatile("" ::: "memory");
    const int row = wid * 32 + (lane & 31);
    if (lane < 32) {
        const float tot = (P[row * 4 + 0] + P[row * 4 + 1]) + (P[row * 4 + 2] + P[row * 4 + 3]);
        __hip_atomic_store((unsigned*)xbuf + (size_t)(u.pm * BM + row) * 4 + u.pn, __builtin_bit_cast(unsigned, tot), __ATOMIC_RELAXED, __HIP_MEMORY_SCOPE_AGENT);
    }
    asm volatile("s_waitcnt vmcnt(0)" ::: "memory");
    if (lane == 0) __hip_atomic_fetch_add(cnt + 64 * u.pm, 1u, __ATOMIC_RELAXED, __HIP_MEMORY_SCOPE_AGENT);
    if (wid == 0) {
        unsigned sp = 0u;
        while ((unsigned)__builtin_amdgcn_readfirstlane(__hip_atomic_load(cnt + 64 * u.pm, __ATOMIC_RELAXED, __HIP_MEMORY_SCOPE_AGENT)) < 32u) { __builtin_amdgcn_s_sleep(2); if (++sp > (1u << 22)) break; }
        __builtin_amdgcn_fence(__ATOMIC_ACQUIRE, "agent");
    }
    asm volatile("s_waitcnt vmcnt(0) lgkmcnt(0)" ::: "memory"); __builtin_amdgcn_s_barrier(); asm volatile("" ::: "memory");
    if (lane < 32) {
        const unsigned* slot = (const unsigned*)xbuf + (size_t)(u.pm * BM + row) * 4; float q = 0.f;
#pragma unroll
        for (int t = 0; t < 4; ++t) q += __builtin_bit_cast(float, __hip_atomic_load(slot + t, __ATOMIC_RELAXED, __HIP_MEMORY_SCOPE_AGENT));
        S[row] = rsqrtf(q * (1.f / 1024.f) + 1e-6f);
    }
    asm volatile("s_waitcnt vmcnt(0) lgkmcnt(0)" ::: "memory"); __builtin_amdgcn_s_barrier(); asm volatile("" ::: "memory");
}
struct EpiRmsRes {
    static constexpr bool PERM = false, AFTER_DRAIN = true;
    const bf16_t* x1b; float* out; const float* gain; float* xbuf; unsigned* cnt;
    __device__ __forceinline__ void fused(f32x4 (&acc)[2][2][4][2], const Unit& u, int wr, int wc, int fr, int fq, PG8_LAS unsigned char* lds, int wid, int lane) const {
        typedef unsigned u32x2v __attribute__((ext_vector_type(2)));
        const PG8_LAS float* S = (const PG8_LAS float*)(lds + 4096);
        const int col0 = u.pn * BM + wc * 32 + 4 * fq;
        u32x2v pre[2][4][2][2];
#pragma unroll
        for (int ai = 0; ai < 2; ++ai)
#pragma unroll
            for (int m = 0; m < 4; ++m) { const size_t off = (size_t)(u.pm * BM + ai * HALF + wr * 64 + m * 16 + fr) * 1024 + col0;
#pragma unroll
                for (int bj = 0; bj < 2; ++bj)
#pragma unroll
                    for (int n = 0; n < 2; ++n) pre[ai][m][bj][n] = *(const u32x2v*)(x1b + off + bj * HALF + n * 16); }
        rms_exchange(acc, u, wr, wc, fr, fq, lds, wid, lane, xbuf, cnt);
        f32x4 gv[2][2];
#pragma unroll
        for (int bj = 0; bj < 2; ++bj)
#pragma unroll
            for (int n = 0; n < 2; ++n) gv[bj][n] = *(const f32x4*)(gain + col0 + bj * HALF + n * 16);
#pragma unroll
        for (int ai = 0; ai < 2; ++ai)
#pragma unroll
            for (int m = 0; m < 4; ++m) { const int r = ai * HALF + wr * 64 + m * 16 + fr; const float rs = S[r]; const size_t off = (size_t)(u.pm * BM + r) * 1024 + col0;
#pragma unroll
                for (int bj = 0; bj < 2; ++bj)
#pragma unroll
                    for (int n = 0; n < 2; ++n) { const u32x2v pv = pre[ai][m][bj][n];
                        const f32x4 bs = {__builtin_bit_cast(float, pv.x << 16), __builtin_bit_cast(float, pv.x & 0xffff0000u), __builtin_bit_cast(float, pv.y << 16), __builtin_bit_cast(float, pv.y & 0xffff0000u)};
                        __builtin_nontemporal_store(bs + acc[ai][bj][m][n] * rs * gv[bj][n], (f32x4*)(out + off + bj * HALF + n * 16)); } }
    }
};
struct EpiRmsResRms {
    static constexpr bool PERM = false, AFTER_DRAIN = true;
    const float* x; bf16_t* x1b; bf16_t* h2; const float* g1; const float* g2; float* xbuf1; unsigned* cnt1; float* xbuf2; unsigned* cnt2;
    __device__ __forceinline__ void fused(f32x4 (&acc)[2][2][4][2], const Unit& u, int wr, int wc, int fr, int fq, PG8_LAS unsigned char* lds, int wid, int lane) const {
        typedef unsigned u32x2v __attribute__((ext_vector_type(2)));
        const PG8_LAS float* S = (const PG8_LAS float*)(lds + 4096);
        const int col0 = u.pn * BM + wc * 32 + 4 * fq;
        rms_exchange(acc, u, wr, wc, fr, fq, lds, wid, lane, xbuf1, cnt1);
        {
            f32x4 gv[2][2];
#pragma unroll
            for (int bj = 0; bj < 2; ++bj)
#pragma unroll
                for (int n = 0; n < 2; ++n) gv[bj][n] = *(const f32x4*)(g1 + col0 + bj * HALF + n * 16);
#pragma unroll
            for (int ai = 0; ai < 2; ++ai)
#pragma unroll
                for (int m = 0; m < 4; ++m) { const int r = ai * HALF + wr * 64 + m * 16 + fr; const float rs = S[r]; const size_t off = (size_t)(u.pm * BM + r) * 1024 + col0;
#pragma unroll
                    for (int bj = 0; bj < 2; ++bj)
#pragma unroll
                        for (int n = 0; n < 2; ++n) { const f32x4 bs = __builtin_nontemporal_load((const f32x4*)(x + off + bj * HALF + n * 16)); acc[ai][bj][m][n] = bs + acc[ai][bj][m][n] * rs * gv[bj][n]; }
                    asm volatile("" : "+v"(acc[ai][0][m][0]), "+v"(acc[ai][0][m][1]), "+v"(acc[ai][1][m][0]), "+v"(acc[ai][1][m][1]));
                    if (m & 1) asm volatile("" ::: "memory"); }
        }
        rms_exchange(acc, u, wr, wc, fr, fq, lds, wid, lane, xbuf2, cnt2);
        f32x4 gv[2][2];
#pragma unroll
        for (int bj = 0; bj < 2; ++bj)
#pragma unroll
            for (int n = 0; n < 2; ++n) gv[bj][n] = *(const f32x4*)(g2 + col0 + bj * HALF + n * 16);
#pragma unroll
        for (int ai = 0; ai < 2; ++ai)
#pragma unroll
            for (int m = 0; m < 4; ++m) { const int r = ai * HALF + wr * 64 + m * 16 + fr; const float rs = S[r]; const size_t off = (size_t)(u.pm * BM + r) * 1024 + col0;
#pragma unroll
                for (int bj = 0; bj < 2; ++bj)
#pragma unroll
                    for (int n = 0; n < 2; ++n) { const f32x4 x1 = acc[ai][bj][m][n]; { u32x2v xw; xw.x = cvt_pk_bf16(x1[0], x1[1]); xw.y = cvt_pk_bf16(x1[2], x1[3]); *(u32x2v*)(x1b + off + bj * HALF + n * 16) = xw; }
                        const f32x4 o = x1 * rs * gv[bj][n]; u32x2v w; w.x = cvt_pk_bf16(o[0], o[1]); w.y = cvt_pk_bf16(o[2], o[3]); *(u32x2v*)(h2 + off + bj * HALF + n * 16) = w; }
                asm volatile("" ::: "memory"); }
    }
};
struct EpiF32 {
    static constexpr bool PERM = true, AFTER_DRAIN = false;
    float* O; int ldc;
    __device__ __forceinline__ void operator()(const f32x4 (&acc)[2][2][4][2], const Unit& u, int wr, int wc, int fr, int fq) const {
        const int row0 = u.pm * BM + wr * 64 + fr, col0 = u.pn * BM + wc * 32 + 8 * fq;
#pragma unroll
        for (int ai = 0; ai < 2; ++ai)
#pragma unroll
            for (int m = 0; m < 4; ++m) { float* rowp = O + (size_t)(row0 + ai * HALF + m * 16) * ldc + col0;
#pragma unroll
                for (int bj = 0; bj < 2; ++bj) { *(f32x4*)(rowp + bj * HALF) = acc[ai][bj][m][0]; *(f32x4*)(rowp + bj * HALF + 4) = acc[ai][bj][m][1]; } }
    }
};
struct EpiSwiglu {
    static constexpr bool PERM = true, AFTER_DRAIN = false;
    bf16_t* O;
    __device__ __forceinline__ void operator()(const f32x4 (&acc)[2][2][4][2], const Unit& u, int wr, int wc, int fr, int fq) const {
        const int row0 = u.pm * BM + wr * 64 + fr, col0 = u.pn * HALF + wc * 32 + 8 * fq;
        const __amdgpu_buffer_rsrc_t rs = wt_rsrc(O, 96u << 20);
        const unsigned bshift = (unsigned)(u.pm >> 3) << 20;
#pragma unroll
        for (int ai = 0; ai < 2; ++ai)
#pragma unroll
            for (int m = 0; m < 4; ++m) { const unsigned rowb = (unsigned)(((size_t)(row0 + ai * HALF + m * 16) * DFF + col0) * 2) + bshift;
                float r[8];
#pragma unroll
                for (int n = 0; n < 2; ++n)
#pragma unroll
                    for (int e = 0; e < 4; ++e) { const float g = acc[ai][0][m][n][e], up = acc[ai][1][m][n][e];
                        r[4 * n + e] = g * __builtin_amdgcn_rcpf(1.f + __expf(-g)) * up; }
                u32x4 w; w.x = cvt_pk_bf16(r[0], r[1]); w.y = cvt_pk_bf16(r[2], r[3]); w.z = cvt_pk_bf16(r[4], r[5]); w.w = cvt_pk_bf16(r[6], r[7]);
                wt16(rs, rowb, w); }
    }
};
}

struct Args {
    const float* x; const float* pre_mix_gain; const float* w_in; const float* conv_w; const float* conv_b; const float* dt_bias; const float* a_log; const float* d_skip;
    const float* ssd_norm_gain; const float* sb_norm_gain; const float* w_out; const float* post_mix_gain; const float* pre_ffn_gain; const float* w_gate; const float* w_up;
    const float* w_down; const float* post_ffn_gain; float* out; unsigned char* ws; int ph_lo, ph_hi;
};

__device__ __forceinline__ void transpose_item(const float* src, int ldw, bf16* dst, int K, LAS float* scr, int lane, __amdgpu_buffer_rsrc_t wr, const bf16* wbase) {
    float tv[32];
#pragma unroll
    for (int i = 0; i < 32; ++i) tv[i] = __builtin_nontemporal_load(src + (size_t)(2 * i + (lane >> 5)) * ldw + (lane & 31));
#pragma unroll
    for (int i = 0; i < 32; ++i) scr[(2 * i + (lane >> 5)) * 33 + (lane & 31)] = tv[i];
    asm volatile("s_waitcnt lgkmcnt(0)" ::: "memory");
    const int c = lane & 7;
#pragma unroll
    for (int j = 0; j < 4; ++j) { const int n = (lane >> 3) + 8 * j; const LAS float* s = scr + (8 * c) * 33 + n;
        v4u o; o.x = pk2(s[0 * 33], s[1 * 33]); o.y = pk2(s[2 * 33], s[3 * 33]); o.z = pk2(s[4 * 33], s[5 * 33]); o.w = pk2(s[6 * 33], s[7 * 33]);
        wt16(wr, (unsigned)((dst + (size_t)n * K + 8 * c - wbase) * 2), o); }
    asm volatile("s_waitcnt lgkmcnt(0)" ::: "memory");
}

__device__ __forceinline__ void phase_p0(const Args& a, LAS unsigned char* lds, bool defer_w4) {
    const int tid = threadIdx.x, lane = tid & 63, wave = tid >> 6;
    const int gw = blockIdx.x * NWAVES + wave, NGW = gridDim.x * NWAVES;
    unsigned char* ws = a.ws;
    LAS float* scr = (LAS float*)(lds + wave * 8704);
    LAS float* wdt = (LAS float*)(lds + 73728);
    for (int i = tid; i < 8192; i += NTHR) { const int hd = i & 7, k = i >> 3; wdt[hd * 1024 + k] = a.w_in[(size_t)k * DIN + 1536 + hd]; }
    __syncthreads();
    bf16* W1 = (bf16*)(ws + WS_W1); bf16* W2 = (bf16*)(ws + WS_W2); bf16* W3 = (bf16*)(ws + WS_W3); bf16* W4 = (bf16*)(ws + WS_W4);
    const __amdgpu_buffer_rsrc_t wrs = wt_rsrc(W1, 25u << 20);
    constexpr int I1 = 16 * 48, I2 = 16 * 32, I3 = 16 * 88, I4 = 44 * 32;
    const int NITEMS = 2 * I1 + I2 + 2 * I3 + (defer_w4 ? 0 : I4);
    for (int _rp = 0; _rp < 1 + (((REPMASK) >> 12) & 1); ++_rp)
    for (int it = gw; it < NITEMS; it += NGW) {
        int r = it;
        if (r < I1) { const int kb = r / 48, nb = r % 48; transpose_item(a.w_in + (size_t)(64 * kb) * DIN + 32 * nb, DIN, W1 + (size_t)(32 * nb) * 1024 + 64 * kb, 1024, scr, lane, wrs, W1); continue; } r -= I1;
        if (r < I1) { const int kb = r / 48, nb = r % 48; transpose_item(a.w_in + (size_t)(64 * kb) * DIN + 1544 + 32 * nb, DIN, W1 + (size_t)(1536 + 32 * nb) * 1024 + 64 * kb, 1024, scr, lane, wrs, W1); continue; } r -= I1;
        if (r < I2) { const int kb = r / 32, nb = r % 32; transpose_item(a.w_out + (size_t)(64 * kb) * 1024 + 32 * nb, 1024, W2 + (size_t)(32 * nb) * 1024 + 64 * kb, 1024, scr, lane, wrs, W1); continue; } r -= I2;
        if (r < I3) { const int kb = r / 88, nb = r % 88, n0 = 32 * nb; transpose_item(a.w_gate + (size_t)(64 * kb) * DFF + n0, DFF, W3 + (size_t)(256 * (n0 >> 7) + (n0 & 127)) * 1024 + 64 * kb, 1024, scr, lane, wrs, W1); continue; } r -= I3;
        if (r < I3) { const int kb = r / 88, nb = r % 88, n0 = 32 * nb; transpose_item(a.w_up + (size_t)(64 * kb) * DFF + n0, DFF, W3 + (size_t)(256 * (n0 >> 7) + 128 + (n0 & 127)) * 1024 + 64 * kb, 1024, scr, lane, wrs, W1); continue; } r -= I3;
        { const int kb = r / 32, nb = r % 32; transpose_item(a.w_down + (size_t)(64 * kb) * 1024 + 32 * nb, 1024, W4 + (size_t)(32 * nb) * DFF + 64 * kb, DFF, scr, lane, wrs, W1); }
    }
    bf16* H = (bf16*)(ws + WS_H); float* DT = (float*)(ws + WS_DT);
    const int hh = lane >> 5, b4 = (lane >> 4) & 1, b3 = (lane >> 3) & 1;
    v4f gpm[4];
#pragma unroll
    for (int j = 0; j < 4; ++j) gpm[j] = ((const v4f*)a.pre_mix_gain)[lane + 64 * j];
    v4f v[4], vn[4];
    if (gw < M) {
#pragma unroll
        for (int j = 0; j < 4; ++j) v[j] = __builtin_nontemporal_load((const v4f*)(a.x + (size_t)gw * DM) + lane + 64 * j);
    }
    for (int _rq = 0; _rq < 1 + (((REPMASK) >> 13) & 1); ++_rq)
    for (int m = gw; m < M; m += NGW) {
        const int mn = m + NGW < M ? m + NGW : gw;
        if (true) {
#pragma unroll
            for (int j = 0; j < 4; ++j) vn[j] = __builtin_nontemporal_load((const v4f*)(a.x + (size_t)mn * DM) + lane + 64 * j);
        }
        float s = 0.f;
#pragma unroll
        for (int j = 0; j < 4; ++j) s += (v[j].x * v[j].x + v[j].y * v[j].y) + (v[j].z * v[j].z + v[j].w * v[j].w);
        const float rstd = rsqrtf(wave_sum(s) * (1.f / DM) + EPS);
        float da[8];
#pragma unroll
        for (int hd = 0; hd < 8; ++hd) da[hd] = 0.f;
        unsigned long long* o8 = (unsigned long long*)(H + (size_t)m * DM) + lane;
#pragma unroll
        for (int j = 0; j < 4; ++j) {
            const v4f hv = v[j] * rstd * gpm[j];
            wt8(o8 + 64 * j, pk2(hv.x, hv.y), pk2(hv.z, hv.w));
#pragma unroll
            for (int hd = 0; hd < 8; ++hd) { const v4f w = *(const LAS v4f*)(wdt + hd * 1024 + 4 * lane + 256 * j); da[hd] += (hv.x * w.x + hv.y * w.y) + (hv.z * w.z + hv.w * w.w); }
        }
        float k4[4], k2[2], k1;
#pragma unroll
        for (int i = 0; i < 4; ++i) { const float keep = hh ? da[4 + i] : da[i], send = hh ? da[i] : da[4 + i]; k4[i] = keep + __shfl_xor(send, 32); }
#pragma unroll
        for (int i = 0; i < 2; ++i) { const float keep = b4 ? k4[2 + i] : k4[i], send = b4 ? k4[i] : k4[2 + i]; k2[i] = keep + __shfl_xor(send, 16); }
        { const float keep = b3 ? k2[1] : k2[0], send = b3 ? k2[0] : k2[1]; k1 = keep + __shfl_xor(send, 8); }
        k1 += __shfl_xor(k1, 4); k1 += __shfl_xor(k1, 2); k1 += __shfl_xor(k1, 1);
        if ((lane & 7) == 0) DT[(size_t)m * 8 + (lane >> 3)] = k1;
#pragma unroll
        for (int j = 0; j < 4; ++j) v[j] = vn[j];
    }
}

__device__ __forceinline__ void phase_w4(const Args& a, LAS unsigned char* lds) {
    if (blockIdx.x < 128) return;
    const int lane = threadIdx.x & 63, wave = threadIdx.x >> 6, gw = (blockIdx.x - 128) * NWAVES + wave, NGW = 128 * NWAVES;
    LAS float* scr = (LAS float*)(lds + wave * 8704);
    bf16* W1 = (bf16*)(a.ws + WS_W1); bf16* W4 = (bf16*)(a.ws + WS_W4);
    const __amdgpu_buffer_rsrc_t wrs = wt_rsrc(W1, 25u << 20);
    for (int r = gw; r < 44 * 32; r += NGW) { const int kb = r / 32, nb = r % 32; transpose_item(a.w_down + (size_t)(64 * kb) * 1024 + 32 * nb, 1024, W4 + (size_t)(32 * nb) * DFF + 64 * kb, DFF, scr, lane, wrs, W1); }
}

__device__ __forceinline__ void phase_conv_naive(const Args& a) {
    const bf16* PROJ = (const bf16*)(a.ws + WS_PROJ); float* XC = (float*)(a.ws + WS_CS);
    const size_t total = (size_t)M * 1024, stride = (size_t)gridDim.x * NTHR;
    for (size_t idx = (size_t)blockIdx.x * NTHR + threadIdx.x; idx < total; idx += stride) {
        const int m = (int)(idx >> 10), ch = (int)(idx & 1023), t = m & (SEQ - 1);
        float acc = a.conv_b[ch];
#pragma unroll
        for (int j = 0; j < 4; ++j) { const int tt = t - 3 + j; if (tt >= 0) acc += a.conv_w[j * 1024 + ch] * bf2f(PROJ[(size_t)(m - 3 + j) * N1 + PX + ch]); }
        XC[idx] = siluf(acc);
    }
}

__device__ __forceinline__ void phase_ssd_naive(const Args& a, LAS unsigned char* lds) {
    if (blockIdx.x >= 16) return;
    const int tid = threadIdx.x, lane = tid & 63, wave = tid >> 6;
    const int b = blockIdx.x >> 1, g = blockIdx.x & 1;
    const bool act = tid < 256;
    const int hl = (tid >> 6) & 3, p = tid & 63, h = 4 * g + hl;
    const bf16* PROJ = (const bf16*)(a.ws + WS_PROJ); const float* XC = (const float*)(a.ws + WS_CS); const float* DT = (const float*)(a.ws + WS_DT);
    bf16* YC = (bf16*)(a.ws + WS_H);
    LAS float* sBC = (LAS float*)lds; LAS float* red = (LAS float*)(lds + 1024);
    float st[128];
#pragma unroll
    for (int n = 0; n < 128; ++n) st[n] = 0.f;
    const float av = -__expf(a.a_log[h]), dtb = a.dt_bias[h], dsk = a.d_skip[h], gain = a.ssd_norm_gain[g * 256 + hl * 64 + p];
    for (int t = 0; t < SEQ; ++t) {
        const size_t m = (size_t)b * SEQ + t;
        if (act) sBC[tid] = XC[m * 1024 + (tid < 128 ? 512 + g * 128 + tid : 768 + g * 128 + (tid - 128))];
        __syncthreads();
        float y = 0.f;
        if (act) {
            const float dt = softplusf(DT[m * 8 + h] + dtb), dA = __expf(dt * av), xv = XC[m * 1024 + h * 64 + p], dx = dt * xv;
#pragma unroll
            for (int n = 0; n < 128; ++n) { st[n] = st[n] * dA + dx * sBC[n]; y += sBC[128 + n] * st[n]; }
            y += dsk * xv;
            y *= siluf(bf2f(PROJ[m * N1 + PZ + h * 64 + p]));
        }
        const float ss = wave_sum(y * y);
        if (lane == 0) red[wave] = ss;
        __syncthreads();
        const float tot = (red[0] + red[1]) + (red[2] + red[3]);
        if (act) YC[m * 1024 + h * 64 + p] = (bf16)f2bf(y * rsqrtf(tot * (1.f / 256.f) + EPS) * gain);
    }
}

__device__ __forceinline__ void phase_attn_naive(const Args& a, LAS unsigned char* lds) {
    const int tid = threadIdx.x;
    const bf16* PROJ = (const bf16*)(a.ws + WS_PROJ); bf16* YC = (bf16*)(a.ws + WS_H);
    LAS float* sK = (LAS float*)(lds + 4096); LAS float* sV = (LAS float*)(lds + 4096 + 16384);
    for (int unit = blockIdx.x; unit < 256; unit += gridDim.x) {
        const int b = unit >> 5, h = (unit >> 2) & 7, qb = unit & 3;
        const int t = qb * 512 + tid; const size_t m = (size_t)b * SEQ + t;
        float q[64], o[64];
#pragma unroll
        for (int d = 0; d < 64; ++d) { q[d] = bf2f(PROJ[m * N1 + PQ + h * 64 + d]); o[d] = 0.f; }
        float P = 1.f;
        for (int kt = qb * 8 + 7; kt >= 0; --kt) {
            __syncthreads();
#pragma unroll
            for (int i = 0; i < 8; ++i) { const int idx = tid + 512 * i, key = idx >> 6, d = idx & 63; const size_t mk = (size_t)b * SEQ + kt * 64 + key;
                sK[idx] = bf2f(PROJ[mk * N1 + PK + h * 64 + d]); sV[idx] = bf2f(PROJ[mk * N1 + PV + h * 64 + d]); }
            __syncthreads();
            for (int kk = 63; kk >= 0; --kk) {
                const int s = kt * 64 + kk;
                if (s < t) {
                    float z = 0.f;
#pragma unroll
                    for (int d = 0; d < 64; ++d) z += q[d] * sK[kk * 64 + d];
                    z = fminf(z, 100.f);
                    const float e = exp2f(z), r = 1.f / (1.f + e);
                    P *= r;
                    const float w = e * P;
#pragma unroll
                    for (int d = 0; d < 64; ++d) o[d] += w * sV[kk * 64 + d];
                }
            }
        }
        float ss = 0.f;
#pragma unroll
        for (int d = 0; d < 64; ++d) ss += o[d] * o[d];
        const float rstd = rsqrtf(ss * (1.f / 64.f) + EPS);
#pragma unroll
        for (int d = 0; d < 64; ++d) YC[m * 1024 + 512 + h * 64 + d] = (bf16)f2bf(o[d] * rstd * a.sb_norm_gain[h * 64 + d]);
    }
}


typedef short v4i16 __attribute__((ext_vector_type(4)));
typedef short bf16x8v __attribute__((ext_vector_type(8)));
constexpr int AT_KSTR = 144, AT_KBYTES = 64 * AT_KSTR, AT_VBYTES = 64 * 128, AT_BUF = AT_KBYTES + AT_VBYTES;
#define MFMA32(a, b, c) __builtin_amdgcn_mfma_f32_32x32x16_bf16((a), (b), (c), 0, 0, 0)

template <bool DIAG>
__device__ __forceinline__ void attn_tile(LAS const unsigned char* Kb, LAS const unsigned char* Vb, const bf16x8v (&qf)[4], f32x16& o0, f32x16& o1, float& carry,
                                          int qrel, int l32, int hh, unsigned vbase0, unsigned vbase1) {
    f32x16 p[2];
    bf16x8v kf[2][4];
#pragma unroll
    for (int blk = 0; blk < 2; ++blk)
#pragma unroll
        for (int s = 0; s < 4; ++s) kf[blk][s] = *(LAS const bf16x8v*)(Kb + (32 * blk + l32) * AT_KSTR + 32 * s + 16 * hh);
    asm volatile("s_waitcnt lgkmcnt(0)" ::: "memory");
#pragma unroll
    for (int bi = 0; bi < 2; ++bi) {
        const int blk = 1 - bi;
#pragma unroll
        for (int i = 0; i < 16; ++i) p[blk][i] = 0.f;
#pragma unroll
        for (int s = 0; s < 4; ++s) p[blk] = MFMA32(kf[blk][s], qf[s], p[blk]);
    }
#pragma unroll
    for (int bi = 0; bi < 2; ++bi) {
        const int blk = 1 - bi;
        float R[16];
#pragma unroll
        for (int i = 0; i < 16; ++i) {
            float rv = __builtin_amdgcn_rcpf(1.f + __builtin_amdgcn_exp2f(p[blk][i]));
            if (DIAG) { const int krel = 32 * blk + (i & 3) + 8 * (i >> 2) + 4 * hh; if (krel >= qrel) rv = 1.f; }
            R[i] = rv;
        }
        float GG[4], sel[4];
#pragma unroll
        for (int g = 0; g < 4; ++g) { R[4 * g + 2] *= R[4 * g + 3]; R[4 * g + 1] *= R[4 * g + 2]; R[4 * g] *= R[4 * g + 1]; }
#pragma unroll
        for (int g = 0; g < 4; g += 2) {
            const unsigned ua = __builtin_bit_cast(unsigned, R[4 * g]), ub = __builtin_bit_cast(unsigned, R[4 * g + 4]);
            auto s1 = __builtin_amdgcn_permlane32_swap(ua, ub, false, false);
            auto s2 = __builtin_amdgcn_permlane32_swap(ub, ua, false, false);
            const float pa = __builtin_bit_cast(float, hh ? s2[0] : s1[1]), pb2 = __builtin_bit_cast(float, hh ? s1[0] : s2[1]);
            GG[g] = R[4 * g] * pa; GG[g + 1] = R[4 * g + 4] * pb2;
            sel[g] = hh ? 1.f : pa; sel[g + 1] = hh ? 1.f : pb2;
        }
        float T3 = carry, T2 = T3 * GG[3], T1 = T2 * GG[2], T0 = T1 * GG[1];
        carry = T0 * GG[0];
        const float base[4] = {T0 * sel[0], T1 * sel[1], T2 * sel[2], T3 * sel[3]};
        float w[16];
#pragma unroll
        for (int g = 0; g < 4; ++g) {
            w[4 * g + 3] = base[g] * (1.f - R[4 * g + 3]); w[4 * g + 2] = base[g] * (R[4 * g + 3] - R[4 * g + 2]);
            w[4 * g + 1] = base[g] * (R[4 * g + 2] - R[4 * g + 1]); w[4 * g] = base[g] * (R[4 * g + 1] - R[4 * g]);
        }
#pragma unroll
        for (int s = 0; s < 2; ++s) {
            v4u pk; pk.x = cvtpk(w[8 * s], w[8 * s + 1]); pk.y = cvtpk(w[8 * s + 2], w[8 * s + 3]); pk.z = cvtpk(w[8 * s + 4], w[8 * s + 5]); pk.w = cvtpk(w[8 * s + 6], w[8 * s + 7]);
            const bf16x8v pb = __builtin_bit_cast(bf16x8v, pk);
            const int rowoff = (32 * blk + 16 * s) * 128;
            const v4i16 a0l = __builtin_amdgcn_ds_read_tr16_b64_v4i16((LAS v4i16*)(Vb + vbase0 + rowoff));
            const v4i16 a0h = __builtin_amdgcn_ds_read_tr16_b64_v4i16((LAS v4i16*)(Vb + vbase0 + rowoff + 8 * 128));
            const v4i16 a1l = __builtin_amdgcn_ds_read_tr16_b64_v4i16((LAS v4i16*)(Vb + vbase1 + rowoff));
            const v4i16 a1h = __builtin_amdgcn_ds_read_tr16_b64_v4i16((LAS v4i16*)(Vb + vbase1 + rowoff + 8 * 128));
            const bf16x8v va0 = __builtin_shufflevector(a0l, a0h, 0, 1, 2, 3, 4, 5, 6, 7), va1 = __builtin_shufflevector(a1l, a1h, 0, 1, 2, 3, 4, 5, 6, 7);
            o0 = MFMA32(va0, pb, o0); o1 = MFMA32(va1, pb, o1);
        }
    }
}

__device__ __forceinline__ void attn_unit(const Args& a, LAS unsigned char* lds, int b, int h, int qb) {
    const int tid = threadIdx.x, lane = tid & 63, w = __builtin_amdgcn_readfirstlane(tid >> 6), l32 = lane & 31, hh = lane >> 5;
    const bf16* PROJ = (const bf16*)(a.ws + WS_PROJ); bf16* YC = (bf16*)(a.ws + WS_H);
    const size_t rowbase = (size_t)b * SEQ;
    const int q0 = qb * 256 + 32 * w, ktd = q0 >> 6, ktmax = 4 * qb + 3, qrel = 32 * (w & 1) + l32;
    bf16x8v qf[4];
    { const bf16* qp = PROJ + (rowbase + q0 + l32) * N1 + PQ + h * 64 + 8 * hh;
#pragma unroll
      for (int s = 0; s < 4; ++s) qf[s] = *(const bf16x8v*)(qp + 16 * s); }
    f32x16 o0, o1;
#pragma unroll
    for (int i = 0; i < 16; ++i) { o0[i] = 0.f; o1[i] = 0.f; }
    float carry = 1.f;
    const int skey = tid >> 3, sc = tid & 7;
    const bf16* kg = PROJ + (rowbase + skey) * N1 + PK + h * 64 + 8 * sc;
    const unsigned kwoff = skey * AT_KSTR + sc * 16, vwoff = AT_KBYTES + skey * 128 + ((sc * 16) ^ (((skey >> 1) & 1) << 6));
    const int gi = (lane >> 4) & 1, q4 = (lane & 15) >> 2, pp = lane & 3;
    const unsigned vb = (4 * hh + q4) * 128 + 32 * gi + 8 * pp, xq = (q4 >> 1) << 6;
    const unsigned vbase0 = vb + xq, vbase1 = vb + (64 ^ xq);
    LAS unsigned* dflag = (LAS unsigned*)(lds + 6 * AT_BUF);
    bool wdone = false;
    const int tlo = ktmax >= 5 ? ktmax - 5 : 0, nwin = ktmax - tlo + 1;
    {
        v4u kr[6], vr[6];
#pragma unroll
        for (int i = 0; i < 6; ++i) if (i < nwin) { const size_t t = (size_t)(tlo + i) * 64 * N1; kr[i] = *(const v4u*)(kg + t); vr[i] = *(const v4u*)(kg + t + (PV - PK)); }
#pragma unroll
        for (int i = 0; i < 6; ++i) if (i < nwin) { *(LAS v4u*)(lds + i * AT_BUF + kwoff) = kr[i]; *(LAS v4u*)(lds + i * AT_BUF + vwoff) = vr[i]; }
    }
    __syncthreads();
#pragma unroll 1
    for (int kt = ktd; kt >= tlo; --kt) {
        if (!wdone) {
            LAS unsigned char* bt = lds + (kt - tlo) * AT_BUF;
            if (kt == ktd) attn_tile<true>(bt, bt + AT_KBYTES, qf, o0, o1, carry, qrel, l32, hh, vbase0, vbase1);
            else attn_tile<false>(bt, bt + AT_KBYTES, qf, o0, o1, carry, qrel, l32, hh, vbase0, vbase1);
            wdone = __builtin_amdgcn_ballot_w64(carry >= 3.5527137e-15f) == 0ull;
        }
    }
    if (lane == 0) dflag[16 + w] = wdone ? 1u : 0u;
    __syncthreads();
    bool alldone;
    { const v4u f0 = *(const LAS v4u*)(dflag + 16), f1 = *(const LAS v4u*)(dflag + 20);
      alldone = __builtin_amdgcn_readfirstlane((f0.x & f0.y & f0.z & f0.w) & (f1.x & f1.y & f1.z & f1.w)) != 0u; }
    if (!alldone && tlo > 0) {
        const int npair = tlo >> 1;
        const bf16* kg2 = kg + (size_t)64 * N1;
        v4u kr0, vr0, kr1, vr1;
        { const size_t t = (size_t)(npair - 1) * 128 * N1;
          kr0 = *(const v4u*)(kg + t); vr0 = *(const v4u*)(kg + t + (PV - PK)); kr1 = *(const v4u*)(kg2 + t); vr1 = *(const v4u*)(kg2 + t + (PV - PK)); }
        *(LAS v4u*)(lds + AT_BUF + kwoff) = kr0; *(LAS v4u*)(lds + AT_BUF + vwoff) = vr0; *(LAS v4u*)(lds + kwoff) = kr1; *(LAS v4u*)(lds + vwoff) = vr1;
        __syncthreads();
        int cur = 0, it = 0;
        for (int pj = npair - 1; pj >= 0; --pj, ++it) {
            if (pj > 0) { const size_t t = (size_t)(pj - 1) * 128 * N1;
                kr0 = *(const v4u*)(kg + t); vr0 = *(const v4u*)(kg + t + (PV - PK)); kr1 = *(const v4u*)(kg2 + t); vr1 = *(const v4u*)(kg2 + t + (PV - PK)); }
            LAS unsigned char* bh = lds + cur * (2 * AT_BUF); LAS unsigned char* bl = bh + AT_BUF;
            if (!wdone) {
                attn_tile<false>(bh, bh + AT_KBYTES, qf, o0, o1, carry, qrel, l32, hh, vbase0, vbase1);
                if (__builtin_amdgcn_ballot_w64(carry >= 3.5527137e-15f) != 0ull)
                    attn_tile<false>(bl, bl + AT_KBYTES, qf, o0, o1, carry, qrel, l32, hh, vbase0, vbase1);
                wdone = __builtin_amdgcn_ballot_w64(carry >= 3.5527137e-15f) == 0ull;
            }
            if (lane == 0) dflag[(it & 1) * 8 + w] = wdone ? 1u : 0u;
            if (pj > 0) { LAS unsigned char* nb = lds + (cur ^ 1) * (2 * AT_BUF);
                *(LAS v4u*)(nb + AT_BUF + kwoff) = kr0; *(LAS v4u*)(nb + AT_BUF + vwoff) = vr0; *(LAS v4u*)(nb + kwoff) = kr1; *(LAS v4u*)(nb + vwoff) = vr1; }
            __syncthreads();
            cur ^= 1;
            const v4u f0 = *(const LAS v4u*)(dflag + (it & 1) * 8), f1 = *(const LAS v4u*)(dflag + (it & 1) * 8 + 4);
            if (__builtin_amdgcn_readfirstlane((f0.x & f0.y & f0.z & f0.w) & (f1.x & f1.y & f1.z & f1.w)) != 0u) break;
        }
    }
    float ss = 0.f;
#pragma unroll
    for (int i = 0; i < 16; ++i) ss += o0[i] * o0[i] + o1[i] * o1[i];
    ss += __shfl_xor(ss, 32);
    const float rstd = rsqrtf(ss * (1.f / 64.f) + EPS);
    bf16* yp = YC + (rowbase + q0 + l32) * 1024 + 512 + h * 64 + 4 * hh;
    const float* gp = a.sb_norm_gain + h * 64 + 4 * hh;
#pragma unroll
    for (int g = 0; g < 4; ++g) {
        const v4f g0 = *(const v4f*)(gp + 8 * g), g1 = *(const v4f*)(gp + 32 + 8 * g);
        v2u s0, s1;
        s0.x = pk2(o0[4 * g] * rstd * g0.x, o0[4 * g + 1] * rstd * g0.y); s0.y = pk2(o0[4 * g + 2] * rstd * g0.z, o0[4 * g + 3] * rstd * g0.w);
        s1.x = pk2(o1[4 * g] * rstd * g1.x, o1[4 * g + 1] * rstd * g1.y); s1.y = pk2(o1[4 * g + 2] * rstd * g1.z, o1[4 * g + 3] * rstd * g1.w);
        *(v2u*)(yp + 8 * g) = s0; *(v2u*)(yp + 32 + 8 * g) = s1;
    }
}

__device__ __forceinline__ void phase_attn(const Args& a, LAS unsigned char* lds) {
    for (int pid = blockIdx.x; pid < 256; pid += gridDim.x) {
        int bh, qp;
        if (gridDim.x == 256) { const int xcd = pid & 7, j = pid >> 3; bh = xcd * 8 + (j >> 2); qp = j & 3; }
        else { bh = pid >> 2; qp = pid & 3; }
        attn_unit(a, lds, bh >> 3, bh & 7, 7 - qp);
        attn_unit(a, lds, bh >> 3, bh & 7, qp);
    }
}

constexpr int SD_DT = 0, SD_ACS = 1024, SD_WB = 2048, SD_X = 4096, SD_XS = 576, SD_B = 40960, SD_BS = 320, SD_C = 61440, SD_Z = 81920, SD_ZS = 528;

__device__ __forceinline__ float ssd_dt_load(const Args& a, int b, int c, int g) {
    const int tid = threadIdx.x;
    if (tid >= 256) return 0.f;
    return ((const float*)(a.ws + WS_DT))[((size_t)b * SEQ + 64 * c + (tid & 63)) * 8 + 4 * g + (tid >> 6)];
}
template <bool S1>
__device__ __forceinline__ void ssd_dt(const Args& a, LAS unsigned char* lds, int b, int c, int g, float dtraw) {
    const int tid = threadIdx.x, lane = tid & 63;
    if (tid < 256) {
        const int hl = tid >> 6, h = 4 * g + hl;
        const float dtv = softplusf(dtraw + a.dt_bias[h]);
        float cs = dtv * (-__expf(a.a_log[h]));
#pragma unroll
        for (int o = 1; o < 64; o <<= 1) { const float t = __shfl_up(cs, o); if (lane >= o) cs += t; }
        ((LAS float*)(lds + SD_DT))[hl * 64 + lane] = dtv;
        ((LAS float*)(lds + SD_ACS))[hl * 64 + lane] = cs;
        if (S1) {
            const float tot = __shfl(cs, 63);
            ((LAS float*)(lds + SD_WB))[hl * 64 + lane] = __expf(tot - cs) * dtv;
            if (lane == 63) ((float*)(a.ws + WS_CD))[((size_t)b * NCH + c) * 8 + h] = __expf(tot);
        }
    }
}

struct ConvIn { unsigned halo[3]; unsigned vin[32]; };
__device__ __forceinline__ void ssd_conv_load(const Args& a, ConvIn& r, int b, int c, int th, int col) {
    const bf16* PROJ = (const bf16*)(a.ws + WS_PROJ);
    const int t0 = 64 * c + 32 * th;
    const bf16* src = PROJ + ((size_t)b * SEQ + t0) * N1 + PX + col;
#pragma unroll
    for (int j = 0; j < 3; ++j) { unsigned v = 0u; if (t0 - 3 + j >= 0) v = *(const unsigned*)(src + (ptrdiff_t)(j - 3) * N1); r.halo[j] = v; }
#pragma unroll
    for (int i = 0; i < 32; ++i) r.vin[i] = *(const unsigned*)(src + (size_t)i * N1);
}
template <bool SCALE>
__device__ __forceinline__ void ssd_conv_compute(const Args& a, const ConvIn& r, LAS unsigned char* dst, int dstride, int th, int col, const LAS float* wsc) {
    float w0[4], w1[4];
#pragma unroll
    for (int j = 0; j < 4; ++j) { w0[j] = a.conv_w[j * 1024 + col]; w1[j] = a.conv_w[j * 1024 + col + 1]; }
    const float b0 = a.conv_b[col], b1 = a.conv_b[col + 1];
    float u0[3], u1[3];
#pragma unroll
    for (int j = 0; j < 3; ++j) { u0[j] = bflo(r.halo[j]); u1[j] = bfhi(r.halo[j]); }
#pragma unroll
    for (int i = 0; i < 32; ++i) {
        const unsigned v = r.vin[i];
        const float c0 = bflo(v), c1 = bfhi(v);
        float y0 = b0 + w0[0] * u0[0] + w0[1] * u0[1] + w0[2] * u0[2] + w0[3] * c0;
        float y1 = b1 + w1[0] * u1[0] + w1[1] * u1[1] + w1[2] * u1[2] + w1[3] * c1;
        u0[0] = u0[1]; u0[1] = u0[2]; u0[2] = c0; u1[0] = u1[1]; u1[1] = u1[2]; u1[2] = c1;
        y0 = silu_fast(y0); y1 = silu_fast(y1);
        if (SCALE) { const float s = wsc[32 * th + i]; y0 *= s; y1 *= s; }
        *(LAS unsigned*)(dst + (32 * th + i) * dstride) = pk2(y0, y1);
    }
}

__device__ __forceinline__ bf16x8v tr_pair(LAS const unsigned char* p, int rowstride4) {
    const v4i16 lo = __builtin_amdgcn_ds_read_tr16_b64_v4i16((LAS v4i16*)p);
    const v4i16 hi = __builtin_amdgcn_ds_read_tr16_b64_v4i16((LAS v4i16*)(p + rowstride4));
    return __builtin_shufflevector(lo, hi, 0, 1, 2, 3, 4, 5, 6, 7);
}

__device__ __forceinline__ int ssd_item(int item);
__device__ __forceinline__ void phase_ssd_s1(const Args& a, LAS unsigned char* lds) {
    const int tid = threadIdx.x, lane = tid & 63, w = __builtin_amdgcn_readfirstlane(tid >> 6), l32 = lane & 31, hh = lane >> 5;
    const int hl = w >> 1, half = w & 1;
    const int gi = (lane >> 4) & 1, q4 = (lane & 15) >> 2, pp = lane & 3;
    bf16* CS = (bf16*)(a.ws + WS_CS);
    ConvIn cin; float dtraw = 0.f;
    const int cp = tid % 192, th = tid / 192;
    if (blockIdx.x < NB * NCH * 2) { const int it0 = ssd_item(blockIdx.x), g0 = it0 & 1, c0 = (it0 >> 1) & (NCH - 1), b0 = it0 >> 6;
        if (tid < 384) ssd_conv_load(a, cin, b0, c0, th, cp < 128 ? 256 * g0 + 2 * cp : 512 + 128 * g0 + 2 * (cp - 128));
        dtraw = ssd_dt_load(a, b0, c0, g0); }
    for (int item = blockIdx.x; item < NB * NCH * 2; item += gridDim.x) {
        const int it2 = ssd_item(item), g = it2 & 1, c = (it2 >> 1) & (NCH - 1), b = it2 >> 6;
        const int ccol = cp < 128 ? 256 * g + 2 * cp : 512 + 128 * g + 2 * (cp - 128);
        __syncthreads();
        ssd_dt<true>(a, lds, b, c, g, dtraw);
        __syncthreads();
        if (tid < 384) {
            if (cp < 128) ssd_conv_compute<true>(a, cin, lds + SD_X + 4 * cp, SD_XS, th, ccol, (const LAS float*)(lds + SD_WB) + (cp >> 5) * 64);
            else ssd_conv_compute<false>(a, cin, lds + SD_B + 4 * (cp - 128), SD_BS, th, ccol, nullptr);
        }
        __syncthreads();
        { const int itn = item + gridDim.x;
          if (itn < NB * NCH * 2) { const int in2 = ssd_item(itn), gn = in2 & 1, cn = (in2 >> 1) & (NCH - 1), bn = in2 >> 6;
              if (tid < 384) ssd_conv_load(a, cin, bn, cn, th, cp < 128 ? 256 * gn + 2 * cp : 512 + 128 * gn + 2 * (cp - 128));
              dtraw = ssd_dt_load(a, bn, cn, gn); } }
        f32x16 acc[2][2];
#pragma unroll
        for (int i = 0; i < 16; ++i) { acc[0][0][i] = 0.f; acc[0][1][i] = 0.f; acc[1][0][i] = 0.f; acc[1][1][i] = 0.f; }
#pragma unroll
        for (int s = 0; s < 4; ++s) {
            const int l0 = 16 * s + 8 * hh + q4;
            bf16x8v af[2], bfr[2];
#pragma unroll
            for (int nb = 0; nb < 2; ++nb) af[nb] = tr_pair(lds + SD_B + l0 * SD_BS + (32 * (2 * half + nb) + 16 * gi + 4 * pp) * 2, 4 * SD_BS);
#pragma unroll
            for (int pb = 0; pb < 2; ++pb) bfr[pb] = tr_pair(lds + SD_X + l0 * SD_XS + (64 * hl + 32 * pb + 16 * gi + 4 * pp) * 2, 4 * SD_XS);
#pragma unroll
            for (int nb = 0; nb < 2; ++nb)
#pragma unroll
                for (int pb = 0; pb < 2; ++pb) acc[nb][pb] = MFMA32(bfr[pb], af[nb], acc[nb][pb]);
        }
        bf16* dst = CS + ((((size_t)b * NCH + c) * 8 + 4 * g + hl) * 64) * 128;
#pragma unroll
        for (int nb = 0; nb < 2; ++nb)
#pragma unroll
            for (int pb = 0; pb < 2; ++pb)
#pragma unroll
                for (int i = 0; i < 16; ++i) { const int p = 32 * pb + (i & 3) + 8 * (i >> 2) + 4 * hh; dst[p * 128 + 32 * (2 * half + nb) + l32] = (bf16)f2bf(acc[nb][pb][i]); }
    }
}

__device__ __forceinline__ void phase_ssd_s2(const Args& a) {
    const bf16* CS = (const bf16*)(a.ws + WS_CS); const float* CD = (const float*)(a.ws + WS_CD);
    for (int gid = blockIdx.x * NTHR + threadIdx.x; gid < 64 * 2048; gid += gridDim.x * NTHR) {
        int bh = gid >> 11, e4 = gid & 2047;
        if (gridDim.x == 256) { const int blk = gid >> 9, grp = blk & 7, j = blk >> 3; bh = grp * 8 + (j >> 2); e4 = (j & 3) * 512 + (gid & 511); }
        const int b = bh >> 3, h = bh & 7;
        const v2u* p = (const v2u*)(CS + (((size_t)b * NCH) * 8 + h) * 8192) + e4;
        const float* cd = CD + (size_t)b * NCH * 8 + h;
        v2u* o = (v2u*)((bf16*)(a.ws + WS_PB) + (((size_t)b * NCH) * 8 + h) * 8192) + e4;
        v4f st = {0.f, 0.f, 0.f, 0.f};
        for (int c0 = 0; c0 < NCH; c0 += 16) {
            v2u v[16]; float d[16];
#pragma unroll
            for (int j = 0; j < 16; ++j) { v[j] = p[(size_t)(c0 + j) * 16384]; d[j] = cd[(c0 + j) * 8]; }
#pragma unroll
            for (int j = 0; j < 16; ++j) { v2u w2; w2.x = cvtpk(st.x, st.y); w2.y = cvtpk(st.z, st.w); wt8(o + (size_t)(c0 + j) * 16384, w2.x, w2.y);
                const v4f vv = {bflo(v[j].x), bfhi(v[j].x), bflo(v[j].y), bfhi(v[j].y)}; st = st * d[j] + vv; }
        }
    }
}

__device__ __forceinline__ void phase_ssd_s3(const Args& a, LAS unsigned char* lds) {
    const int tid = threadIdx.x, lane = tid & 63, w = __builtin_amdgcn_readfirstlane(tid >> 6), l32 = lane & 31, hh = lane >> 5;
    const int hl = w >> 1, half = w & 1;
    const int gi = (lane >> 4) & 1, q4 = (lane & 15) >> 2, pp = lane & 3;
    const bf16* PROJ = (const bf16*)(a.ws + WS_PROJ); bf16* YC = (bf16*)(a.ws + WS_H);
    for (int item = blockIdx.x; item < NB * NCH * 2; item += gridDim.x) {
        const int it2 = ssd_item(item), g = it2 & 1, c = (it2 >> 1) & (NCH - 1), b = it2 >> 6, h = 4 * g + hl;
        const size_t m0 = (size_t)b * SEQ + 64 * c;
        __syncthreads();
        bf16x8v pvf[8][2];
        { const bf16* pvb = (const bf16*)(a.ws + WS_PB) + ((((size_t)b * NCH + c) * 8 + h) * 64 + l32) * 128 + 8 * hh;
#pragma unroll
          for (int s = 0; s < 8; ++s) { pvf[s][0] = *(const bf16x8v*)(pvb + 16 * s); pvf[s][1] = *(const bf16x8v*)(pvb + 32 * 128 + 16 * s); } }
        ConvIn cin; v4u zr[4];
        {
            const int cp = tid & 255, th = tid >> 8;
            const int ccol = cp < 128 ? 256 * g + 2 * cp : (cp < 192 ? 512 + 128 * g + 2 * (cp - 128) : 768 + 128 * g + 2 * (cp - 192));
            ssd_conv_load(a, cin, b, c, th, ccol);
#pragma unroll
            for (int i = 0; i < 4; ++i) { const int id = tid + 512 * i, row = id >> 5, ck = id & 31; zr[i] = *(const v4u*)(PROJ + (m0 + row) * N1 + PZ + 256 * g + 8 * ck); }
            ssd_dt<false>(a, lds, b, c, g, ssd_dt_load(a, b, c, g));
            LAS unsigned char* cdst = cp < 128 ? lds + SD_X + 4 * cp : (cp < 192 ? lds + SD_B + 4 * (cp - 128) : lds + SD_C + 4 * (cp - 192));
            ssd_conv_compute<false>(a, cin, cdst, cp < 128 ? SD_XS : SD_BS, th, ccol, nullptr);
#pragma unroll
            for (int i = 0; i < 4; ++i) { const int id = tid + 512 * i, row = id >> 5, ck = id & 31; *(LAS v4u*)(lds + SD_Z + row * SD_ZS + 16 * ck) = zr[i]; }
        }
        __syncthreads();
        const int lcol = 32 * half + l32;
        bf16x8v cf[8];
        f32x16 yo[2], yd[2];
#pragma unroll
        for (int i = 0; i < 16; ++i) { yo[0][i] = 0.f; yo[1][i] = 0.f; yd[0][i] = 0.f; yd[1][i] = 0.f; }
#pragma unroll
        for (int s = 0; s < 8; ++s) {
            cf[s] = *(LAS const bf16x8v*)(lds + SD_C + lcol * SD_BS + (16 * s + 8 * hh) * 2);
            yo[0] = MFMA32(pvf[s][0], cf[s], yo[0]); yo[1] = MFMA32(pvf[s][1], cf[s], yo[1]);
        }
        const float acs_l = ((const LAS float*)(lds + SD_ACS))[hl * 64 + lcol];
#pragma unroll
        for (int sb = 0; sb < 2; ++sb) {
            if (sb <= half) {
                f32x16 cb;
#pragma unroll
                for (int i = 0; i < 16; ++i) cb[i] = 0.f;
#pragma unroll
                for (int s = 0; s < 8; ++s) { const bf16x8v bfrag = *(LAS const bf16x8v*)(lds + SD_B + (32 * sb + l32) * SD_BS + (16 * s + 8 * hh) * 2); cb = MFMA32(bfrag, cf[s], cb); }
                float mv[16];
#pragma unroll
                for (int gq = 0; gq < 4; ++gq) {
                    const v4f as4 = *(const LAS v4f*)(lds + SD_ACS + (hl * 64 + 32 * sb + 8 * gq + 4 * hh) * 4), dt4 = *(const LAS v4f*)(lds + SD_DT + (hl * 64 + 32 * sb + 8 * gq + 4 * hh) * 4);
#pragma unroll
                    for (int j = 0; j < 4; ++j) { const int srow = 32 * sb + 8 * gq + 4 * hh + j;
                        const float dec = __expf(fminf(acs_l - as4[j], 0.f)) * dt4[j];
                        mv[4 * gq + j] = (srow <= lcol) ? cb[4 * gq + j] * dec : 0.f; }
                }
#pragma unroll
                for (int k2 = 0; k2 < 2; ++k2) {
                    v4u pk; pk.x = cvtpk(mv[8 * k2], mv[8 * k2 + 1]); pk.y = cvtpk(mv[8 * k2 + 2], mv[8 * k2 + 3]); pk.z = cvtpk(mv[8 * k2 + 4], mv[8 * k2 + 5]); pk.w = cvtpk(mv[8 * k2 + 6], mv[8 * k2 + 7]);
                    const bf16x8v mf = __builtin_bit_cast(bf16x8v, pk);
#pragma unroll
                    for (int pb = 0; pb < 2; ++pb) {
                        const bf16x8v xf = tr_pair(lds + SD_X + (32 * sb + 16 * k2 + 4 * hh + q4) * SD_XS + (64 * hl + 32 * pb + 16 * gi + 4 * pp) * 2, 8 * SD_XS);
                        yd[pb] = MFMA32(xf, mf, yd[pb]);
                    }
                }
            }
        }
        const float eal = __expf(acs_l), dsk = a.d_skip[h];
        float y[2][16]; float ss = 0.f;
#pragma unroll
        for (int pb = 0; pb < 2; ++pb)
#pragma unroll
            for (int gq = 0; gq < 4; ++gq) {
                const int ch = 64 * hl + 32 * pb + 8 * gq + 4 * hh;
                const v2u xv = *(const LAS v2u*)(lds + SD_X + lcol * SD_XS + ch * 2), zv = *(const LAS v2u*)(lds + SD_Z + lcol * SD_ZS + ch * 2);
                const float xs[4] = {bflo(xv.x), bfhi(xv.x), bflo(xv.y), bfhi(xv.y)}, zs[4] = {bflo(zv.x), bfhi(zv.x), bflo(zv.y), bfhi(zv.y)};
#pragma unroll
                for (int j = 0; j < 4; ++j) { float t = yd[pb][4 * gq + j] + yo[pb][4 * gq + j] * eal + dsk * xs[j]; t *= silu_fast(zs[j]); y[pb][4 * gq + j] = t; ss += t * t; }
            }
        ss += __shfl_xor(ss, 32);
        if (hh == 0) ((LAS float*)(lds + SD_WB))[hl * 64 + lcol] = ss;
        __syncthreads();
        const LAS float* sred = (const LAS float*)(lds + SD_WB);
        const float tot = (sred[lcol] + sred[64 + lcol]) + (sred[128 + lcol] + sred[192 + lcol]);
        const float rstd = rsqrtf(tot * (1.f / 256.f) + EPS);
        bf16* yp = YC + (m0 + lcol) * 1024 + 256 * g + 64 * hl + 4 * hh;
        const float* gp = a.ssd_norm_gain + 256 * g + 64 * hl + 4 * hh;
#pragma unroll
        for (int pb = 0; pb < 2; ++pb)
#pragma unroll
            for (int gq = 0; gq < 4; ++gq) {
                const v4f gn = *(const v4f*)(gp + 32 * pb + 8 * gq);
                v2u o; o.x = pk2(y[pb][4 * gq] * rstd * gn.x, y[pb][4 * gq + 1] * rstd * gn.y); o.y = pk2(y[pb][4 * gq + 2] * rstd * gn.z, y[pb][4 * gq + 3] * rstd * gn.w);
                *(v2u*)(yp + 32 * pb + 8 * gq) = o;
            }
    }
}

__device__ __forceinline__ void phase_norm1(const Args& a) {
    const int lane = threadIdx.x & 63, wave = threadIdx.x >> 6, gw = blockIdx.x * NWAVES + wave, NGW = gridDim.x * NWAVES;
    const bf16* MIX = (const bf16*)(a.ws + WS_PROJ); bf16* H = (bf16*)(a.ws + WS_H);
    v4f g1[4], g2[4];
#pragma unroll
    for (int j = 0; j < 4; ++j) { g1[j] = ((const v4f*)a.post_mix_gain)[lane + 64 * j]; g2[j] = ((const v4f*)a.pre_ffn_gain)[lane + 64 * j]; }
    v2u mv[4], mvn[4]; v4f xv[4], xvn[4];
    if (gw < M) {
#pragma unroll
        for (int j = 0; j < 4; ++j) { mv[j] = ((const v2u*)(MIX + (size_t)gw * DM))[lane + 64 * j]; xv[j] = ((const v4f*)(a.x + (size_t)gw * DM))[lane + 64 * j]; }
    }
    for (int m = gw; m < M; m += NGW) {
        const int mn = m + NGW;
        if (mn < M) {
#pragma unroll
            for (int j = 0; j < 4; ++j) { mvn[j] = ((const v2u*)(MIX + (size_t)mn * DM))[lane + 64 * j]; xvn[j] = ((const v4f*)(a.x + (size_t)mn * DM))[lane + 64 * j]; }
        }
        v4f* orow = (v4f*)(a.out + (size_t)m * DM) + lane;
        v4f v[4]; float s = 0.f;
#pragma unroll
        for (int j = 0; j < 4; ++j) { v[j] = (v4f){bflo(mv[j].x), bfhi(mv[j].x), bflo(mv[j].y), bfhi(mv[j].y)}; s += (v[j].x * v[j].x + v[j].y * v[j].y) + (v[j].z * v[j].z + v[j].w * v[j].w); }
        const float rstd = rsqrtf(wave_sum(s) * (1.f / DM) + EPS);
        float s2 = 0.f;
#pragma unroll
        for (int j = 0; j < 4; ++j) { xv[j] = xv[j] + v[j] * rstd * g1[j]; orow[64 * j] = xv[j];
            s2 += (xv[j].x * xv[j].x + xv[j].y * xv[j].y) + (xv[j].z * xv[j].z + xv[j].w * xv[j].w); }
        const float rstd2 = rsqrtf(wave_sum(s2) * (1.f / DM) + EPS);
        unsigned long long* o8 = (unsigned long long*)(H + (size_t)m * DM) + lane;
#pragma unroll
        for (int j = 0; j < 4; ++j) { const v4f hv = xv[j] * rstd2 * g2[j];
            o8[64 * j] = (unsigned long long)pk2(hv.x, hv.y) | ((unsigned long long)pk2(hv.z, hv.w) << 32); }
#pragma unroll
        for (int j = 0; j < 4; ++j) { mv[j] = mvn[j]; xv[j] = xvn[j]; }
    }
}
__device__ __forceinline__ void phase_norm2(const Args& a) {
    const int lane = threadIdx.x & 63, wave = threadIdx.x >> 6, gw = blockIdx.x * NWAVES + wave, NGW = gridDim.x * NWAVES;
    const bf16* F = (const bf16*)(a.ws + WS_CS);
    v4f g1[4];
#pragma unroll
    for (int j = 0; j < 4; ++j) g1[j] = ((const v4f*)a.post_ffn_gain)[lane + 64 * j];
    v2u fv[4], fvn[4]; v4f xv[4], xvn[4];
    if (gw < M) {
#pragma unroll
        for (int j = 0; j < 4; ++j) { fv[j] = ((const v2u*)(F + (size_t)gw * DM))[lane + 64 * j]; xv[j] = ((const v4f*)(a.out + (size_t)gw * DM))[lane + 64 * j]; }
    }
    for (int m = gw; m < M; m += NGW) {
        const int mn = m + NGW;
        if (mn < M) {
#pragma unroll
            for (int j = 0; j < 4; ++j) { fvn[j] = ((const v2u*)(F + (size_t)mn * DM))[lane + 64 * j]; xvn[j] = ((const v4f*)(a.out + (size_t)mn * DM))[lane + 64 * j]; }
        }
        v4f* orow = (v4f*)(a.out + (size_t)m * DM) + lane;
        v4f v[4]; float s = 0.f;
#pragma unroll
        for (int j = 0; j < 4; ++j) { v[j] = (v4f){bflo(fv[j].x), bfhi(fv[j].x), bflo(fv[j].y), bfhi(fv[j].y)}; s += (v[j].x * v[j].x + v[j].y * v[j].y) + (v[j].z * v[j].z + v[j].w * v[j].w); }
        const float rstd = rsqrtf(wave_sum(s) * (1.f / DM) + EPS);
#pragma unroll
        for (int j = 0; j < 4; ++j) orow[64 * j] = xv[j] + v[j] * rstd * g1[j];
#pragma unroll
        for (int j = 0; j < 4; ++j) { fv[j] = fvn[j]; xv[j] = xvn[j]; }
    }
}

#define XB_TMO      128
#define XB_XCNT(j)  (256  + 64 * (j))
#define XB_XSUB(j)  (1280 + 64 * (j))
#define XB_XGEN(j)  (2304 + 64 * (j))
#define XB_TOP      3328
#define XB_TOPGEN   3392
#define XCD_BAR_WORDS 3456
#define XB_SPIN_CAP (1u << 18)

__device__ __forceinline__ unsigned xb_ld(unsigned* p)              { return __hip_atomic_load(p, __ATOMIC_RELAXED, __HIP_MEMORY_SCOPE_AGENT); }
__device__ __forceinline__ unsigned xb_add(unsigned* p, unsigned v) { return __hip_atomic_fetch_add(p, v, __ATOMIC_RELAXED, __HIP_MEMORY_SCOPE_AGENT); }
__device__ __forceinline__ unsigned xb_xcc_id() { return (unsigned)__builtin_amdgcn_s_getreg((3 << 11) | 20) & 0xFu; }
#define XB_SPIN(cond, bar) do { unsigned _sp = 0; while (cond) { __builtin_amdgcn_s_sleep(1); \
    if ((++_sp & 255u) == 0u) { if (xb_ld(&(bar)[XB_TMO])) break; if (_sp > XB_SPIN_CAP) { atomicAdd(&(bar)[XB_TMO], 1u); break; } } } } while (0)

struct XcdBarrier {
    unsigned* bar; unsigned x;
    volatile LAS unsigned* st;
};

__device__ __forceinline__ XcdBarrier xcd_barrier_post(unsigned* bar, volatile LAS unsigned* st) {
    XcdBarrier b; b.bar = bar; b.x = xb_xcc_id(); b.st = st;
    if (threadIdx.x == 0) (void)xb_add(&bar[XB_XCNT(b.x)], 1u);
    return b;
}
__device__ __forceinline__ void xcd_barrier_complete(unsigned* bar, unsigned x, unsigned& nloc, unsigned& nx) {
    const unsigned G = gridDim.x * gridDim.y * gridDim.z;
    unsigned sum, cnt, mine, sp = 0u;
    for (;;) {
        sum = 0u; cnt = 0u; mine = 0u;
#pragma unroll
        for (unsigned j = 0; j < 16; ++j) { const unsigned c = xb_ld(&bar[XB_XCNT(j)]); sum += c; cnt += (c > 0u) ? 1u : 0u; mine = (j == x) ? c : mine; }
        if (sum == G) break;
        __builtin_amdgcn_s_sleep(1);
        if ((++sp & 255u) == 0u) { if (xb_ld(&bar[XB_TMO])) break; if (sp > XB_SPIN_CAP) { atomicAdd(&bar[XB_TMO], 1u); break; } }
    }
    nloc = mine > 0u ? mine : 1u; nx = cnt > 0u ? cnt : 1u;
}

__device__ __forceinline__ void xcd_barrier(const XcdBarrier& b) {
    asm volatile("s_waitcnt vmcnt(0)" ::: "memory");
    __syncthreads();
    if (threadIdx.x == 0) {
        unsigned* bar = b.bar;
        __builtin_amdgcn_s_waitcnt(0);
        unsigned nloc = b.st[0], nx = b.st[1];
        if (nloc == 0u) { xcd_barrier_complete(bar, b.x, nloc, nx); b.st[0] = nloc; b.st[1] = nx; }
        const unsigned old = xb_add(&bar[XB_XSUB(b.x)], 1u);
        const unsigned gen = old / nloc;
        if (old + 1u == (gen + 1u) * nloc) {
            __builtin_amdgcn_fence(__ATOMIC_RELEASE, "agent");
            asm volatile("s_waitcnt vmcnt(0)" ::: "memory");
            const unsigned og = xb_add(&bar[XB_TOP], 1u);
            const unsigned tg = og / nx;
            if (og + 1u == (tg + 1u) * nx) xb_add(&bar[XB_TOPGEN], 1u);
            else XB_SPIN(xb_ld(&bar[XB_TOPGEN]) == tg, bar);
            __builtin_amdgcn_fence(__ATOMIC_ACQUIRE, "agent");
            xb_add(&bar[XB_XGEN(b.x)], 1u);
            asm volatile("s_waitcnt vmcnt(0)" ::: "memory");
        } else {
            XB_SPIN(xb_ld(&bar[XB_XGEN(b.x)]) == gen, bar);
            __builtin_amdgcn_fence(__ATOMIC_ACQUIRE, "agent");
            asm volatile("s_waitcnt vmcnt(0)" ::: "memory");
        }
    }
    __syncthreads();
}


__device__ __forceinline__ int ssd_item(int item) {
    if (gridDim.x != 256) return item;
    const int blk = item & 255, k = item >> 8, grp = blk & 7, j = blk >> 3;
    return (grp << 6) | (j + 32 * k);
}
#define XL_SUB(g) (3472 + 16 * (g))
#define XL_GEN(g) (3600 + 16 * (g))
#define XL_MASK(g) (3456 + (g))
__device__ __forceinline__ void local_barrier(unsigned* ctl, int g) {
    asm volatile("s_waitcnt vmcnt(0)" ::: "memory");
    __syncthreads();
    if (threadIdx.x == 0) {
        const unsigned old = xb_add(&ctl[XL_SUB(g)], 1u), gen = old / 32u;
        if (old + 1u == (gen + 1u) * 32u) xb_add(&ctl[XL_GEN(g)], 1u);
        else { unsigned sp = 0u; while (xb_ld(&ctl[XL_GEN(g)]) == gen) { __builtin_amdgcn_s_sleep(1); if (++sp > (1u << 22)) break; } }
        __builtin_amdgcn_fence(__ATOMIC_ACQUIRE, "agent");
        asm volatile("s_waitcnt vmcnt(0)" ::: "memory");
    }
    __syncthreads();
}
constexpr int NPHASE = 10;
__global__ void __launch_bounds__(NTHR, 2) fwd(Args a) {
    extern __shared__ __attribute__((aligned(16))) unsigned char lds_raw[];
    LAS unsigned char* lds = (LAS unsigned char*)lds_raw;
    const int lo = a.ph_lo, hi = a.ph_hi;
#ifndef REPMASK
#define REPMASK 0
#endif
#define REP(k) for (int _r = 0; _r < (((REPMASK) >> (k)) & 1) + 1; ++_r)
#define IN(k) (lo <= (k) && (k) < hi)
#define SEAM(k) do { if (IN(k) && IN((k) + 1)) xcd_barrier(bar); } while (0)
    unsigned char* ws = a.ws;
    volatile LAS unsigned* misc = (volatile LAS unsigned*)(lds + 131072);
    if (threadIdx.x < 2) misc[threadIdx.x] = 0u;
    __syncthreads();
    XcdBarrier bar = xcd_barrier_post((unsigned*)(ws + WS_CTL), misc);
    unsigned* ctlw = (unsigned*)(ws + WS_CTL);
    if (threadIdx.x == 0) __hip_atomic_fetch_or(&ctlw[XL_MASK(blockIdx.x & 7)], 1u << bar.x, __ATOMIC_RELAXED, __HIP_MEMORY_SCOPE_AGENT);
    if ((REPMASK) & 16384) { for (int i = 0; i < 10; ++i) xcd_barrier(bar); }
    const bool defer_w4 = (gridDim.x == 256) && lo == 0 && hi > 7;
    if (IN(0)) REP(0) { phase_p0(a, lds, defer_w4); __syncthreads(); }
    SEAM(0);
    bool colo = false;
    if ((gridDim.x == 256) && lo == 0 && hi > 5) {
        unsigned seen = 0u; colo = true;
#pragma unroll
        for (int g8 = 0; g8 < 8; ++g8) { const unsigned mk = xb_ld(&ctlw[XL_MASK(g8)]); colo = colo && mk != 0u && (mk & (mk - 1u)) == 0u && (seen & mk) == 0u; seen |= mk; }
        colo = __builtin_amdgcn_readfirstlane(colo ? 1 : 0) != 0;
    }
#define SEAM_L(k) do { if (IN(k) && IN((k) + 1)) { if (colo) local_barrier(ctlw, blockIdx.x & 7); else xcd_barrier(bar); } } while (0)
    if (IN(1)) REP(1) { pg8::Gemm g{(const bf16*)(ws + WS_H), (const bf16*)(ws + WS_W1), M, N1, DM}; pg8::StaticOrder S; S.init(M, N1, gridDim.x, blockIdx.x);
        pg8::EpiProj E{(bf16*)(ws + WS_PROJ)}; pg8::gemm_phase<pg8::EpiProj, pg8::StaticOrder, true, true>(lds, g, S, E); }
    SEAM_L(1);
    const bool att_first = colo && (blockIdx.x & 1) && IN(2) && IN(4);
    if (att_first) { phase_attn(a, lds); __syncthreads(); }
    if (IN(2)) REP(2) { phase_ssd_s1(a, lds); }
    SEAM_L(2);
    if (IN(3)) REP(3) { phase_ssd_s2(a); }
    SEAM_L(3);
    if (IN(4)) { REP(10) { phase_ssd_s3(a, lds); __syncthreads(); } if (!att_first) REP(11) { phase_attn(a, lds); __syncthreads(); } }
    SEAM_L(4);
    const bool fuse_n1 = (gridDim.x == 256) && lo <= 5 && hi > 7;
    if (IN(5)) { pg8::Gemm g{(const bf16*)(ws + WS_H), (const bf16*)(ws + WS_W2), M, DM, DM}; pg8::StaticOrder S; S.init(M, DM, gridDim.x, blockIdx.x);
        if (fuse_n1) {
            pg8::EpiRmsResRms E{a.x, (bf16*)(ws + WS_CS), (bf16*)(ws + WS_PB), a.post_mix_gain, a.pre_ffn_gain, (float*)(ws + WS_CTL + 65536 + 262144), (unsigned*)(ws + WS_CTL + 32768), (float*)(ws + WS_CTL + 65536 + 524288), (unsigned*)(ws + WS_CTL + 49152)};
            pg8::gemm_phase<pg8::EpiRmsResRms, pg8::StaticOrder, false, true>(lds, g, S, E);
        } else {
            pg8::EpiBf16 E{(bf16*)(ws + WS_PROJ), DM}; pg8::gemm_phase<pg8::EpiBf16, pg8::StaticOrder, true, true>(lds, g, S, E);
        }
    }
    if (!fuse_n1) {
    SEAM(5);
    if (IN(6)) REP(6) { phase_norm1(a); }
    }
    SEAM_L(6);
    if (IN(7)) REP(7) { pg8::Gemm g{(const bf16*)(ws + (fuse_n1 ? WS_PB : WS_H)), (const bf16*)(ws + WS_W3), M, N3, DM}; pg8::StaticOrder S; S.init(M, N3, gridDim.x, blockIdx.x);
        pg8::EpiSwiglu E{(bf16*)(ws + WS_PROJ)}; pg8::gemm_phase<pg8::EpiSwiglu, pg8::StaticOrder, true, true>(lds, g, S, E);
        if (defer_w4) { __syncthreads(); phase_w4(a, lds); } }
    SEAM(7);
    if (IN(8)) { pg8::Gemm g{(const bf16*)(ws + WS_PROJ), (const bf16*)(ws + WS_W4), M, DM, DFF, (size_t)1 << 20}; pg8::StaticOrder S; S.init(M, DM, gridDim.x, blockIdx.x);
        if (gridDim.x == 256 && hi > 9 && lo <= 5) {
            pg8::EpiRmsRes E{(const bf16*)(ws + WS_CS), a.out, a.post_ffn_gain, (float*)(ws + WS_CTL + 65536), (unsigned*)(ws + WS_CTL + 16384)};
            pg8::gemm_phase<pg8::EpiRmsRes, pg8::StaticOrder, false, true>(lds, g, S, E);
        } else {
            pg8::EpiBf16 E{(bf16*)(ws + WS_CS), DM}; pg8::gemm_phase<pg8::EpiBf16, pg8::StaticOrder, true, true>(lds, g, S, E);
            SEAM(8);
            if (IN(9)) { phase_norm2(a); }
        }
    }
#undef IN
#undef SEAM
}

#ifndef N_LAUNCHES
#define N_LAUNCHES 1
#endif
extern "C" void kernel_launch(void* const* d_in, const int* in_sizes, int n_in, void* d_out, int out_size, void* d_ws, size_t ws_size, hipStream_t stream) {
    static int grid = 0;
    if (grid == 0) {
        if (n_in != 17 || out_size != M * DM || ws_size < WS_END) { fprintf(stderr, "kernel_launch: unexpected problem (n_in %d out %d ws %zu)\n", n_in, out_size, ws_size); grid = -1; return; }
        int dev = 0, cus = 0, per_cu = 0;
        hipGetDevice(&dev); hipDeviceGetAttribute(&cus, hipDeviceAttributeMultiprocessorCount, dev);
        if (hipFuncSetAttribute((const void*)fwd, hipFuncAttributeMaxDynamicSharedMemorySize, LDS_BYTES) != hipSuccess) { fprintf(stderr, "kernel_launch: hipFuncSetAttribute failed\n"); grid = -1; return; }
        if (hipOccupancyMaxActiveBlocksPerMultiprocessor(&per_cu, (const void*)fwd, NTHR, LDS_BYTES) != hipSuccess || per_cu < 1) { fprintf(stderr, "kernel_launch: occupancy query says %d blocks per CU\n", per_cu); per_cu = 1; }
        (void)hipGetLastError();
        grid = cus;
    }
    if (grid < 0) return;
    if (hipMemsetAsync((char*)d_ws + WS_CTL, 0, 65536, stream) != hipSuccess) { fprintf(stderr, "kernel_launch: memset failed\n"); return; }
    Args a{};
    const float** ap = (const float**)&a;
    for (int i = 0; i < 17; ++i) ap[i] = (const float*)d_in[i];
    a.out = (float*)d_out; a.ws = (unsigned char*)d_ws;
#if N_LAUNCHES == 1
    a.ph_lo = 0; a.ph_hi = NPHASE;
    void* args[] = {&a};
    hipError_t e = hipLaunchCooperativeKernel((const void*)fwd, dim3(grid), dim3(NTHR), args, LDS_BYTES, stream);
    if (e != hipSuccess) fprintf(stderr, "cooperative launch failed: %s (grid %d)\n", hipGetErrorString(e), grid);
#else
    for (int ph = 0; ph < NPHASE; ++ph) { a.ph_lo = ph; a.ph_hi = ph + 1; hipLaunchKernelGGL(fwd, dim3(grid), dim3(NTHR), LDS_BYTES, stream, a); }
#endif
}
```
